# Optimizing an MI355X kernel written in HIP

```python
import jax, jax.numpy as jnp
from jax import lax
import numpy as np

D_MODEL = 1024
BATCH = 4
SEQ = 8192
DEPTH = 2

GRID_W = 64
CTX_LEN = 256
D_MIX = D_MODEL
D_FOURIER = D_MIX // 2
FOURIER_GROUPS = 8
FOURIER_GW = D_FOURIER // FOURIER_GROUPS
D_MLSTM = D_MIX - D_FOURIER
MLSTM_HEADS = 4
MLSTM_HD = D_MLSTM // MLSTM_HEADS
N_GATE = 4 * MLSTM_HEADS
D_IN = D_FOURIER + 2 * D_MLSTM + N_GATE
CONV_K = 3
CHUNK = 128
D_FF = 2816
N_MOD = 9
FFN_RES = 0.5
EPS = 1e-6

kernel_name = "hybrid_fourier_mlstm_macaron_dit"


def rmsnorm(x, w):
    xf = x.astype(jnp.float32)
    y = xf * lax.rsqrt(jnp.mean(xf * xf, axis=-1, keepdims=True) + EPS)
    return (y * w.astype(jnp.float32)).astype(x.dtype)


def _mod(m, j):
    return m[..., 3 * j, :], m[..., 3 * j + 1, :], m[..., 3 * j + 2, :]


def _pre(x, nw, shift, scale):
    return rmsnorm(x, nw) * (1 + scale) + shift


def swiglu(h, w_in_ff, w_out_ff):
    gu = h @ w_in_ff
    g, u = gu[..., :D_FF], gu[..., D_FF:]
    return (jax.nn.silu(g) * u) @ w_out_ff


def _ffn_sublayer(x, mod, j, nw_pre, nw_post, w_in_ff, w_out_ff):
    shift, scale, gate = _mod(mod, j)
    y = swiglu(_pre(x, nw_pre, shift, scale), w_in_ff, w_out_ff)
    return x + FFN_RES * gate * rmsnorm(y, nw_post)


def fourier_mix(xf, w_fmix):
    b_, s_, _ = xf.shape
    xg = xf.astype(jnp.float32).reshape(b_, s_, FOURIER_GROUPS, FOURIER_GW)
    y = jnp.fft.fft2(xg, axes=(1, 3), norm="ortho").real.astype(xf.dtype)
    y = jnp.einsum("bsgc,gcd->bsgd", y, w_fmix)
    return y.reshape(b_, s_, D_FOURIER)


def grid_conv(x, w, b):
    b_, s_, c_ = x.shape
    rows = s_ // GRID_W
    img = x.reshape(b_, rows, GRID_W, c_)
    y = lax.conv_general_dilated(img, w[:, :, None, :].astype(x.dtype), (1, 1), "SAME",
                                 dimension_numbers=("NHWC", "HWIO", "NHWC"),
                                 feature_group_count=c_)
    return y.reshape(b_, s_, c_) + b


def seq_conv(x, w, b):
    c_ = x.shape[-1]
    y = lax.conv_general_dilated(x, w[:, None, :].astype(x.dtype), (1,), "SAME",
                                 dimension_numbers=("NWC", "WIO", "NWC"),
                                 feature_group_count=c_)
    return y + b


def _split_proj(u):
    xf = u[..., :D_FOURIER]
    xm = u[..., D_FOURIER:D_FOURIER + D_MLSTM]
    z = u[..., D_FOURIER + D_MLSTM:D_FOURIER + 2 * D_MLSTM]
    g = u[..., D_FOURIER + 2 * D_MLSTM:]
    return xf, xm, z, g


def _mlstm_inputs(xm, xconv, g, w_qkv, gate_b):
    b_, s_, _ = xm.shape
    heads = lambda t: t.reshape(b_, s_, MLSTM_HEADS, MLSTM_HD)
    q = jnp.einsum("bshd,hde->bhse", heads(xconv), w_qkv[0]).astype(jnp.float32)
    k = (jnp.einsum("bshd,hde->bhse", heads(xconv), w_qkv[1]) * MLSTM_HD ** -0.5).astype(jnp.float32)
    v = jnp.einsum("bshd,hde->bhse", heads(xm), w_qkv[2]).astype(jnp.float32)
    gp = g.astype(jnp.float32) + gate_b.reshape(-1).astype(jnp.float32)
    gp = jnp.transpose(gp.reshape(b_, s_, 4, MLSTM_HEADS), (2, 0, 3, 1))
    gates = (gp[0], jax.nn.log_sigmoid(gp[1]), gp[2], jax.nn.log_sigmoid(gp[3]))
    return q, k, v, gates


def _flip(t):
    return jnp.flip(t, axis=2)


def _chunk(t):
    return t.reshape(t.shape[:2] + (t.shape[2] // CHUNK, CHUNK) + t.shape[3:])


def mlstm_states(k, v, ig, lf, state0):
    kc, vc = _chunk(k), _chunk(v)
    igc, lfc = _chunk(ig), _chunk(lf)
    b = jnp.cumsum(lfc, axis=-1)
    b_tot = b[..., -1]
    a = b_tot[..., None] - b + igc
    m_loc = jnp.max(a, axis=-1)
    w = jnp.exp(a - m_loc[..., None])
    c_loc = jnp.einsum("bhcsd,bhcse->bhcde", vc * w[..., None], kc)
    n_loc = jnp.einsum("bhcs,bhcse->bhce", w, kc)

    def step(carry, xs):
        c_st, n_st, m_st = carry
        cl, nl, ml, bt = xs
        m_new = jnp.maximum(bt + m_st, ml)
        dec = jnp.exp(bt + m_st - m_new)
        inj = jnp.exp(ml - m_new)
        c_new = dec[..., None, None] * c_st + inj[..., None, None] * cl
        n_new = dec[..., None] * n_st + inj[..., None] * nl
        return (c_new, n_new, m_new), (c_st, n_st, m_st)

    xs = (jnp.moveaxis(c_loc, 2, 0), jnp.moveaxis(n_loc, 2, 0),
          jnp.moveaxis(m_loc, 2, 0), jnp.moveaxis(b_tot, 2, 0))
    final, prev = lax.scan(step, state0, xs)
    prev = tuple(jnp.moveaxis(t, 0, 2) for t in prev)
    return prev, final


def mlstm_outputs(q, k, v, ig, lf, prev):
    c_prev, n_prev, m_prev = prev
    qc, kc, vc = _chunk(q), _chunk(k), _chunk(v)
    igc, lfc = _chunk(ig), _chunk(lf)
    b = jnp.cumsum(lfc, axis=-1)
    log_inter = b + m_prev[..., None]
    log_intra = b[..., :, None] - b[..., None, :] + igc[..., None, :]
    scan_order = jnp.tril(jnp.ones((CHUNK, CHUNK), dtype=bool))
    log_intra = jnp.where(scan_order, log_intra, -jnp.inf)
    m_t = jnp.maximum(log_inter, jnp.max(log_intra, axis=-1))
    w_intra = jnp.exp(log_intra - m_t[..., None])
    w_inter = jnp.exp(log_inter - m_t)
    s = jnp.einsum("bhctd,bhcsd->bhcts", qc, kc) * w_intra
    num = (jnp.einsum("bhcts,bhcsd->bhctd", s, vc)
           + w_inter[..., None] * jnp.einsum("bhcde,bhcte->bhctd", c_prev, qc))
    den = jnp.sum(s, axis=-1) + w_inter * jnp.einsum("bhce,bhcte->bhct", n_prev, qc)
    h = num / jnp.maximum(jnp.abs(den), jnp.exp(-m_t))[..., None]
    return h.reshape(q.shape)


def _bidir_outputs(q, k, v, gates, prev_f, prev_b):
    i_f, f_f, i_b, f_b = gates
    h_f = mlstm_outputs(q, k, v, i_f, f_f, prev_f)
    h_b = mlstm_outputs(_flip(q), _flip(k), _flip(v), _flip(i_b), _flip(f_b), prev_b)
    return h_f + _flip(h_b)


def head_norm(h, w):
    mu = jnp.mean(h, axis=-1, keepdims=True)
    var = jnp.mean(jnp.square(h - mu), axis=-1, keepdims=True)
    hn = (h - mu) * lax.rsqrt(var + EPS)
    b_, _, s_, _ = h.shape
    hn = jnp.transpose(hn, (0, 2, 1, 3)).reshape(b_, s_, D_MLSTM)
    return hn * w.astype(jnp.float32)


def _combine(xf, h_sum, z, w_fmix, hn_w, w_out):
    yf = fourier_mix(xf, w_fmix)
    ym = head_norm(h_sum, hn_w).astype(z.dtype) * jax.nn.sigmoid(z)
    return jnp.concatenate([yf, ym], axis=-1) @ w_out


def setup_inputs(seed: int = 0) -> dict:
    key = jax.random.key(seed)
    ks = jax.random.split(key, 20)
    nrm = lambda k, shape, s: jax.random.normal(k, shape, jnp.float32) * s
    forget_bias = jnp.linspace(3.0, 6.0, MLSTM_HEADS, dtype=jnp.float32)
    gb = nrm(ks[14], (DEPTH, 4, MLSTM_HEADS), 0.1)
    gb = gb + jnp.stack([jnp.zeros_like(forget_bias), forget_bias,
                         jnp.zeros_like(forget_bias), forget_bias])[None]
    return {
        "x": nrm(ks[0], (BATCH, SEQ, D_MODEL), 1.0),
        "c": nrm(ks[1], (BATCH, D_MODEL), 1.0),
        "ctx": nrm(ks[2], (BATCH, CTX_LEN, D_MODEL), 1.0),
        "c_ctx": nrm(ks[3], (D_MODEL,), 1.0),
        "w_ada": nrm(ks[4], (DEPTH, D_MODEL, N_MOD * D_MODEL), 0.5 * D_MODEL ** -0.5),
        "b_ada": nrm(ks[5], (DEPTH, N_MOD * D_MODEL), 0.02),
        "norm_w": 1.0 + nrm(ks[6], (DEPTH, 6, D_MODEL), 0.05),
        "w_ff_in": nrm(ks[7], (DEPTH, 2, D_MODEL, 2 * D_FF), D_MODEL ** -0.5),
        "w_ff_out": nrm(ks[8], (DEPTH, 2, D_FF, D_MODEL), D_FF ** -0.5),
        "w_in": nrm(ks[9], (DEPTH, D_MODEL, D_IN), D_MODEL ** -0.5),
        "w_fmix": nrm(ks[10], (DEPTH, FOURIER_GROUPS, FOURIER_GW, FOURIER_GW), FOURIER_GW ** -0.5),
        "conv_w": nrm(ks[11], (DEPTH, CONV_K, CONV_K, D_MLSTM), (CONV_K * CONV_K) ** -0.5),
        "conv_b": nrm(ks[12], (DEPTH, D_MLSTM), 0.02),
        "w_qkv": nrm(ks[13], (DEPTH, 3, MLSTM_HEADS, MLSTM_HD, MLSTM_HD), MLSTM_HD ** -0.5),
        "gate_b": gb,
        "mlstm_norm_w": 1.0 + nrm(ks[15], (DEPTH, D_MLSTM), 0.05),
        "w_out": nrm(ks[16], (DEPTH, D_MIX, D_MODEL), D_MIX ** -0.5),
    }


def reference(x, c, ctx, c_ctx, w_ada, b_ada, norm_w, w_ff_in, w_ff_out, w_in, w_fmix,
              conv_w, conv_b, w_qkv, gate_b, mlstm_norm_w, w_out):
    b_ = x.shape[0]
    xl, xc = x, ctx
    zero = (jnp.zeros((b_, MLSTM_HEADS, MLSTM_HD, MLSTM_HD), jnp.float32),
            jnp.zeros((b_, MLSTM_HEADS, MLSTM_HD), jnp.float32),
            jnp.zeros((b_, MLSTM_HEADS), jnp.float32))
    for l in range(DEPTH):
        last = l == DEPTH - 1
        nw = norm_w[l]
        mod_l = (jax.nn.silu(c) @ w_ada[l] + b_ada[l]).reshape(b_, 1, N_MOD, D_MODEL)
        mod_c = (jax.nn.silu(c_ctx) @ w_ada[l] + b_ada[l]).reshape(N_MOD, D_MODEL)

        xl = _ffn_sublayer(xl, mod_l, 0, nw[0], nw[1], w_ff_in[l, 0], w_ff_out[l, 0])
        xc = _ffn_sublayer(xc, mod_c, 0, nw[0], nw[1], w_ff_in[l, 0], w_ff_out[l, 0])

        sh_l, sc_l, g_l = _mod(mod_l, 1)
        sh_c, sc_c, g_c = _mod(mod_c, 1)
        ul = _pre(xl, nw[2], sh_l, sc_l) @ w_in[l]
        uc = _pre(xc, nw[2], sh_c, sc_c) @ w_in[l]
        xf_l, xm_l, z_l, gp_l = _split_proj(ul)
        xf_c, xm_c, z_c, gp_c = _split_proj(uc)

        cv_l = jax.nn.silu(grid_conv(xm_l, conv_w[l], conv_b[l]))
        cv_c = jax.nn.silu(seq_conv(xm_c, conv_w[l, 1], conv_b[l]))
        q_l, k_l, v_l, gates_l = _mlstm_inputs(xm_l, cv_l, gp_l, w_qkv[l], gate_b[l])
        q_c, k_c, v_c, gates_c = _mlstm_inputs(xm_c, cv_c, gp_c, w_qkv[l], gate_b[l])

        prev_cf, st_f = mlstm_states(k_c, v_c, gates_c[0], gates_c[1], zero)
        prev_cb, st_b = mlstm_states(_flip(k_c), _flip(v_c), _flip(gates_c[2]),
                                     _flip(gates_c[3]), zero)
        prev_lf, _ = mlstm_states(k_l, v_l, gates_l[0], gates_l[1], st_f)
        prev_lb, _ = mlstm_states(_flip(k_l), _flip(v_l), _flip(gates_l[2]),
                                  _flip(gates_l[3]), st_b)
        h_l = _bidir_outputs(q_l, k_l, v_l, gates_l, prev_lf, prev_lb)
        y_l = _combine(xf_l, h_l, z_l, w_fmix[l], mlstm_norm_w[l], w_out[l])
        xl = xl + g_l * rmsnorm(y_l, nw[3])
        xl = _ffn_sublayer(xl, mod_l, 2, nw[4], nw[5], w_ff_in[l, 1], w_ff_out[l, 1])

        if not last:
            h_c = _bidir_outputs(q_c, k_c, v_c, gates_c, prev_cf, prev_cb)
            y_c = _combine(xf_c, h_c, z_c, w_fmix[l], mlstm_norm_w[l], w_out[l])
            xc = xc + g_c * rmsnorm(y_c, nw[3])
            xc = _ffn_sublayer(xc, mod_c, 2, nw[4], nw[5], w_ff_in[l, 1], w_ff_out[l, 1])
    return xl
```

```cpp
#include <hip/hip_runtime.h>
#include <cstdio>
#include <cstdint>
namespace pg8 {
#define PG8_LAS __attribute__((address_space(3)))
typedef unsigned short bf16_t;
typedef short bf16x8 __attribute__((ext_vector_type(8)));
typedef float f32x4 __attribute__((ext_vector_type(4)));
typedef unsigned u32x4 __attribute__((ext_vector_type(4)));
constexpr int BM = 256, BK = 64, HALF = 128, HTB = HALF * BK * 2  , STAGE_BYTES = 8 * HTB, NXCD = 8, WGM = 8;

__host__ __device__ __forceinline__ int lds_byte(int r, int c) { const int st = (r >> 4) * 2 + (c >> 5), rr = r & 15, cc = c & 31, ob = rr * 64 + cc * 2; return st * 1024 + (ob ^ (((ob >> 9) & 1) << 5)); }
__host__ __device__ __forceinline__ void stage_rc(int b, int& R, int& C) { const int st = b / 1024, sb = b % 1024, swz = sb ^ (((sb >> 9) & 1) << 5); R = (st >> 1) * 16 + swz / 64; C = (st & 1) * 32 + (swz % 64) / 2; }
__host__ __device__ __forceinline__ int perm32(int rho) { const int n = rho >> 4, i = rho & 15; return 8 * (i >> 2) + 4 * n + (i & 3); }

struct Unit { int pm, pn, ks; };
struct Gemm { const bf16_t* A; const bf16_t* Bt; int M, N, K, Klen; int atm, btm; };

struct StaticOrder {
    int nM, nN, nwg, G, c, rev;
    __host__ __device__ void init(int M, int N, int G_, int c_, int rev_ = 0) { nM = M / BM; nN = N / BM; nwg = nM * nN; G = G_; c = c_; rev = rev_; }
    __host__ __device__ bool next(int i, Unit& u) const {
        const long L = (long)i * G + c; if (L >= nwg) return false;
        int wgid = (int)L; { const int q = nwg / NXCD, r = nwg % NXCD, xcd = wgid % NXCD, off = wgid / NXCD; wgid = (xcd < r ? xcd * (q + 1) : r * (q + 1) + (xcd - r) * q) + off; }
        const int nig = WGM * nN, gid = wgid / nig, fm = gid * WGM, gsz = (nM - fm) < WGM ? (nM - fm) : WGM;
        u.pm = fm + ((wgid % nig) % gsz); u.pn = (wgid % nig) / gsz; u.ks = 0; if (rev) u.pm = nM - 1 - u.pm; return true;
    }
    __device__ __forceinline__ void a_ready(const Unit&) const {}
    __device__ __forceinline__ void done(const Unit&) const {}
};

struct SplitKOrder {
    int pm0, nN, nS, nU, G, c;
    __host__ __device__ void init(int pm0_, int nP, int nN_, int nS_, int G_, int c_) { pm0 = pm0_; nN = nN_; nS = nS_; nU = nP * nN_ * nS_; G = G_; c = c_; }
    __host__ __device__ bool next(int i, Unit& u) const { const int L = i * G + c; if (L >= nU) return false; u.ks = L % nS; u.pn = (L / nS) % nN; u.pm = pm0 + L / (nS * nN); return true; }
    __device__ __forceinline__ void a_ready(const Unit&) const {}
    __device__ __forceinline__ void done(const Unit&) const {}
};

__device__ __forceinline__ unsigned cvt_pk_bf16(float lo, float hi) { unsigned r; asm volatile("v_cvt_pk_bf16_f32 %0, %1, %2" : "=v"(r) : "v"(lo), "v"(hi)); return r; }
typedef float f32x2 __attribute__((ext_vector_type(2)));
__device__ __forceinline__ float fast_sigmoid(float x) { return __builtin_amdgcn_rcpf(1.0f + __expf(-x)); }
struct EpiPlain {
    static constexpr bool PERM = true, AFTER_DRAIN = false;
    bf16_t* O; int ldo;
    __device__ __forceinline__ void operator()(const f32x4 (&acc)[2][2][4][2], const Unit& u, int wr, int wc, int fr, int fq) const {
        const int row0 = u.pm * BM + wr * 64 + fr, col0 = u.pn * BM + wc * 32 + 8 * fq;
#pragma unroll
        for (int ai = 0; ai < 2; ++ai)
#pragma unroll
            for (int m = 0; m < 4; ++m) { bf16_t* rowp = O + (size_t)(row0 + ai * HALF + m * 16) * ldo + col0;
#pragma unroll
                for (int bj = 0; bj < 2; ++bj) { const f32x4 v0 = acc[ai][bj][m][0], v1 = acc[ai][bj][m][1];
                    u32x4 w; w.x = cvt_pk_bf16(v0[0], v0[1]); w.y = cvt_pk_bf16(v0[2], v0[3]); w.z = cvt_pk_bf16(v1[0], v1[1]); w.w = cvt_pk_bf16(v1[2], v1[3]);
                    *(u32x4*)(rowp + bj * HALF) = w; } }
    }
};
struct EpiSwiGLU {
    static constexpr bool PERM = true, AFTER_DRAIN = false;
    bf16_t* O; int ldo;
    __device__ __forceinline__ void operator()(const f32x4 (&acc)[2][2][4][2], const Unit& u, int wr, int wc, int fr, int fq) const {
        const int nkt = ldo / BK, kt = u.pn * 2 + (wc >> 1), c64 = (wc & 1) * 32 + 8 * fq;
        bf16_t* base = O + ((size_t)(u.pm * nkt + kt) * BM) * BK + c64;
#pragma unroll
        for (int ai = 0; ai < 2; ++ai)
#pragma unroll
            for (int m = 0; m < 4; ++m) { bf16_t* rowp = base + (size_t)(wr * 64 + fr + ai * HALF + m * 16) * BK;
                f32x4 a0, a1;
#pragma unroll
                for (int j = 0; j < 4; ++j) { const float g0 = acc[ai][0][m][0][j], g1 = acc[ai][0][m][1][j];
                    a0[j] = g0 * fast_sigmoid(g0) * acc[ai][1][m][0][j]; a1[j] = g1 * fast_sigmoid(g1) * acc[ai][1][m][1][j]; }
                u32x4 w; w.x = cvt_pk_bf16(a0[0], a0[1]); w.y = cvt_pk_bf16(a0[2], a0[3]); w.z = cvt_pk_bf16(a1[0], a1[1]); w.w = cvt_pk_bf16(a1[2], a1[3]);
                *(u32x4*)rowp = w; }
    }
};
struct EpiInProj {
    static constexpr bool PERM = true, AFTER_DRAIN = false;
    bf16_t* XF; bf16_t* XM; bf16_t* A4; float* GT;
    __device__ __forceinline__ void operator()(const f32x4 (&acc)[2][2][4][2], const Unit& u, int wr, int wc, int fr, int fq) const {
        const int row0 = u.pm * BM + wr * 64 + fr;
        if (u.pn < 6) {
            bf16_t* base; int ldo;
            if (u.pn < 2) { base = XF + u.pn * BM; ldo = 512; } else if (u.pn < 4) { base = XM + (u.pn - 2) * BM; ldo = 512; } else { base = A4 + 512 + (u.pn - 4) * BM; ldo = 1024; }
            const int col0 = wc * 32 + 8 * fq;
#pragma unroll
            for (int ai = 0; ai < 2; ++ai)
#pragma unroll
                for (int m = 0; m < 4; ++m) { bf16_t* rowp = base + (size_t)(row0 + ai * HALF + m * 16) * ldo + col0;
#pragma unroll
                    for (int bj = 0; bj < 2; ++bj) { const f32x4 v0 = acc[ai][bj][m][0], v1 = acc[ai][bj][m][1];
                        u32x4 w; w.x = cvt_pk_bf16(v0[0], v0[1]); w.y = cvt_pk_bf16(v0[2], v0[3]); w.z = cvt_pk_bf16(v1[0], v1[1]); w.w = cvt_pk_bf16(v1[2], v1[3]);
                        *(u32x4*)(rowp + bj * HALF) = w; } }
        } else if (wc == 0 && fq < 2) {
#pragma unroll
            for (int ai = 0; ai < 2; ++ai)
#pragma unroll
                for (int m = 0; m < 4; ++m) { float* rowp = GT + (size_t)(row0 + ai * HALF + m * 16) * 16 + 8 * fq;
                    *(f32x4*)rowp = acc[ai][0][m][0]; *(f32x4*)(rowp + 4) = acc[ai][0][m][1]; }
        }
    }
};
struct EpiSlab {
    static constexpr bool PERM = false, AFTER_DRAIN = false;
    float* S; int ldo; int pm0; size_t slab_stride;
    __device__ __forceinline__ void operator()(const f32x4 (&acc)[2][2][4][2], const Unit& u, int wr, int wc, int fr, int fq) const {
        float* base = S + (size_t)u.ks * slab_stride + (size_t)((u.pm - pm0) * BM) * ldo + u.pn * BM;
        unsigned off = (unsigned)((wr * 64 + fr) * ldo + wc * 32 + 4 * fq);
#pragma unroll
        for (int ai = 0; ai < 2; ++ai)
#pragma unroll
            for (int m = 0; m < 4; ++m) { float* rowp = base + off + (unsigned)((ai * HALF + m * 16) * ldo);
#pragma unroll
                for (int bj = 0; bj < 2; ++bj)
#pragma unroll
                    for (int n = 0; n < 2; ++n) *(f32x4*)(rowp + bj * HALF + n * 16) = acc[ai][bj][m][n];
                asm volatile("" ::: "memory"); }
    }
};
template <class Epi, class Sched, bool ALIGN_EPI = false, bool SP2 = false>
__device__ __forceinline__ void gemm_phase(PG8_LAS unsigned char* lds, const Gemm g, const Sched& S, const Epi& E, int tid_in) {
    int tid_ = tid_in; asm volatile("" : "+v"(tid_)); const int tid = tid_, wid = __builtin_amdgcn_readfirstlane(tid >> 6), lane = tid & 63, wr = wid >> 2, wc = wid & 3, fr = lane & 15, fq = lane >> 4;
    const int K = g.K, nt = g.Klen / BK;
    unsigned voffA[2], voffB[2];
#pragma unroll
    for (int i = 0; i < 2; ++i) { int R, C; stage_rc(tid * 16 + i * 8192, R, C); const int Rb = Epi::PERM ? ((R & ~31) + perm32(R & 31)) : R;
        voffA[i] = (unsigned)(R * (g.atm ? BK : K) + C) * 2u; voffB[i] = (unsigned)(Rb * (g.btm ? BK : K) + C) * 2u; }
    const size_t kstepA = g.atm ? (size_t)BM * BK * 2 : (size_t)(BK * 2), hstepA = g.atm ? (size_t)HALF * BK * 2 : (size_t)HALF * K * 2, tstepA = (size_t)BM * K * 2;
    const size_t kstepB = g.btm ? (size_t)BM * BK * 2 : (size_t)(BK * 2), hstepB = g.btm ? (size_t)HALF * BK * 2 : (size_t)HALF * K * 2, tstepB = (size_t)BM * K * 2;
    const unsigned ldsw = (unsigned)wid * 1024u;
    const int aoff = lds_byte(wr * 64 + fr, fq * 8), boff = lds_byte(wc * 32 + fr, fq * 8);
#define PG8_SA(b, h) (((b) * 2 + (h)) * HTB)
#define PG8_SB(b, h) ((4 + (b) * 2 + (h)) * HTB)
#define PG8_STAGE(bufoff, gbase, voff) do { _Pragma("unroll") for (int _i = 0; _i < 2; ++_i) \
        __builtin_amdgcn_global_load_lds((const unsigned*)((const char*)(gbase) + (voff)[_i]), (PG8_LAS unsigned*)(lds + (bufoff) + ldsw + _i * 8192), 16, 0, 0); } while (0)
#define PG8_LDA(dst, b, h) do { _Pragma("unroll") for (int m = 0; m < 4; ++m) _Pragma("unroll") for (int k = 0; k < 2; ++k) dst[m][k] = *(const PG8_LAS bf16x8*)(lds + PG8_SA(b, h) + aoff + m * 2048 + k * 1024); } while (0)
#define PG8_LDB(dst, b, h) do { _Pragma("unroll") for (int n = 0; n < 2; ++n) _Pragma("unroll") for (int k = 0; k < 2; ++k) dst[n][k] = *(const PG8_LAS bf16x8*)(lds + PG8_SB(b, h) + boff + n * 2048 + k * 1024); } while (0)
#define PG8_MMA(ai, bj, At, Bt) do { __builtin_amdgcn_s_setprio(1); _Pragma("unroll") for (int m = 0; m < 4; ++m) _Pragma("unroll") for (int n = 0; n < 2; ++n) _Pragma("unroll") for (int k = 0; k < 2; ++k) \
        acc[ai][bj][m][n] = __builtin_amdgcn_mfma_f32_16x16x32_bf16(Bt[n][k], At[m][k], acc[ai][bj][m][n], 0, 0, 0); __builtin_amdgcn_s_setprio(0); } while (0)
#define PG8_WAIT_V(n) asm volatile("s_waitcnt vmcnt(" #n ")" ::: "memory")
#define PG8_WAIT_L(n) asm volatile("s_waitcnt lgkmcnt(" #n ")" ::: "memory")
#define PG8_BAR __builtin_amdgcn_s_barrier()
#define PG8_SCHED __builtin_amdgcn_sched_barrier(0)
    Unit cur, nxt; int ui = 0;
    if (!S.next(0, cur)) return;
    f32x4 acc[2][2][4][2];
#pragma unroll
    for (int a = 0; a < 2; ++a)
#pragma unroll
        for (int b = 0; b < 2; ++b)
#pragma unroll
            for (int m = 0; m < 4; ++m)
#pragma unroll
                for (int n = 0; n < 2; ++n) acc[a][b][m][n] = (f32x4){0.f, 0.f, 0.f, 0.f};
    bf16x8 At[4][2], B0[2][2], B1[2][2];
    const size_t sstepA = (size_t)(g.Klen / BK) * kstepA, sstepB = (size_t)(g.Klen / BK) * kstepB;
    const char* cA = (const char*)g.A + (size_t)cur.pm * tstepA + (size_t)cur.ks * sstepA; const char* cB = (const char*)g.Bt + (size_t)cur.pn * tstepB + (size_t)cur.ks * sstepB;
    S.a_ready(cur);
    if constexpr (SP2) {
        PG8_STAGE(PG8_SB(0, 0), cB, voffB); PG8_STAGE(PG8_SB(0, 1), cB + hstepB, voffB); PG8_STAGE(PG8_SA(0, 0), cA, voffA); PG8_STAGE(PG8_SA(0, 1), cA + hstepA, voffA);
        if (wr == 1) PG8_BAR;
        PG8_WAIT_V(2); PG8_BAR;
        PG8_STAGE(PG8_SB(1, 0), cB + kstepB, voffB); PG8_STAGE(PG8_SA(1, 0), cA + kstepA, voffA); PG8_STAGE(PG8_SB(1, 1), cB + hstepB + kstepB, voffB);
        PG8_WAIT_V(6); PG8_BAR;
    } else {
        PG8_STAGE(PG8_SB(0, 0), cB, voffB); PG8_STAGE(PG8_SA(0, 0), cA, voffA); PG8_STAGE(PG8_SB(0, 1), cB + hstepB, voffB); PG8_STAGE(PG8_SA(0, 1), cA + hstepA, voffA);
        if (wr == 1) PG8_BAR;
        PG8_WAIT_V(4); PG8_BAR;
        PG8_STAGE(PG8_SB(1, 0), cB + kstepB, voffB); PG8_STAGE(PG8_SA(1, 0), cA + kstepA, voffA); PG8_STAGE(PG8_SB(1, 1), cB + hstepB + kstepB, voffB);
        PG8_WAIT_V(6); PG8_BAR;
    }
    for (;;) {
        const bool has_next = S.next(ui + 1, nxt);
        const char* nA = has_next ? (const char*)g.A + (size_t)nxt.pm * tstepA + (size_t)nxt.ks * sstepA : cA; const char* nB = has_next ? (const char*)g.Bt + (size_t)nxt.pn * tstepB + (size_t)nxt.ks * sstepB : cB;
        for (int t = 0; t < nt; t += 2) {
            const bool last = (t == nt - 2);
            const char* a1 = cA + (size_t)(t + 1) * kstepA;
            const char* a2 = last ? nA : cA + (size_t)(t + 2) * kstepA; const char* b2 = last ? nB : cB + (size_t)(t + 2) * kstepB;
            const char* a3 = a2 + kstepA; const char* b3 = b2 + kstepB;
            if (last && has_next) S.a_ready(nxt);
            if constexpr (SP2) {
            PG8_LDB(B0, 0, 0); PG8_LDB(B1, 0, 1); PG8_SCHED; PG8_LDA(At, 0, 0); PG8_STAGE(PG8_SA(1, 1), a1 + hstepA, voffA);
            PG8_WAIT_V(8); PG8_WAIT_L(0); PG8_BAR; PG8_MMA(0, 0, At, B0); PG8_MMA(0, 1, At, B1); PG8_BAR; PG8_SCHED;
            PG8_LDA(At, 0, 1); PG8_STAGE(PG8_SB(0, 0), b2, voffB); PG8_STAGE(PG8_SB(0, 1), b2 + hstepB, voffB); PG8_STAGE(PG8_SA(0, 0), a2, voffA);
            PG8_WAIT_V(8); PG8_WAIT_L(0); PG8_BAR; PG8_MMA(1, 0, At, B0); PG8_MMA(1, 1, At, B1); PG8_BAR; PG8_SCHED;
            PG8_LDB(B0, 1, 0); PG8_LDB(B1, 1, 1); PG8_SCHED; PG8_LDA(At, 1, 0); PG8_STAGE(PG8_SA(0, 1), a2 + hstepA, voffA);
            PG8_WAIT_V(8); PG8_WAIT_L(0); PG8_BAR; PG8_MMA(0, 0, At, B0); PG8_MMA(0, 1, At, B1); PG8_BAR; PG8_SCHED;
            PG8_LDA(At, 1, 1); PG8_STAGE(PG8_SB(1, 0), b3, voffB); PG8_STAGE(PG8_SB(1, 1), b3 + hstepB, voffB); PG8_STAGE(PG8_SA(1, 0), a3, voffA);
            PG8_WAIT_V(8); PG8_WAIT_L(0); PG8_BAR; PG8_MMA(1, 0, At, B0); PG8_MMA(1, 1, At, B1); PG8_BAR; PG8_SCHED;
            } else {
            PG8_LDB(B0, 0, 0); PG8_SCHED; PG8_LDA(At, 0, 0); PG8_STAGE(PG8_SA(1, 1), a1 + hstepA, voffA);
            PG8_WAIT_L(8); PG8_BAR; PG8_WAIT_L(0); PG8_MMA(0, 0, At, B0); PG8_BAR; PG8_SCHED;
            PG8_LDB(B1, 0, 1); PG8_STAGE(PG8_SB(0, 0), b2, voffB);
            PG8_BAR; PG8_WAIT_L(0); PG8_MMA(0, 1, At, B1); PG8_BAR;
            PG8_LDA(At, 0, 1); PG8_STAGE(PG8_SA(0, 0), a2, voffA);
            PG8_BAR; PG8_WAIT_L(0); PG8_MMA(1, 0, At, B0); PG8_BAR; PG8_SCHED;
            PG8_STAGE(PG8_SB(0, 1), b2 + hstepB, voffB);
            PG8_WAIT_V(6); PG8_BAR; PG8_MMA(1, 1, At, B1); PG8_BAR;
            PG8_LDB(B0, 1, 0); PG8_SCHED; PG8_LDA(At, 1, 0); PG8_STAGE(PG8_SA(0, 1), a2 + hstepA, voffA);
            PG8_WAIT_L(8); PG8_BAR; PG8_WAIT_L(0); PG8_MMA(0, 0, At, B0); PG8_BAR; PG8_SCHED;
            PG8_LDB(B1, 1, 1); PG8_STAGE(PG8_SB(1, 0), b3, voffB);
            PG8_BAR; PG8_WAIT_L(0); PG8_MMA(0, 1, At, B1); PG8_BAR;
            PG8_LDA(At, 1, 1); PG8_STAGE(PG8_SA(1, 0), a3, voffA);
            PG8_BAR; PG8_WAIT_L(0); PG8_MMA(1, 0, At, B0); PG8_BAR; PG8_SCHED;
            PG8_STAGE(PG8_SB(1, 1), b3 + hstepB, voffB);
            PG8_WAIT_V(6); PG8_BAR; PG8_MMA(1, 1, At, B1); PG8_BAR;
            }
        }
        if constexpr (ALIGN_EPI) { if (wr == 0) PG8_BAR; }
        if constexpr (!Epi::AFTER_DRAIN) { E(acc, cur, wr, wc, fr, fq); S.done(cur); }
        if (!has_next) break;
#pragma unroll
        for (int a = 0; a < 2; ++a)
#pragma unroll
            for (int b = 0; b < 2; ++b)
#pragma unroll
                for (int m = 0; m < 4; ++m)
#pragma unroll
                    for (int n = 0; n < 2; ++n) acc[a][b][m][n] = (f32x4){0.f, 0.f, 0.f, 0.f};
        cur = nxt; cA = nA; cB = nB; ++ui;
        if constexpr (ALIGN_EPI) { if (wr == 1) PG8_BAR; }
    }
    PG8_WAIT_V(0);
    if constexpr (!ALIGN_EPI) { if (wr == 0) PG8_BAR; }
    PG8_BAR;
    if constexpr (Epi::AFTER_DRAIN) { E.fused(acc, cur, wr, wc, fr, fq, lds, wid, lane); S.done(cur); }
#undef PG8_SA
#undef PG8_SB
#undef PG8_STAGE
#undef PG8_LDA
#undef PG8_LDB
#undef PG8_MMA
#undef PG8_WAIT_V
#undef PG8_WAIT_L
#undef PG8_BAR
#undef PG8_SCHED
}
}
constexpr int NWAVES = 8, NTHR = 512;
constexpr int DM = 1024, NB = 4, SEQ = 8192, DEPTH = 2, CTXL = 256, DFF = 2816, DINP = 1552, DIN_PAD = 1792;
constexpr int TL = NB * SEQ, TC = NB * CTXL, TT = TL + TC;
constexpr int NH = 4, HD = 128, NMOD = 9;
constexpr int NCG = TT / 128;
constexpr int NUID = NCG * NH;
constexpr float EPSN = 1e-6f;

constexpr size_t MiB = 1u << 20;
constexpr size_t WS_CTL = 0, CTL_ZERO_BYTES = 1 * MiB;
constexpr size_t WS_MOD = 1 * MiB;
constexpr size_t WS_TAB = 2 * MiB;
constexpr size_t WS_WQKV = 3 * MiB;
constexpr size_t WS_XC = 4 * MiB;
constexpr size_t WS_WFFIN = 8 * MiB;
constexpr size_t WS_WFFOUT = 52 * MiB;
constexpr size_t WS_WIN = 74 * MiB;
constexpr size_t WS_WOUT = 81 * MiB;
constexpr size_t WS_XB = 88 * MiB;
constexpr size_t WS_Y = 154 * MiB;
constexpr size_t WS_R = 220 * MiB;
constexpr size_t WS_ACT = WS_R;
constexpr size_t WS_Q = WS_R;
constexpr size_t WS_K = WS_R + 33 * MiB;
constexpr size_t WS_VT = WS_R + 66 * MiB;
constexpr size_t WS_CL = WS_R + 99 * MiB;
constexpr size_t WS_A4 = WS_R + 165 * MiB;
constexpr size_t WS_GT = WS_R + 264 * MiB;
constexpr size_t WS_GA = WS_R + 267 * MiB;
constexpr size_t WS_NL = WS_R + 270 * MiB;
constexpr size_t WS_SC = WS_R + 272 * MiB;
constexpr size_t WS_WC = WS_R + 273 * MiB;
constexpr size_t WS_END = WS_R + 274 * MiB;
constexpr size_t WS_SLAB2 = WS_R + 184 * MiB;
constexpr size_t WS_SLAB4 = WS_R;
static_assert(WS_ACT + (size_t)TT * DFF * 2 <= 512 * MiB && WS_END <= 512 * MiB, "d_ws map");
static_assert((size_t)TT * 1024 * 2 <= 99 * MiB && (size_t)2 * NUID * 32768 <= 66 * MiB && (size_t)TT * 512 * 2 <= 33 * MiB, "d_ws map 2");
constexpr int CW_BAR = 4096;
constexpr size_t TAB_W1 = 0;
constexpr size_t TAB_W2 = 65536;
constexpr size_t TAB_TW = 131072;
constexpr size_t TAB_PQF = 196608;
constexpr size_t TAB_PQ32 = 458752;

constexpr int LDS_BYTES = 163840;
constexpr int MISC_OFF = LDS_BYTES - 256;
constexpr int SCR_BYTES = MISC_OFF;

#define GAS __attribute__((address_space(1)))
#define LAS __attribute__((address_space(3)))
typedef unsigned short bf16;
typedef unsigned v4u __attribute__((ext_vector_type(4)));
typedef unsigned v2u __attribute__((ext_vector_type(2)));
typedef float f32x4 __attribute__((ext_vector_type(4)));
typedef float f32x2 __attribute__((ext_vector_type(2)));
typedef short bf16x8 __attribute__((ext_vector_type(8)));
typedef short s16x4 __attribute__((ext_vector_type(4)));
typedef GAS unsigned gu32;
#define RLX_AGENT __ATOMIC_RELAXED, __HIP_MEMORY_SCOPE_AGENT
#define LDS_WAIT() asm volatile("s_waitcnt lgkmcnt(0)" ::: "memory")
#define VM_WAIT() asm volatile("s_waitcnt vmcnt(0)" ::: "memory")
#define VM_DONE() __builtin_amdgcn_s_waitcnt(0x0F70)
__device__ __forceinline__ float bf2f(unsigned b) { return __builtin_bit_cast(float, b << 16); }
typedef __bf16 bf16x2_t __attribute__((ext_vector_type(2)));
__device__ __forceinline__ unsigned pk2(float lo, float hi) { const f32x2 v = {lo, hi}; const bf16x2_t b = __builtin_convertvector(v, bf16x2_t); return __builtin_bit_cast(unsigned, b); }
__device__ __forceinline__ float wave_sum(float v) {
#pragma unroll
    for (int o = 1; o < 64; o <<= 1) v += __shfl_xor(v, o);
    return v;
}
__device__ __forceinline__ f32x4 mfma16(bf16x8 a, bf16x8 b, f32x4 c) { return __builtin_amdgcn_mfma_f32_16x16x32_bf16(a, b, c, 0, 0, 0); }
__device__ __forceinline__ float logsigf(float x) { return fminf(x, 0.f) - log1pf(__expf(-fabsf(x))); }

#ifndef DUPMASK
#define DUPMASK 0
#endif
#define REP(bit) _Pragma("unroll 1") for (int rep_ = 0; rep_ < 1 + ((DUPMASK >> (bit)) & 1); ++rep_)
__device__ __forceinline__ void lds_barrier() { asm volatile("s_waitcnt lgkmcnt(0)" ::: "memory"); __builtin_amdgcn_s_barrier(); asm volatile("" ::: "memory"); }
#define XB_TMO      128
#define XB_XCNT(j)  (256  + 64 * (j))
#define XB_XSUB(j)  (1280 + 64 * (j))
#define XB_XGEN(j)  (2304 + 64 * (j))
#define XB_TOP      3328
#define XB_TOPGEN   3392
#define XCD_BAR_WORDS 3456
#define XB_SPIN_CAP (1u << 18)

__device__ __forceinline__ unsigned xb_ld(unsigned* p)              { return __hip_atomic_load(p, __ATOMIC_RELAXED, __HIP_MEMORY_SCOPE_AGENT); }
__device__ __forceinline__ unsigned xb_add(unsigned* p, unsigned v) { return __hip_atomic_fetch_add(p, v, __ATOMIC_RELAXED, __HIP_MEMORY_SCOPE_AGENT); }
__device__ __forceinline__ unsigned xb_xcc_id() { return (unsigned)__builtin_amdgcn_s_getreg((3 << 11) | 20) & 0xFu; }
#define XB_SPIN(cond, bar) do { unsigned _sp = 0; while (cond) { __builtin_amdgcn_s_sleep(1); \
    if ((++_sp & 255u) == 0u) { if (xb_ld(&(bar)[XB_TMO])) break; if (_sp > XB_SPIN_CAP) { atomicAdd(&(bar)[XB_TMO], 1u); break; } } } } while (0)

struct XcdBarrier {
    unsigned* bar; unsigned x;
    volatile LAS unsigned* st;
};

__device__ __forceinline__ XcdBarrier xcd_barrier_post(unsigned* bar, volatile LAS unsigned* st) {
    XcdBarrier b; b.bar = bar; b.x = xb_xcc_id(); b.st = st;
    if (threadIdx.x == 0) (void)xb_add(&bar[XB_XCNT(b.x)], 1u);
    return b;
}
__device__ __forceinline__ void xcd_barrier_complete(unsigned* bar, unsigned x, unsigned& nloc, unsigned& nx, const unsigned G) {
    unsigned sum, cnt, mine, sp = 0u;
    for (;;) {
        sum = 0u; cnt = 0u; mine = 0u;
#pragma unroll
        for (unsigned j = 0; j < 16; ++j) { const unsigned c = xb_ld(&bar[XB_XCNT(j)]); sum += c; cnt += (c > 0u) ? 1u : 0u; mine = (j == x) ? c : mine; }
        if (sum == G) break;
        __builtin_amdgcn_s_sleep(1);
        if ((++sp & 255u) == 0u) { if (xb_ld(&bar[XB_TMO])) break; if (sp > XB_SPIN_CAP) { atomicAdd(&bar[XB_TMO], 1u); break; } }
    }
    nloc = mine > 0u ? mine : 1u; nx = cnt > 0u ? cnt : 1u;
}

__device__ __attribute__((noinline)) void xcd_barrier(unsigned* bar_, unsigned x_, volatile LAS unsigned* st_, int tid_, unsigned G_) { XcdBarrier b; b.bar = bar_; b.x = x_; b.st = st_;
    asm volatile("s_waitcnt vmcnt(0)" ::: "memory");
    __syncthreads();
    if (tid_ == 0) {
        unsigned* bar = b.bar;
        __builtin_amdgcn_s_waitcnt(0);
        unsigned nloc = b.st[0], nx = b.st[1];
        if (nloc == 0u) { xcd_barrier_complete(bar, b.x, nloc, nx, G_); b.st[0] = nloc; b.st[1] = nx; }
        const unsigned old = xb_add(&bar[XB_XSUB(b.x)], 1u);
        const unsigned gen = old / nloc;
        if (old + 1u == (gen + 1u) * nloc) {
            __builtin_amdgcn_fence(__ATOMIC_RELEASE, "agent");
            asm volatile("s_waitcnt vmcnt(0)" ::: "memory");
            const unsigned og = xb_add(&bar[XB_TOP], 1u);
            const unsigned tg = og / nx;
            if (og + 1u == (tg + 1u) * nx) xb_add(&bar[XB_TOPGEN], 1u);
            else XB_SPIN(xb_ld(&bar[XB_TOPGEN]) == tg, bar);
            __builtin_amdgcn_fence(__ATOMIC_ACQUIRE, "agent");
            xb_add(&bar[XB_XGEN(b.x)], 1u);
            asm volatile("s_waitcnt vmcnt(0)" ::: "memory");
        } else {
            XB_SPIN(xb_ld(&bar[XB_XGEN(b.x)]) == gen, bar);
            __builtin_amdgcn_fence(__ATOMIC_ACQUIRE, "agent");
            asm volatile("s_waitcnt vmcnt(0)" ::: "memory");
        }
    }
    __syncthreads();
}
struct Frame {
    LAS unsigned char* lds;
    volatile LAS unsigned* MISC;
    gu32* ctl;
    int tid, lane, wave;
    int vcu, G, bid;
    unsigned char* ws;
};
constexpr int PTAB_OFF = MISC_OFF + 64;
__device__ __forceinline__ unsigned long long ptab(const Frame& F, int i) { const LAS unsigned* p = (const LAS unsigned*)(F.lds + PTAB_OFF) + 2 * i;
    const unsigned lo = __builtin_amdgcn_readfirstlane(p[0]), hi = __builtin_amdgcn_readfirstlane(p[1]); return ((unsigned long long)hi << 32) | lo; }
#define FIN(i) ((const float*)(const GAS float*)ptab(F, (i)))
#define FOUT ((float*)(GAS float*)ptab(F, 17))
enum { I_X = 0, I_C, I_CTX, I_CCTX, I_WADA, I_BADA, I_NORMW, I_WFFIN, I_WFFOUT, I_WIN, I_WFMIX, I_CONVW, I_CONVB, I_WQKV, I_GATEB, I_HNW, I_WOUT };
#define WSP(T, off) ((T*)(F.ws + (off)))

__device__ __forceinline__ void p0_transpose_item(const float* W, int ldn, int nvalid, int k0, int n0, bf16* WT, int ldw, int drow, int dcol, float scale, LAS float* scr, int lane, int tm = 0) {
    const int c4 = (lane & 7) * 4; const bool ok = (n0 + c4) < nvalid;
#pragma unroll
    for (int i = 0; i < 8; ++i) { const int kk = 8 * i + (lane >> 3); const f32x4 v = ok ? *(const f32x4*)(W + (size_t)(k0 + kk) * ldn + n0 + c4) * scale : (f32x4){0.f, 0.f, 0.f, 0.f};
        LAS float* d = scr + kk * 33 + c4; d[0] = v[0]; d[1] = v[1]; d[2] = v[2]; d[3] = v[3]; }
    LDS_WAIT(); asm volatile("" ::: "memory");
    const int c = lane & 7;
#pragma unroll
    for (int j = 0; j < 4; ++j) { const int n = (lane >> 3) + 8 * j; const LAS float* s = scr + (8 * c) * 33 + n;
        v4u o; o.x = pk2(s[0 * 33], s[1 * 33]); o.y = pk2(s[2 * 33], s[3 * 33]); o.z = pk2(s[4 * 33], s[5 * 33]); o.w = pk2(s[6 * 33], s[7 * 33]);
        const int rr = drow + n, kk0 = dcol + k0;
        if (tm) *(v4u*)(WT + (((size_t)(rr >> 8) * (ldw >> 6) + (kk0 >> 6)) * 256 + (rr & 255)) * 64 + (kk0 & 63) + 8 * c) = o;
        else *(v4u*)(WT + (size_t)rr * ldw + kk0 + 8 * c) = o; }
    LDS_WAIT(); asm volatile("" ::: "memory");
}

__device__ __forceinline__ void mod_first(Frame& F) {
    const int ncol = 2048 / F.G;
    if (ncol != 8) return;
    const int c0 = 8 * F.vcu, kc = F.tid >> 1, q = F.tid & 1;
    const float* cin = FIN(I_C); const float* cctx = FIN(I_CCTX); const float* wada = FIN(I_WADA);
    f32x4 a[5];
#pragma unroll
    for (int bi = 0; bi < 5; ++bi) a[bi] = (f32x4){0.f, 0.f, 0.f, 0.f};
#pragma unroll
    for (int kk = 0; kk < 4; ++kk) { const int k = 4 * kc + kk; const f32x4 w = *(const f32x4*)(wada + (size_t)k * (NMOD * DM) + c0 + 4 * q);
#pragma unroll
        for (int bi = 0; bi < 5; ++bi) { const float v = (bi < 4) ? cin[bi * DM + k] : cctx[k]; a[bi] += w * (v / (1.f + __expf(-v))); } }
    LAS f32x4* red = (LAS f32x4*)F.lds;
#pragma unroll
    for (int bi = 0; bi < 5; ++bi) red[(kc * 2 + q) * 5 + bi] = a[bi];
    __syncthreads();
    if (F.tid < 40) { const int bi = F.tid >> 3, col = F.tid & 7; float s = FIN(I_BADA)[c0 + col];
        for (int k2 = 0; k2 < 256; ++k2) s += red[(k2 * 2 + (col >> 2)) * 5 + bi][col & 3];
        WSP(float, WS_MOD)[(size_t)bi * (NMOD * DM) + c0 + col] = s; }
    __syncthreads();
}
__device__ __forceinline__ void p0_prologue(Frame& F, const int stage, const int wgi, const int NWG) {
    const int gw = wgi * NWAVES + F.wave, NGW = NWG * NWAVES;
    const float* const p_w_ff_in = FIN(I_WFFIN); const float* const p_w_ff_out = FIN(I_WFFOUT); const float* const p_w_in = FIN(I_WIN); const float* const p_w_out = FIN(I_WOUT); const float* const p_w_qkv = FIN(I_WQKV);
    {
        LAS float* scr = (LAS float*)(F.lds + F.wave * 16384);
        constexpr int I_FI = (DM / 64) * (2 * DFF / 32);
        constexpr int I_FO = (DFF / 64) * (DM / 32);
        constexpr int I_IN = (DM / 64) * 49;
        constexpr int I_WO = (DM / 64) * (DM / 32);
        constexpr int I_QK = 12 * 2 * 4;
        constexpr int I_ZR = 224 / 4;
        constexpr int PER_L = 2 * I_FI + 2 * I_FO + I_IN + I_WO + I_QK + I_ZR;
        const int r_lo = (stage == 1) ? I_FI : 0, r_hi = (stage == 0) ? I_FI : (stage == 3 ? DEPTH * PER_L : PER_L);
        REP(22) for (int it = gw; it < r_hi - r_lo; it += NGW) {
            const int l = (stage == 3) ? (r_lo + it) / PER_L : ((stage == 2) ? 1 : 0); int r = (r_lo + it) % PER_L;
            if (r < 2 * I_FI) { const int f = r / I_FI; r %= I_FI; const int nb = r % 176, kb = r / 176; const int n0 = nb * 32;
                const int drow = (n0 < DFF) ? (256 * (n0 >> 7) + (n0 & 127)) : (256 * ((n0 - DFF) >> 7) + 128 + ((n0 - DFF) & 127));
                p0_transpose_item(p_w_ff_in + (size_t)(l * 2 + f) * DM * 2 * DFF, 2 * DFF, 2 * DFF, kb * 64, n0, WSP(bf16, WS_WFFIN) + (size_t)(l * 2 + f) * 2 * DFF * DM, DM, drow, 0, 1.f, scr, F.lane); continue; }
            r -= 2 * I_FI;
            if (r < 2 * I_FO) { const int f = r / I_FO; r %= I_FO; const int nb = r % 32, kb = r / 32;
                p0_transpose_item(p_w_ff_out + (size_t)(l * 2 + f) * DFF * DM, DM, DM, kb * 64, nb * 32, WSP(bf16, WS_WFFOUT) + (size_t)(l * 2 + f) * DM * DFF, DFF, nb * 32, 0, 1.f, scr, F.lane, 1); continue; }
            r -= 2 * I_FO;
            if (r < I_IN) { const int nb = r % 49, kb = r / 49;
                p0_transpose_item(p_w_in + (size_t)l * DM * DINP, DINP, DINP, kb * 64, nb * 32, WSP(bf16, WS_WIN) + (size_t)l * DIN_PAD * DM, DM, nb * 32, 0, 1.f, scr, F.lane); continue; }
            r -= I_IN;
            if (r < I_WO) { const int nb = r % 32, kb = r / 32;
                p0_transpose_item(p_w_out + (size_t)l * DM * DM, DM, DM, kb * 64, nb * 32, WSP(bf16, WS_WOUT) + (size_t)l * DM * DM, DM, nb * 32, 0, 1.f, scr, F.lane); continue; }
            r -= I_WO;
            if (r < I_QK) { const int mat = r / 8, q = r % 8, nb = q % 4, kb = q / 4;
                p0_transpose_item(p_w_qkv + ((size_t)l * 12 + mat) * HD * HD, HD, HD, kb * 64, nb * 32, WSP(bf16, WS_WQKV) + ((size_t)l * 12 + mat) * HD * HD, HD, nb * 32, 0, (mat / 4 == 1) ? 0.08838834764831845f : 1.f, scr, F.lane); continue; }
            r -= I_QK;
            { bf16* z = WSP(bf16, WS_WIN) + (size_t)l * DIN_PAD * DM + (size_t)(1568 + 4 * r) * DM;
#pragma unroll
              for (int j = 0; j < 8; ++j) *(v4u*)(z + (size_t)(j * 64 + F.lane) * 8) = (v4u){0u, 0u, 0u, 0u}; }
        }
    }
    __syncthreads();
    constexpr int I_MOD = DEPTH * (NMOD * DM / 64);
    constexpr int I_FW = DEPTH * 8;
    constexpr int I_TB = 112 + 256;
    const int b_lo = (stage == 0 || stage == 3) ? 0 : (stage == 1 ? I_MOD : I_MOD + I_FW / 2), b_hi = (stage == 0) ? I_MOD : (stage == 1 ? I_MOD + I_FW / 2 : I_MOD + I_FW);
    REP(23) for (int it0 = wgi; it0 < b_hi - b_lo + ((stage == 1 || stage == 3) ? I_TB : 0); it0 += NWG) {
        const int it = (b_lo + it0 < b_hi) ? b_lo + it0 : I_MOD + I_FW + (b_lo + it0 - b_hi);
        if (it < I_MOD) {
            if (it < 32 && F.G == 256) continue;
            const int l = it / 144, j0 = (it % 144) * 64;
            LAS float* sc = (LAS float*)F.lds;
            LAS float* red = (LAS float*)(F.lds + 20480);
            for (int i = F.tid; i < 5 * DM; i += NTHR) { const int bi = i >> 10, k = i & 1023; const float v = (bi < 4) ? FIN(I_C)[bi * DM + k] : FIN(I_CCTX)[k]; sc[i] = v / (1.f + __expf(-v)); }
            __syncthreads();
            const int q = F.tid & 15, kc = F.tid >> 4;
            f32x4 a[5];
#pragma unroll
            for (int bi = 0; bi < 5; ++bi) a[bi] = (f32x4){0.f, 0.f, 0.f, 0.f};
            const float* wp = FIN(I_WADA) + (size_t)l * DM * NMOD * DM + (size_t)(kc * 32) * (NMOD * DM) + j0 + 4 * q;
#pragma unroll 16
            for (int k = 0; k < 32; ++k) { const f32x4 w = *(const f32x4*)(wp + (size_t)k * (NMOD * DM));
#pragma unroll
                for (int bi = 0; bi < 5; ++bi) a[bi] += w * sc[bi * DM + kc * 32 + k]; }
#pragma unroll
            for (int bi = 0; bi < 5; ++bi) *(LAS f32x4*)(red + (kc * 5 + bi) * 64 + 4 * q) = a[bi];
            __syncthreads();
            if (F.tid < 320) { const int bi = F.tid >> 6, col = F.tid & 63; float s = FIN(I_BADA)[l * NMOD * DM + j0 + col];
                for (int k2 = 0; k2 < 32; ++k2) s += red[(k2 * 5 + bi) * 64 + col];
                WSP(float, WS_MOD)[((size_t)l * 5 + bi) * (NMOD * DM) + j0 + col] = s; }
            __syncthreads();
        } else if (it < I_MOD + I_FW) {
            const int r = it - I_MOD, g = r & 7, l = r >> 3;
            LAS float* tab = (LAS float*)F.lds;
            LAS float* FM = (LAS float*)(F.lds + 1024);
            LAS float* PQ = (LAS float*)(F.lds + 1024 + 16384);
            if (F.tid < 64) { float sv, cv; sincospif((float)F.tid * (1.f / 32.f), &sv, &cv); tab[F.tid] = 0.125f * cv; tab[64 + F.tid] = -0.125f * sv; }
            for (int i = F.tid; i < 4096; i += NTHR) FM[i] = FIN(I_WFMIX)[((size_t)l * 8 + g) * 4096 + i];
            __syncthreads();
            { const int d4 = (F.tid & 15) * 4, c0 = F.tid >> 4;
              f32x4 s0 = {0.f, 0.f, 0.f, 0.f}, s1 = s0, t0 = s0, t1 = s0;
#pragma unroll 8
              for (int e = 0; e < 64; ++e) { const f32x4 fm = *(const LAS f32x4*)(FM + e * 64 + d4); const int m0 = (c0 * e) & 63, m1 = ((c0 + 32) * e) & 63;
                  s0 += fm * tab[m0]; s1 += fm * tab[m1]; t0 += fm * tab[64 + m0]; t1 += fm * tab[64 + m1]; }
              *(LAS f32x4*)(PQ + c0 * 64 + d4) = s0; *(LAS f32x4*)(PQ + (c0 + 32) * 64 + d4) = s1; *(LAS f32x4*)(PQ + 4096 + c0 * 64 + d4) = t0; *(LAS f32x4*)(PQ + 4096 + (c0 + 32) * 64 + d4) = t1; }
            __syncthreads();
            { float* o32 = (float*)(F.ws + WS_TAB + TAB_PQ32) + ((size_t)l * 8 + g) * 8192;
              for (int i = F.tid; i < 8192; i += NTHR) o32[i] = PQ[i];
              bf16* of = (bf16*)(F.ws + WS_TAB + TAB_PQF) + ((size_t)l * 8 + g) * 8192;
              for (int i = F.tid; i < 8192; i += NTHR) { const int e = i & 7, ln = (i >> 3) & 63, ks = (i >> 9) & 3, nd = i >> 11;
                  const int d = 16 * nd + (ln & 15), c = 32 * (ks & 1) + 16 * (e >> 2) + 4 * (ln >> 4) + (e & 3);
                  of[i] = (bf16)(pk2(PQ[(ks >> 1) * 4096 + c * 64 + d], 0.f) & 0xffffu); } }
            __syncthreads();
        } else {
            const int ti = it - I_MOD - I_FW;
            if (ti < 64) {
                bf16* o = (bf16*)(F.ws + WS_TAB + TAB_W1);
                { const int i = ti * NTHR + F.tid; const int e = i & 7, ln = (i >> 3) & 63, t = (i >> 9) & 3, tl = (i >> 11) & 1, w = i >> 12;
                    const int g = ln >> 4, k1 = 16 * w + (ln & 15), s1 = 32 * t + 16 * (g >> 1) + 8 * (e >> 2) + 4 * (g & 1) + (e & 3);
                    float sv, cv; sincospif((float)((k1 * s1) & 127) * (1.f / 64.f), &sv, &cv);
                    o[i] = (bf16)(pk2(tl ? sv : cv, 0.f) & 0xffffu); }
            } else if (ti < 96) {
                bf16* o = (bf16*)(F.ws + WS_TAB + TAB_W2);
                { const int i = (ti - 64) * NTHR + F.tid; const int e = i & 7, ln = (i >> 3) & 63, t = (i >> 9) & 3, w = i >> 11;
                    const int g = ln >> 4, k2 = 16 * (w & 3) + (ln & 15), sp = 32 * t + 16 * (g >> 1) + 8 * (e >> 2) + 4 * (g & 1) + (e & 3), s2 = sp & 63, inim = sp >> 6, outim = w >> 2;
                    float sv, cv; sincospif((float)((k2 * s2) & 63) * (1.f / 32.f), &sv, &cv);
                    const float v = outim ? (inim ? cv : sv) : (inim ? -sv : cv);
                    o[i] = (bf16)(pk2(v, 0.f) & 0xffffu); }
            } else if (ti >= 112) {
                bf16* o = (bf16*)(F.ws + WS_WC);
                { const int i = (ti - 112) * NTHR + F.tid; const int e = i & 7, ln = (i >> 3) & 63, t = (i >> 9) & 7, tl = (i >> 12) & 1, w = i >> 13;
                    const int g = ln >> 4, k = 16 * w + (ln & 15), sp = 32 * t + 16 * (g >> 1) + 8 * (e >> 2) + 4 * (g & 1) + (e & 3);
                    float sv, cv; sincospif((float)((k * sp) & 255) * (1.f / 128.f), &sv, &cv);
                    o[i] = (bf16)(pk2(0.0625f * (tl ? sv : cv), 0.f) & 0xffffu); }
            } else {
                f32x2* o = (f32x2*)(F.ws + WS_TAB + TAB_TW);
                { const int i = (ti - 96) * NTHR + F.tid; const int s2 = i & 63, k1 = i >> 6; float sv, cv; sincospif((float)(k1 * s2) * (1.f / 4096.f), &sv, &cv);
                    o[i] = (f32x2){cv * 0.011048543456039806f, sv * 0.011048543456039806f}; }
            }
        }
    }
}

struct Thin {
    const void* xin_l; const float* xin_c;
    void* xout_l; float* xout_c;
    const bf16* Y;
    const float* YS;
    const float* nw_post; const float* gate;
    bf16* H; const float* nw_pre; const float* scale; const float* shift;
    float fac; int nslab; int nrows; int xin_bf, xout_bf;
};
#ifdef DBG_FLAGS
#define DBG_FLAG(bit) __hip_atomic_fetch_or((unsigned*)(F.ctl + 64), 1u << (bit), __ATOMIC_RELAXED, __HIP_MEMORY_SCOPE_AGENT)
#else
#define DBG_FLAG(bit) do {} while (0)
#endif
#ifdef DBG_FLAGS
#define DBG_CHK(val, bit) do { if (!(fabsf(val) < 1e30f)) DBG_FLAG(bit); } while (0)
#else
#define DBG_CHK(val, bit) do {} while (0)
#endif
__device__ __forceinline__ void thin_finish(Frame& F, const Thin& P, const int r, f32x4 (&x)[4], const f32x4 (&y)[4], const f32x4 (&A1)[4], const f32x4 (&A2)[4], const f32x4 (&A3)[4], const bool dry) {
    if (P.Y) { float ss = 0.f;
#pragma unroll
        for (int j = 0; j < 4; ++j) ss += (y[j].x * y[j].x + y[j].y * y[j].y) + (y[j].z * y[j].z + y[j].w * y[j].w);
        const float rs = 1.0f / sqrtf(wave_sum(ss) * (1.f / DM) + EPSN);
#pragma unroll
        for (int j = 0; j < 4; ++j) x[j] += A1[j] * (y[j] * rs); }
    if (r < TL) { if (P.xout_l) { if (P.xout_bf) { bf16* xo = (dry ? WSP(bf16, WS_ACT) : (bf16*)P.xout_l) + (size_t)r * DM;
#pragma unroll
                for (int j = 0; j < 4; ++j) { v2u w; w.x = pk2(x[j].x, x[j].y); w.y = pk2(x[j].z, x[j].w); *(v2u*)(xo + 4 * F.lane + 256 * j) = w; } }
            else { float* xo = (dry ? WSP(float, WS_ACT) : (float*)P.xout_l) + (size_t)r * DM;
#pragma unroll
                for (int j = 0; j < 4; ++j) *(f32x4*)(xo + 4 * F.lane + 256 * j) = x[j]; } } }
    else if (P.xout_c) { float* xo = (dry ? WSP(float, WS_ACT) + (size_t)TL * DM : P.xout_c) + (size_t)(r - TL) * DM;
#pragma unroll
        for (int j = 0; j < 4; ++j) *(f32x4*)(xo + 4 * F.lane + 256 * j) = x[j]; }
    if (P.H) { float ss = 0.f;
#pragma unroll
        for (int j = 0; j < 4; ++j) ss += (x[j].x * x[j].x + x[j].y * x[j].y) + (x[j].z * x[j].z + x[j].w * x[j].w);
        const float rs = 1.0f / sqrtf(wave_sum(ss) * (1.f / DM) + EPSN);
        bf16* hr = P.H + (size_t)r * DM;
#pragma unroll
        for (int j = 0; j < 4; ++j) { const f32x4 h = x[j] * rs * A2[j] + A3[j]; v2u w; w.x = pk2(h.x, h.y); w.y = pk2(h.z, h.w); *(v2u*)(hr + 4 * F.lane + 256 * j) = w; } }
}
__device__ __forceinline__ void thin_vectors(Frame& F, const Thin& P, const int bi, f32x4 (&A1)[4], f32x4 (&A2)[4], f32x4 (&A3)[4]) {
#pragma unroll
    for (int j = 0; j < 4; ++j) { const int col = 4 * F.lane + 256 * j;
        if (P.Y) A1[j] = *(const f32x4*)(P.gate + (size_t)bi * (NMOD * DM) + col) * *(const f32x4*)(P.nw_post + col) * P.fac;
        if (P.H) { A2[j] = *(const f32x4*)(P.nw_pre + col) * (*(const f32x4*)(P.scale + (size_t)bi * (NMOD * DM) + col) + 1.0f); A3[j] = *(const f32x4*)(P.shift + (size_t)bi * (NMOD * DM) + col); } }
}
__device__ __forceinline__ f32x4 bf4(v2u w) { return (f32x4){bf2f(w.x & 0xffffu), bf2f(w.x >> 16), bf2f(w.y & 0xffffu), bf2f(w.y >> 16)}; }
__device__ __forceinline__ void thin_phase(Frame& F, const Thin& P, int dbg_idx = 99, bool dry = false) {
    const int gw = F.vcu * NWAVES + F.wave, NGW = F.G * NWAVES;
    const int nlat = (P.nrows < TL) ? P.nrows : TL;
    const bool has_ctx = P.nrows > TL;
    const int CTXW = (P.nslab > 0) ? 4 : 1;
    int r0, r1;
    if (!has_ctx || NGW != 2048) { const int per = (nlat + NGW - 1) / NGW; r0 = gw * per; r1 = (r0 + per < nlat) ? r0 + per : nlat; }
    else { const int a = 16 - CTXW / 2, b = 16 + CTXW / 2;
        if (gw < 1024) { r0 = gw * a; r1 = r0 + a; } else { r0 = 1024 * a + (gw - 1024) * b; r1 = r0 + b; } }
    int cur = -1;
    f32x4 A1[4], A2[4], A3[4];
    v2u xbA[4], ybA[4], xbB[4], ybB[4]; f32x4 xfA[4], xfB[4];
    unsigned sh16, mhi, mall;
#define TH_LD(XB_, XF_, YB_, r_) do { const int rr_ = (r_); if (P.xin_bf) { const bf16* xr_ = (const bf16*)P.xin_l + (size_t)rr_ * DM + 4 * F.lane; _Pragma("unroll") for (int j = 0; j < 4; ++j) asm volatile("global_load_dwordx2 %0, %1, off" : "=v"(XB_[j]) : "v"(xr_ + 256 * j) : "memory"); } \
        else { const float* xr_ = (const float*)P.xin_l + (size_t)rr_ * DM + 4 * F.lane; _Pragma("unroll") for (int j = 0; j < 4; ++j) asm volatile("global_load_dwordx4 %0, %1, off" : "=v"(XF_[j]) : "v"(xr_ + 256 * j) : "memory"); } \
        if (P.Y) { const bf16* yr_ = P.Y + (size_t)rr_ * DM + 4 * F.lane; _Pragma("unroll") for (int j = 0; j < 4; ++j) asm volatile("global_load_dwordx2 %0, %1, off" : "=v"(YB_[j]) : "v"(yr_ + 256 * j) : "memory"); } } while (0)
#define TH_WAIT(n_) asm volatile("s_waitcnt vmcnt(" #n_ ")\n\ts_mov_b32 %0, 16\n\ts_mov_b32 %1, 0xffff0000\n\ts_mov_b32 %2, -1" : "=s"(sh16), "=s"(mhi), "=s"(mall) :: "memory")
#define TH_UNPK(w_) ((f32x4){__builtin_bit_cast(float, (w_).x << sh16), __builtin_bit_cast(float, (w_).x & mhi), __builtin_bit_cast(float, (w_).y << sh16), __builtin_bit_cast(float, (w_).y & mhi)})
#define TH_ROW(XB_, XF_, YB_, NXB_, NXF_, NYB_) do { \
        if (P.H) TH_WAIT(8); else TH_WAIT(4); \
        if (r + 1 < r1) TH_LD(NXB_, NXF_, NYB_, r + 1); \
        f32x4 x[4], y[4]; \
        _Pragma("unroll") for (int j = 0; j < 4; ++j) { \
            if (P.xin_bf) x[j] = TH_UNPK(XB_[j]); else { const v4u b_ = __builtin_bit_cast(v4u, XF_[j]); x[j] = __builtin_bit_cast(f32x4, (v4u){b_.x & mall, b_.y & mall, b_.z & mall, b_.w & mall}); } \
            if (P.Y) y[j] = TH_UNPK(YB_[j]); else y[j] = (f32x4){0.f, 0.f, 0.f, 0.f}; } \
        const int bi = r >> 13; \
        if (bi != cur) { cur = bi; thin_vectors(F, P, bi, A1, A2, A3); VM_DONE(); } \
        thin_finish(F, P, r, x, y, A1, A2, A3, dry); } while (0)
    if (r0 < r1) { TH_LD(xbA, xfA, ybA, r0); asm volatile("s_waitcnt vmcnt(0)" ::: "memory"); }
    for (int r = r0; r < r1; ++r) {
        TH_ROW(xbA, xfA, ybA, xbB, xfB, ybB);
        ++r; if (r >= r1) break;
        TH_ROW(xbB, xfB, ybB, xbA, xfA, ybA);
    }
#undef TH_LD
#undef TH_WAIT
#undef TH_UNPK
#undef TH_ROW
    if (has_ctx && gw < TC) { const int r = TL + gw;
        thin_vectors(F, P, 4, A1, A2, A3);
        f32x4 x[4], y[4]; const float* xr = P.xin_c + (size_t)gw * DM;
#pragma unroll
        for (int j = 0; j < 4; ++j) { x[j] = *(const f32x4*)(xr + 4 * F.lane + 256 * j); y[j] = (f32x4){0.f, 0.f, 0.f, 0.f}; }
        if (P.Y) { if (P.nslab > 0) {
#pragma unroll 4
                for (int ks = 0; ks < P.nslab; ++ks) { const float* sr = P.YS + ((size_t)ks * TC + gw) * DM;
#pragma unroll
                    for (int j = 0; j < 4; ++j) y[j] += *(const f32x4*)(sr + 4 * F.lane + 256 * j); } }
            else { const bf16* yr = P.Y + (size_t)r * DM;
#pragma unroll
                for (int j = 0; j < 4; ++j) y[j] = bf4(*(const v2u*)(yr + 4 * F.lane + 256 * j)); } }
        thin_finish(F, P, r, x, y, A1, A2, A3, dry);
    }
}
constexpr int RS = 272;
constexpr int TILE_B = 128 * RS;
__device__ __forceinline__ int cg_row0(int cg) { return cg * 128; }
__device__ __forceinline__ bf16x8 lds_frag(const LAS unsigned char* p) { return *(const LAS bf16x8*)p; }
__device__ __forceinline__ bf16x8 glb_frag(const bf16* p) { return *(const bf16x8*)p; }
__device__ __forceinline__ void st4bf(bf16* p, f32x4 v) { v2u w; w.x = pk2(v[0], v[1]); w.y = pk2(v[2], v[3]); *(v2u*)p = w; }
__device__ __forceinline__ void st4bf_lds(LAS unsigned char* p, f32x4 v) { v2u w; w.x = pk2(v[0], v[1]); w.y = pk2(v[2], v[3]); *(LAS v2u*)p = w; }

__device__ __forceinline__ float wscan_add_up(float v, int lane) {
#pragma unroll
    for (int o = 1; o < 64; o <<= 1) { const float t = __shfl_up(v, o); if (lane >= o) v += t; }
    return v; }
__device__ __forceinline__ float wscan_add_down(float v, int lane) {
#pragma unroll
    for (int o = 1; o < 64; o <<= 1) { const float t = __shfl_down(v, o); if (lane + o < 64) v += t; }
    return v; }
__device__ __forceinline__ float wscan_max_up(float v, int lane) {
#pragma unroll
    for (int o = 1; o < 64; o <<= 1) { const float t = __shfl_up(v, o); if (lane >= o) v = fmaxf(v, t); }
    return v; }
__device__ __forceinline__ float wscan_max_down(float v, int lane) {
#pragma unroll
    for (int o = 1; o < 64; o <<= 1) { const float t = __shfl_down(v, o); if (lane + o < 64) v = fmaxf(v, t); }
    return v; }
__device__ __forceinline__ float wave_max(float v) {
#pragma unroll
    for (int o = 1; o < 64; o <<= 1) v = fmaxf(v, __shfl_xor(v, o));
    return v; }

__device__ __forceinline__ void m1_phase(Frame& F, int l) {
    LAS unsigned char* HALO = F.lds;
    LAS unsigned char* XM = HALO + 64 * RS;
    LAS unsigned char* CV = F.lds + 2 * TILE_B;
    LAS unsigned char* VT = F.lds + 3 * TILE_B;
#define KT_ROW(dk_) (HALO + ((dk_) + (((dk_) & 64) << 1)) * RS)
    LAS float* FL = (LAS float*)(F.lds + 4 * TILE_B);
    const bf16* UXM = WSP(bf16, WS_Y) + (size_t)TT * 512;
    const float* GT = WSP(float, WS_GT);
    bf16* Qg = WSP(bf16, WS_Q); bf16* Kg = WSP(bf16, WS_K); bf16* VTg = WSP(bf16, WS_VT); bf16* CLg = WSP(bf16, WS_CL);
    float* GA = WSP(float, WS_GA); float* NL = WSP(float, WS_NL); float* SC = WSP(float, WS_SC);
    const bf16* WQ = WSP(bf16, WS_WQKV) + (size_t)l * 12 * HD * HD;
    const int wv = F.wave;
    const float* const p_conv_w = FIN(I_CONVW); const float* const p_conv_b = FIN(I_CONVB); const float* const p_gate_b = FIN(I_GATEB);
    bf16x8 wq[4], wk[4], wvv[4]; int cur_h = -1;
    for (int uid = F.vcu; uid < NUID; uid += F.G) {
        int tid = F.tid; asm volatile("" : "+v"(tid));
        const int lane = tid & 63, li = lane & 15, g = lane >> 4;
        const int cg = uid >> 2, h = uid & 3;
        const bool isc = cg >= 256;
        const int r0 = cg * 128;
        const int seq0 = isc ? (TL + ((cg - 256) >> 1) * 256) : ((cg >> 6) * SEQ);
        const int s0 = r0 - seq0;
        if (h != cur_h) { cur_h = h;
            lds_barrier();
            for (int i = tid; i < 1280; i += NTHR) { const int tap = i >> 7, ch = i & 127;
                FL[256 + i] = (tap < 9) ? p_conv_w[((size_t)l * 9 + tap) * 512 + h * 128 + ch] : p_conv_b[l * 512 + h * 128 + ch]; }
#pragma unroll
            for (int ks = 0; ks < 4; ++ks) { const int off = (16 * wv + li) * HD + 32 * ks + 8 * g;
                wq[ks] = glb_frag(WQ + (size_t)(0 * 4 + h) * HD * HD + off); wk[ks] = glb_frag(WQ + (size_t)(1 * 4 + h) * HD * HD + off); wvv[ks] = glb_frag(WQ + (size_t)(2 * 4 + h) * HD * HD + off); }
            lds_barrier(); }
        REP(16) {
        { const int L = isc ? CTXL : SEQ;
#pragma unroll
          for (int it = 0; it < 8; ++it) { const int ch = tid + NTHR * it, row = ch >> 4, c16 = ch & 15; const int s = s0 - 64 + row; const bool ok = (unsigned)s < (unsigned)L;
              const v4u v = *(const v4u*)(UXM + (size_t)(seq0 + (ok ? s : s0)) * 512 + h * 128 + 8 * c16);
              *(LAS v4u*)(HALO + row * RS + 16 * c16) = ok ? v : (v4u){0u, 0u, 0u, 0u}; } }
        lds_barrier();
        { const int cb = tid & 15, tg = tid >> 4;
          f32x2 ac[4][4];
          const f32x4 b0 = *(const LAS f32x4*)(FL + 256 + 9 * 128 + 8 * cb), b1 = *(const LAS f32x4*)(FL + 256 + 9 * 128 + 8 * cb + 4);
          const f32x2 bias[4] = {(f32x2){b0[0], b0[1]}, (f32x2){b0[2], b0[3]}, (f32x2){b1[0], b1[1]}, (f32x2){b1[2], b1[3]}};
          const bool zl = !isc && (tg & 15) == 0, zr = !isc && (tg & 15) == 15;
          const LAS unsigned char* hb = HALO + (63 + 4 * tg) * RS + 16 * cb; const int o0 = zl ? RS : 0, o5 = zr ? 4 * RS : 5 * RS;
#pragma unroll
          for (int dy = -1; dy <= 1; ++dy) {
              if (isc && dy != 0) continue;
              f32x2 xr[6][4];
#pragma unroll
              for (int j = 0; j < 6; ++j) {
                  v4u x = *(const LAS v4u*)(hb + 64 * dy * RS + (j == 0 ? o0 : (j == 5 ? o5 : j * RS)));
                  if ((j == 0 && zl) || (j == 5 && zr)) x = (v4u){0u, 0u, 0u, 0u};
                  xr[j][0] = (f32x2){__builtin_bit_cast(float, x.x << 16), __builtin_bit_cast(float, x.x & 0xffff0000u)}; xr[j][1] = (f32x2){__builtin_bit_cast(float, x.y << 16), __builtin_bit_cast(float, x.y & 0xffff0000u)};
                  xr[j][2] = (f32x2){__builtin_bit_cast(float, x.z << 16), __builtin_bit_cast(float, x.z & 0xffff0000u)}; xr[j][3] = (f32x2){__builtin_bit_cast(float, x.w << 16), __builtin_bit_cast(float, x.w & 0xffff0000u)}; }
#pragma unroll
              for (int dx = -1; dx <= 1; ++dx) { const int tap = (dy + 1) * 3 + dx + 1;
                  const f32x4 w0 = *(const LAS f32x4*)(FL + 256 + tap * 128 + 8 * cb), w1 = *(const LAS f32x4*)(FL + 256 + tap * 128 + 8 * cb + 4);
                  const f32x2 wp[4] = {(f32x2){w0[0], w0[1]}, (f32x2){w0[2], w0[3]}, (f32x2){w1[0], w1[1]}, (f32x2){w1[2], w1[3]}};
#pragma unroll
                  for (int i = 0; i < 4; ++i)
#pragma unroll
                      for (int c = 0; c < 4; ++c) ac[i][c] = wp[c] * xr[i + dx + 1][c] + ((tap == (isc ? 3 : 0)) ? bias[c] : ac[i][c]); } }
#pragma unroll
          for (int i = 0; i < 4; ++i) { float a[8] = {ac[i][0][0], ac[i][0][1], ac[i][1][0], ac[i][1][1], ac[i][2][0], ac[i][2][1], ac[i][3][0], ac[i][3][1]};
#pragma unroll
              for (int j = 0; j < 8; ++j) { a[j] = a[j] * pg8::fast_sigmoid(a[j]); DBG_CHK(a[j], 1); }
              v4u o; o.x = pk2(a[0], a[1]); o.y = pk2(a[2], a[3]); o.z = pk2(a[4], a[5]); o.w = pk2(a[6], a[7]);
              *(LAS v4u*)(CV + (4 * tg + i) * RS + 16 * cb) = o; } }
        }
        REP(17) if (wv == 0) { const float* gb = p_gate_b + l * 16; const float* gp0 = GT + (size_t)(r0 + 2 * lane) * 16; const float* gp1 = gp0 + 16;
            const float if0 = gp0[h] + gb[h], if1 = gp1[h] + gb[h], lf0 = logsigf(gp0[4 + h] + gb[4 + h]), lf1 = logsigf(gp1[4 + h] + gb[4 + h]);
            const float ib0 = gp0[8 + h] + gb[8 + h], ib1 = gp1[8 + h] + gb[8 + h], lb0 = logsigf(gp0[12 + h] + gb[12 + h]), lb1 = logsigf(gp1[12 + h] + gb[12 + h]);
            DBG_CHK(if0 + if1 + lf0 + lf1 + ib0 + ib1 + lb0 + lb1, 0);
            const float pin = wscan_add_up(lf0 + lf1, lane);
            const float bf1 = pin, bf0 = pin - lf1, btf = __shfl(pin, 63);
            const float sin_ = wscan_add_down(lb0 + lb1, lane);
            const float bb0 = sin_, bb1 = sin_ - lb0, btb = __shfl(sin_, 0);
            const float af0 = btf - bf0 + if0, af1 = btf - bf1 + if1, ab0 = btb - bb0 + ib0, ab1 = btb - bb1 + ib1;
            const float mf = wave_max(fmaxf(af0, af1)), mb = wave_max(fmaxf(ab0, ab1));
            FL[2 * lane] = __expf(af0 - mf); FL[2 * lane + 1] = __expf(af1 - mf); FL[128 + 2 * lane] = __expf(ab0 - mb); FL[128 + 2 * lane + 1] = __expf(ab1 - mb);
            *(f32x4*)(GA + ((size_t)(r0 + 2 * lane) * 4 + h) * 4) = (f32x4){bf0, if0 - bf0, bb0, ib0 - bb0};
            *(f32x4*)(GA + ((size_t)(r0 + 2 * lane + 1) * 4 + h) * 4) = (f32x4){bf1, if1 - bf1, bb1, ib1 - bb1};
            if (lane == 0) { SC[(0 * 2 + 0) * NUID + uid] = mf; SC[(0 * 2 + 1) * NUID + uid] = mb; SC[(1 * 2 + 0) * NUID + uid] = btf; SC[(1 * 2 + 1) * NUID + uid] = btb; } }
        lds_barrier();
        REP(18)
#pragma unroll 2
        for (int n = 0; n < 8; ++n) {
            bf16x8 cvf[4], xmf[4];
#pragma unroll
            for (int ks = 0; ks < 4; ++ks) { cvf[ks] = lds_frag(CV + (16 * n + li) * RS + (32 * ks + 8 * g) * 2); xmf[ks] = lds_frag(XM + (16 * n + li) * RS + (32 * ks + 8 * g) * 2); }
            f32x4 aq = {0.f, 0.f, 0.f, 0.f}, ak = aq, akt = aq, avt = aq;
#pragma unroll
            for (int ks = 0; ks < 4; ++ks) { aq = mfma16(wq[ks], cvf[ks], aq); ak = mfma16(wk[ks], cvf[ks], ak); akt = mfma16(cvf[ks], wk[ks], akt); avt = mfma16(xmf[ks], wvv[ks], avt); }
            DBG_CHK(aq[0] + aq[1] + aq[2] + aq[3] + ak[0] + ak[1] + ak[2] + ak[3] + akt[0] + akt[1] + akt[2] + akt[3] + avt[0] + avt[1] + avt[2] + avt[3], 2);
            st4bf(Qg + (size_t)(r0 + 16 * n + li) * 512 + h * 128 + 16 * wv + 4 * g, aq);
            st4bf(Kg + (size_t)(r0 + 16 * n + li) * 512 + h * 128 + 16 * wv + 4 * g, ak);
            st4bf_lds(KT_ROW(16 * wv + li) + (16 * n + 4 * g) * 2, akt);
            st4bf_lds(VT + (16 * wv + li) * RS + (16 * n + 4 * g) * 2, avt);
            st4bf(VTg + (size_t)uid * 16384 + (16 * wv + li) * 128 + 16 * n + 4 * g, avt);
        }
        lds_barrier();
        REP(19) {
            bf16x8 vf[4], vb[4];
#pragma unroll
            for (int ks = 0; ks < 4; ++ks) { const bf16x8 v = lds_frag(VT + (16 * wv + li) * RS + (32 * ks + 8 * g) * 2);
                float x[8];
#pragma unroll
                for (int e = 0; e < 8; ++e) x[e] = bf2f((unsigned short)v[e]);
                v4u a, b; const LAS float* wf = FL + 32 * ks + 8 * g; const LAS float* wb = FL + 128 + 32 * ks + 8 * g;
                a.x = pk2(x[0] * wf[0], x[1] * wf[1]); a.y = pk2(x[2] * wf[2], x[3] * wf[3]); a.z = pk2(x[4] * wf[4], x[5] * wf[5]); a.w = pk2(x[6] * wf[6], x[7] * wf[7]);
                b.x = pk2(x[0] * wb[0], x[1] * wb[1]); b.y = pk2(x[2] * wb[2], x[3] * wb[3]); b.z = pk2(x[4] * wb[4], x[5] * wb[5]); b.w = pk2(x[6] * wb[6], x[7] * wb[7]);
                vf[ks] = __builtin_bit_cast(bf16x8, a); vb[ks] = __builtin_bit_cast(bf16x8, b); }
#pragma unroll 2
            for (int n = 0; n < 8; ++n) {
                f32x4 af = {0.f, 0.f, 0.f, 0.f}, ab = af;
#pragma unroll
                for (int ks = 0; ks < 4; ++ks) { const bf16x8 kt = lds_frag(KT_ROW(16 * n + li) + (32 * ks + 8 * g) * 2); af = mfma16(kt, vf[ks], af); ab = mfma16(kt, vb[ks], ab); }
                DBG_CHK(af[0] + af[1] + af[2] + af[3] + ab[0] + ab[1] + ab[2] + ab[3], 3);
                st4bf(CLg + ((size_t)0 * NUID + uid) * 16384 + (16 * wv + li) * 128 + 16 * n + 4 * g, af);
                st4bf(CLg + ((size_t)1 * NUID + uid) * 16384 + (16 * wv + li) * 128 + 16 * n + 4 * g, ab);
            }
            if (tid < 256) { const int dir = tid >> 7, dk = tid & 127; float sacc = 0.f; const LAS float* w = FL + 128 * dir;
#pragma unroll 4
                for (int t8 = 0; t8 < 16; ++t8) { const bf16x8 kk = lds_frag(KT_ROW(dk) + 16 * t8);
#pragma unroll
                    for (int e = 0; e < 8; ++e) sacc += w[8 * t8 + e] * bf2f((unsigned short)kk[e]); }
                NL[((size_t)dir * NUID + uid) * 128 + dk] = sacc; }
        }
        lds_barrier();
    }
}

#undef KT_ROW
__device__ __forceinline__ int m2_cg(int step, int b, int dir) { return (step < 2) ? (256 + 2 * b + (dir ? 1 - step : step)) : (64 * b + (dir ? 63 - (step - 2) : (step - 2))); }
__device__ __forceinline__ void m2_phase(Frame& F, bool dry = false) {
    bf16* CLg = WSP(bf16, WS_CL); float* NL = WSP(float, WS_NL); float* SC = WSP(float, WS_SC);
    const int gid = F.vcu * NTHR + F.tid;
    const int nthreads = F.G * NTHR;
    constexpr int PF = 11, NSTEP = 66;
    for (int item = gid; item < 32 * 4096; item += nthreads) {
        const int chain = item >> 12, e4 = item & 4095;
        const int dir = chain & 1, h = (chain >> 1) & 3, b = chain >> 3;
        float zero_ = 0.f; asm volatile("" : "+v"(zero_));
        float C0 = zero_, C1 = zero_, C2 = zero_, C3 = zero_, m = zero_;
        f32x4 nvec = {zero_, zero_, zero_, zero_};
        const bool do_n = e4 < 32; const int en = do_n ? e4 : 0;
        v2u w[PF]; float ml[PF], bt[PF]; f32x4 nl[PF];
#pragma unroll
        for (int p = 0; p < PF; ++p) { const int uid = m2_cg(p, b, dir) * 4 + h;
            w[p] = *(const v2u*)(CLg + ((size_t)dir * NUID + uid) * 16384 + 4 * e4); ml[p] = SC[(0 * 2 + dir) * NUID + uid]; bt[p] = SC[(1 * 2 + dir) * NUID + uid];
            nl[p] = *(const f32x4*)(NL + ((size_t)dir * NUID + uid) * 128 + 4 * en); }
#pragma unroll
        for (int s0 = 0; s0 < NSTEP; s0 += PF) {
#pragma unroll
            for (int p = 0; p < PF; ++p) { const int step = s0 + p; const int uid = m2_cg(step, b, dir) * 4 + h;
                bf16* cp = CLg + ((size_t)dir * NUID + uid) * 16384 + 4 * e4;
                const v2u wc = w[p]; const float mlc = ml[p], btc = bt[p]; const f32x4 nlc = nl[p];
                if (!dry) { v2u o; o.x = pk2(C0, C1); o.y = pk2(C2, C3); *(v2u*)cp = o; } else asm volatile("" :: "v"(C0), "v"(C1), "v"(C2), "v"(C3), "v"(m), "v"(nvec[0]));
                if (do_n && !dry) *(f32x4*)(NL + ((size_t)dir * NUID + uid) * 128 + 4 * e4) = nvec;
                if (e4 == 0 && !dry) SC[(2 * 2 + dir) * NUID + uid] = m;
                { const int uid2 = m2_cg((step + PF < NSTEP) ? step + PF : NSTEP - 1, b, dir) * 4 + h;
                    w[p] = *(const v2u*)(CLg + ((size_t)dir * NUID + uid2) * 16384 + 4 * e4); ml[p] = SC[(0 * 2 + dir) * NUID + uid2]; bt[p] = SC[(1 * 2 + dir) * NUID + uid2];
                    nl[p] = *(const f32x4*)(NL + ((size_t)dir * NUID + uid2) * 128 + 4 * en); }
                const float mn = fmaxf(btc + m, mlc), dec = __expf(btc + m - mn), inj = __expf(mlc - mn);
                C0 = dec * C0 + inj * bf2f(wc.x & 0xffffu); C1 = dec * C1 + inj * bf2f(wc.x >> 16); C2 = dec * C2 + inj * bf2f(wc.y & 0xffffu); C3 = dec * C3 + inj * bf2f(wc.y >> 16);
                nvec = nvec * dec + nlc * inj; m = mn; DBG_CHK(C0 + C1 + C2 + C3 + m + nvec[0] + nvec[1] + nvec[2] + nvec[3], 5);
            }
        }
    }
}

__device__ __forceinline__ void m3_phase(Frame& F, int l, int ncg, bool dry = false) {
    LAS unsigned char* KS = F.lds;
    LAS unsigned char* VT = F.lds + TILE_B;
    LAS unsigned char* CF = F.lds + 2 * TILE_B;
    LAS unsigned char* CB = F.lds + 3 * TILE_B;
    LAS float* FL = (LAS float*)(F.lds + 4 * TILE_B);
    const bf16* Qg = WSP(bf16, WS_Q); const bf16* Kg = WSP(bf16, WS_K); const bf16* VTg = WSP(bf16, WS_VT); const bf16* CLg = WSP(bf16, WS_CL);
    const float* GA = WSP(float, WS_GA); const float* NL = WSP(float, WS_NL); const float* SC = WSP(float, WS_SC);
    bf16* A4 = WSP(bf16, WS_A4);
    const int wv = F.wave;
    v4u pk_[4], pv_[4], pf_[4], pb_[4];
#define M3_LOAD(uid_) do { const int u_ = (uid_), cg_ = u_ >> 2, h_ = u_ & 3, rr_ = cg_ * 128; _Pragma("unroll") for (int it = 0; it < 4; ++it) { const int ch = tid0 + NTHR * it, row = ch >> 4, c16 = ch & 15; \
        pk_[it] = *(const v4u*)(Kg + (size_t)(rr_ + row) * 512 + h_ * 128 + 8 * c16); \
        pf_[it] = *(const v4u*)(CLg + ((size_t)0 * NUID + u_) * 16384 + row * 128 + 8 * c16); } } while (0)
#define M3_STORE() do { _Pragma("unroll") for (int it = 0; it < 4; ++it) { const int ch = tid0 + NTHR * it, row = ch >> 4, c16 = ch & 15; \
        *(LAS v4u*)(KS + row * RS + 16 * c16) = pk_[it]; *(LAS v4u*)(CF + row * RS + 16 * c16) = pf_[it]; } } while (0)
    { const int tid0 = F.tid; if (F.vcu < ncg * 4) { M3_LOAD(F.vcu); M3_STORE(); } }
    for (int uid = F.vcu; uid < ncg * 4; uid += F.G) {
        int tid = F.tid; asm volatile("" : "+v"(tid));
        const int lane = tid & 63, li = lane & 15, g = lane >> 4; const int tid0 = tid;
        const int cg = uid >> 2, h = uid & 3, r0 = cg * 128;
        const bool more = uid + F.G < ncg * 4;
        const int t = 16 * wv + li;
        f32x4 sm4; float sm1;
        { const float* p4 = (tid < 128) ? GA + ((size_t)(r0 + tid) * 4 + h) * 4 : FIN(I_HNW) + l * 512 + h * 128 + 4 * ((tid - 128) & 31);
          const int e1 = tid - 160; const float* p1 = ((unsigned)e1 < 256u) ? NL + ((size_t)(e1 >> 7) * NUID + uid) * 128 + (e1 & 127) : SC + (2 * 2 + (tid & 1)) * NUID + uid;
          sm4 = *(const f32x4*)p4; sm1 = *p1; }
        bf16x8 qf[4];
#pragma unroll
        for (int ks = 0; ks < 4; ++ks) qf[ks] = glb_frag(Qg + (size_t)(r0 + t) * 512 + h * 128 + 32 * ks + 8 * g);
#pragma unroll
        for (int it = 0; it < 4; ++it) { const int ch = tid + NTHR * it; pv_[it] = *(const v4u*)(VTg + (size_t)uid * 16384 + (ch >> 4) * 128 + 8 * (ch & 15)); pb_[it] = *(const v4u*)(CLg + ((size_t)1 * NUID + uid) * 16384 + (ch >> 4) * 128 + 8 * (ch & 15)); }
        if (tid < 128) *(LAS f32x4*)(FL + 4 * tid) = sm4; else if (tid < 160) *(LAS f32x4*)(FL + 1040 + 4 * (tid - 128)) = sm4;
        if ((unsigned)(tid - 160) < 256u) FL[512 + (tid - 160)] = sm1; else if ((unsigned)(tid - 416) < 2u) FL[1024 + (tid - 416)] = sm1;
        lds_barrier();
        if (wv == 0) { const float u0 = FL[4 * (2 * lane) + 1], u1 = FL[4 * (2 * lane + 1) + 1];
            const float pm = wscan_max_up(fmaxf(u0, u1), lane), pe = __shfl_up(pm, 1); const float excl = (lane > 0) ? pe : -3.0e38f, mp = FL[1024];
            FL[768 + 2 * lane] = fmaxf(mp, fmaxf(excl, u0)); FL[768 + 2 * lane + 1] = fmaxf(mp, pm); }
        else if (wv == 1) { const float u0 = FL[4 * (2 * lane) + 3], u1 = FL[4 * (2 * lane + 1) + 3];
            const float sm = wscan_max_down(fmaxf(u0, u1), lane), se = __shfl_down(sm, 1); const float excl = (lane < 63) ? se : -3.0e38f, mp = FL[1025];
            FL[896 + 2 * lane + 1] = fmaxf(mp, fmaxf(excl, u1)); FL[896 + 2 * lane] = fmaxf(mp, sm); }
        lds_barrier();
        M3_LOAD(more ? uid + F.G : uid);
        REP(21) {
            const bool dry_ = dry || (rep_ == 0 && ((DUPMASK >> 21) & 1));
            bf16x8 sfr[4], sbr[4];
            const float Mf = FL[768 + t], Mb = FL[896 + t], mpf = FL[1024], mpb = FL[1025];
            float rsf = 0.f, rsb = 0.f; const int d = wv >> 1;
#pragma unroll
            for (int kp = 0; kp < 4; ++kp) { f32x4 a0 = {0.f, 0.f, 0.f, 0.f}, a1 = a0;
#pragma unroll
                for (int ks = 0; ks < 4; ++ks) { a0 = mfma16(lds_frag(KS + (32 * kp + li) * RS + (32 * ks + 8 * g) * 2), qf[ks], a0); a1 = mfma16(lds_frag(KS + (32 * kp + 16 + li) * RS + (32 * ks + 8 * g) * 2), qf[ks], a1); }
                DBG_CHK(a0[0] + a0[1] + a0[2] + a0[3] + a1[0] + a1[1] + a1[2] + a1[3], 7);
                __builtin_amdgcn_sched_barrier(0);
                float pf_[8], pb_[8];
                if (kp < d) {
#pragma unroll
                    for (int e = 0; e < 8; ++e) { const int s = 32 * kp + 16 * (e >> 2) + 4 * g + (e & 3); const float a = (e < 4) ? a0[e & 3] : a1[e & 3];
                        pf_[e] = a * __expf(FL[4 * s + 1] - Mf); pb_[e] = 0.f; rsf += pf_[e]; }
                } else if (kp > d) {
#pragma unroll
                    for (int e = 0; e < 8; ++e) { const int s = 32 * kp + 16 * (e >> 2) + 4 * g + (e & 3); const float a = (e < 4) ? a0[e & 3] : a1[e & 3];
                        pb_[e] = a * __expf(FL[4 * s + 3] - Mb); pf_[e] = 0.f; rsb += pb_[e]; }
                } else {
#pragma unroll
                    for (int e = 0; e < 8; ++e) { const int s = 32 * kp + 16 * (e >> 2) + 4 * g + (e & 3); const float a = (e < 4) ? a0[e & 3] : a1[e & 3]; const float uf = FL[4 * s + 1], ub = FL[4 * s + 3];
                        const int dts = t - s; const float pen_f = (float)min(dts, 0) * 1.0e30f, pen_b = (float)min(-dts, 0) * 1.0e30f;
                        const float wf = __expf(uf - Mf + pen_f), wb = __expf(ub - Mb + pen_b);
                        pf_[e] = a * wf; pb_[e] = a * wb; rsf += pf_[e]; rsb += pb_[e]; }
                }
                v4u wa, wb4; wa.x = pk2(pf_[0], pf_[1]); wa.y = pk2(pf_[2], pf_[3]); wa.z = pk2(pf_[4], pf_[5]); wa.w = pk2(pf_[6], pf_[7]);
                wb4.x = pk2(pb_[0], pb_[1]); wb4.y = pk2(pb_[2], pb_[3]); wb4.z = pk2(pb_[4], pb_[5]); wb4.w = pk2(pb_[6], pb_[7]);
                sfr[kp] = __builtin_bit_cast(bf16x8, wa); sbr[kp] = __builtin_bit_cast(bf16x8, wb4);
                __builtin_amdgcn_sched_barrier(0); }
            rsf += __shfl_xor(rsf, 16); rsf += __shfl_xor(rsf, 32); rsb += __shfl_xor(rsb, 16); rsb += __shfl_xor(rsb, 32);
            float qnf = 0.f, qnb = 0.f;
#pragma unroll
            for (int ks = 0; ks < 4; ++ks)
#pragma unroll
                for (int e = 0; e < 8; ++e) { const float qv = bf2f((unsigned short)qf[ks][e]); const int d = 32 * ks + 8 * g + e; qnf += qv * FL[512 + d]; qnb += qv * FL[640 + d]; }
            qnf += __shfl_xor(qnf, 16); qnf += __shfl_xor(qnf, 32); qnb += __shfl_xor(qnb, 16); qnb += __shfl_xor(qnb, 32);
            const f32x4 gat = *(const LAS f32x4*)(FL + 4 * t);
            const float wif = __expf(mpf - Mf), wib = __expf(mpb - Mb);
            const float denf = rsf + wif * qnf, denb = rsb + wib * qnb;
            const float rf = 1.0f / fmaxf(fabsf(denf), __expf(-(gat[0] + Mf))), rb = 1.0f / fmaxf(fabsf(denb), __expf(-(gat[2] + Mb)));
            const float alf = rf * wif, alb = rb * wib; DBG_CHK(rf + rb + alf + alb, 8);
            if (rep_ == 0) {
#pragma unroll
                for (int it = 0; it < 4; ++it) { const int ch = tid + NTHR * it; *(LAS v4u*)(VT + (ch >> 4) * RS + 16 * (ch & 15)) = pv_[it]; *(LAS v4u*)(CB + (ch >> 4) * RS + 16 * (ch & 15)) = pb_[it]; } }
            lds_barrier();
            f32x4 o[8]; float sum = 0.f;
#pragma unroll
            for (int n = 0; n < 8; ++n) { f32x4 apf = {0.f, 0.f, 0.f, 0.f}, apb = apf, acf = apf, acb = apf;
#pragma unroll
                for (int kp = 0; kp < 4; ++kp) { const v2u lo = *(const LAS v2u*)(VT + (16 * n + li) * RS + (32 * kp + 4 * g) * 2), hi = *(const LAS v2u*)(VT + (16 * n + li) * RS + (32 * kp + 16 + 4 * g) * 2);
                    const v4u vv = {lo.x, lo.y, hi.x, hi.y}; const bf16x8 vfr = __builtin_bit_cast(bf16x8, vv); if (kp <= d) apf = mfma16(vfr, sfr[kp], apf); if (kp >= d) apb = mfma16(vfr, sbr[kp], apb); }
#pragma unroll
                for (int ks = 0; ks < 4; ++ks) { acf = mfma16(lds_frag(CF + (16 * n + li) * RS + (32 * ks + 8 * g) * 2), qf[ks], acf); acb = mfma16(lds_frag(CB + (16 * n + li) * RS + (32 * ks + 8 * g) * 2), qf[ks], acb); }
                const f32x4 a = apf * rf + apb * rb + acf * alf + acb * alb;
                o[n] = a; sum += (a[0] + a[1]) + (a[2] + a[3]);
                __builtin_amdgcn_sched_barrier(0); }
            DBG_CHK(sum, 9);
            bf16* zrow = A4 + (size_t)(r0 + t) * 1024 + 512 + h * 128;
            v2u zz[8];
#pragma unroll
            for (int n = 0; n < 8; ++n) zz[n] = *(const v2u*)(zrow + 16 * n + 4 * g);
            sum += __shfl_xor(sum, 16); sum += __shfl_xor(sum, 32);
            const float mu = sum * (1.f / 128.f); float var = 0.f;
#pragma unroll
            for (int n = 0; n < 8; ++n) { o[n] = o[n] - mu; var += (o[n][0] * o[n][0] + o[n][1] * o[n][1]) + (o[n][2] * o[n][2] + o[n][3] * o[n][3]); }
            var += __shfl_xor(var, 16); var += __shfl_xor(var, 32);
            const float rstd = 1.0f / sqrtf(var * (1.f / 128.f) + EPSN);
#pragma unroll
            for (int n = 0; n < 8; ++n) { const int dv = 16 * n + 4 * g; const f32x4 w4 = *(const LAS f32x4*)(FL + 1040 + dv);
                f32x4 y; y[0] = o[n][0] * rstd * w4[0] * pg8::fast_sigmoid(bf2f(zz[n].x & 0xffffu)); y[1] = o[n][1] * rstd * w4[1] * pg8::fast_sigmoid(bf2f(zz[n].x >> 16));
                y[2] = o[n][2] * rstd * w4[2] * pg8::fast_sigmoid(bf2f(zz[n].y & 0xffffu)); y[3] = o[n][3] * rstd * w4[3] * pg8::fast_sigmoid(bf2f(zz[n].y >> 16));
                DBG_CHK(y[0] + y[1] + y[2] + y[3], 10); if (!dry_) st4bf(zrow + dv, y); else asm volatile("" :: "v"(y[0]), "v"(y[1]), "v"(y[2]), "v"(y[3])); }
        }
        lds_barrier();
        M3_STORE();
        lds_barrier();
    }
#undef M3_LOAD
#undef M3_STORE
}
constexpr int FRS = 288;
__device__ __forceinline__ s16x4 tr_read(const LAS unsigned char* p) { typedef short v4i16_t __attribute__((ext_vector_type(4))); return __builtin_bit_cast(s16x4, __builtin_amdgcn_ds_read_tr16_b64_v4i16((LAS v4i16_t*)p)); }
__device__ __forceinline__ bf16x8 dft_frag(const LAS unsigned char* tile, int t, int nt, int lane) {
    const int g = lane >> 4, q = (lane & 15) >> 2, p = lane & 3;
    const LAS unsigned char* a = tile + (32 * t + 16 * (g >> 1) + 4 * (g & 1) + q) * FRS + (16 * nt + 4 * p) * 2;
    const s16x4 lo = tr_read(a), hi = tr_read(a + 8 * FRS);
    bf16x8 r; r[0] = lo[0]; r[1] = lo[1]; r[2] = lo[2]; r[3] = lo[3]; r[4] = hi[0]; r[5] = hi[1]; r[6] = hi[2]; r[7] = hi[3]; return r;
}
__device__ __forceinline__ const bf16* f1_src(const bf16* UXF, int u, int ch) { const int cb = u & 3, s2 = (u >> 2) & 63, b = u >> 8, row = ch >> 4, c16 = ch & 15; return UXF + (size_t)(b * SEQ + 64 * row + s2) * 512 + 128 * cb + 8 * c16; }
__device__ __forceinline__ void f1_phase(Frame& F) {
    const bf16* UXF = WSP(bf16, WS_Y); bf16* HS1 = (bf16*)FOUT;
    const bf16* W1 = (const bf16*)(F.ws + WS_TAB + TAB_W1); const f32x2* TW = (const f32x2*)(F.ws + WS_TAB + TAB_TW);
    const int lane0 = F.lane, wv = F.wave;
    bf16x8 wre[4], wim[4];
#pragma unroll
    for (int t = 0; t < 4; ++t) { wre[t] = glb_frag(W1 + ((((size_t)wv * 2 + 0) * 4 + t) * 64 + lane0) * 8); wim[t] = glb_frag(W1 + ((((size_t)wv * 2 + 1) * 4 + t) * 64 + lane0) * 8); }
    int ub, un, us;
    if (F.G == 256) { us = 1; const int v = F.vcu; if (v < 32) { ub = v; un = 1; } else { const int w = v - 32; if (w < 96) { ub = 32 + 5 * w; un = 5; } else { ub = 32 + 480 + 4 * (w - 96); un = 4; } } }
    else { ub = F.vcu; us = F.G; un = (NB * 64 * 4 - F.vcu + F.G - 1) / F.G; }
    constexpr int TB = 128 * FRS;
    f32x2 twn = {0.f, 0.f};
    if (un > 0) { const int tid = F.tid;
#pragma unroll
        for (int it = 0; it < 4; ++it) { const int ch = tid + NTHR * it; *(LAS v4u*)(F.lds + (ch >> 4) * FRS + 16 * (ch & 15)) = *(const v4u*)f1_src(UXF, ub, ch); }
        twn = TW[(16 * wv + (lane0 & 15)) * 64 + ((ub >> 2) & 63)]; }
    VM_DONE();
    lds_barrier();
    for (int ui = 0; ui < un; ++ui) {
        const int u = ub + ui * us;
        int tid = F.tid; asm volatile("" : "+v"(tid)); const int lane = tid & 63, li = lane & 15, g = lane >> 4;
        const int cb = u & 3, s2 = (u >> 2) & 63, b = u >> 8;
        LAS unsigned char* tile = F.lds + (ui & 1) * TB; LAS unsigned char* ntile = F.lds + ((ui + 1) & 1) * TB;
        v4u pre[4]; const bool more = ui + 1 < un;
        const int k1 = 16 * wv + li; const f32x2 tw = twn;
        if (more) {
#pragma unroll
            for (int it = 0; it < 4; ++it) pre[it] = *(const v4u*)f1_src(UXF, u + us, tid + NTHR * it);
            twn = TW[k1 * 64 + (((u + us) >> 2) & 63)]; }
        bf16* ore = HS1 + (size_t)(b * SEQ + 64 * k1 + s2) * 1024 + 128 * cb;
#pragma unroll
        for (int nt = 0; nt < 8; ++nt) { f32x4 are = {0.f, 0.f, 0.f, 0.f}, aim = are;
#pragma unroll
            for (int t = 0; t < 4; ++t) { const bf16x8 d = dft_frag(tile, t, nt, lane); are = mfma16(d, wre[t], are); aim = mfma16(d, wim[t], aim); }
            DBG_CHK(are[0] + are[1] + are[2] + are[3] + aim[0] + aim[1] + aim[2] + aim[3], 4);
            st4bf(ore + 16 * nt + 4 * g, are * tw.x - aim * tw.y);
            st4bf(ore + 512 + 16 * nt + 4 * g, are * tw.y + aim * tw.x); }
        if (more) {
#pragma unroll
            for (int it = 0; it < 4; ++it) { const int ch = tid + NTHR * it; *(LAS v4u*)(ntile + (ch >> 4) * FRS + 16 * (ch & 15)) = pre[it]; } }
        lds_barrier();
    }
}
__device__ __forceinline__ const bf16* f2_src(const bf16* HS1, int u, int ch) { const int cb = u & 3, k1 = (u >> 2) & 127, b = u >> 9, row = ch >> 4, c16 = ch & 15;
    return HS1 + (size_t)(b * SEQ + 64 * k1 + (row & 63)) * 1024 + (row >> 6) * 512 + 128 * cb + 8 * c16; }
__device__ __forceinline__ void f2_phase(Frame& F, int l) {
    const bf16* HS1 = (const bf16*)FOUT; bf16* A4 = WSP(bf16, WS_A4);
    const bf16* W2 = (const bf16*)(F.ws + WS_TAB + TAB_W2); const bf16* PQF = (const bf16*)(F.ws + WS_TAB + TAB_PQF) + (size_t)l * 8 * 8192;
    const int lane0 = F.lane, wv = F.wave, kq = wv & 3, grp = wv >> 2;
    bf16x8 w2r[4], w2i[4];
#pragma unroll
    for (int t = 0; t < 4; ++t) { w2r[t] = glb_frag(W2 + (((size_t)kq * 4 + t) * 64 + lane0) * 8); w2i[t] = glb_frag(W2 + (((size_t)(kq + 4) * 4 + t) * 64 + lane0) * 8); }
    constexpr int TB = 128 * FRS;
    constexpr int NQP = NB * 63 * 4, NU = NQP + NB * 2 * 4;
#define F2_OLD(q_) (((q_) < NQP) ? ((((q_) >> 2) / 63 * 128 + 1 + ((q_) >> 2) % 63) << 2) | ((q_) & 3) : ((((((q_) - NQP) >> 3) * 128 + ((((q_) - NQP) >> 2) & 1) * 64)) << 2) | ((q_) & 3))
    bf16x8 pqr[16]; int cur_gi = 2 * (F.vcu & 3) + grp;
    { const bf16* pq = PQF + (size_t)cur_gi * 8192 + lane0 * 8;
#pragma unroll
      for (int q = 0; q < 16; ++q) pqr[q] = glb_frag(pq + q * 512); }
    if (F.vcu < NU) { const int tid = F.tid;
#pragma unroll
        for (int it = 0; it < 4; ++it) { const int ch = tid + NTHR * it; *(LAS v4u*)(F.lds + (ch >> 4) * FRS + 16 * (ch & 15)) = *(const v4u*)f2_src(HS1, F2_OLD(F.vcu), ch); } }
    VM_DONE();
    v4u preA[4], preB[4];
#define PF_LOAD(dst_, ptr_) asm volatile("global_load_dwordx4 %0, %1, off" : "=v"(dst_) : "v"(ptr_) : "memory")
#define PF_WAIT(P_, younger4_) do { if (younger4_) asm volatile("s_waitcnt vmcnt(4)" :: "v"(P_[0]), "v"(P_[1]), "v"(P_[2]), "v"(P_[3]) : "memory"); \
        else asm volatile("s_waitcnt vmcnt(0)" :: "v"(P_[0]), "v"(P_[1]), "v"(P_[2]), "v"(P_[3]) : "memory"); } while (0)
    if (F.vcu + F.G < NU) { const int tid = F.tid;
#pragma unroll
        for (int it = 0; it < 4; ++it) PF_LOAD(preA[it], f2_src(HS1, F2_OLD(F.vcu + F.G), tid + NTHR * it)); }
    lds_barrier();
#define F2_BODY(TILE_, NTILE_, PL_, PW_) do { \
        int tid = F.tid; asm volatile("" : "+v"(tid)); const int lane = tid & 63, li = lane & 15, g = lane >> 4; \
        const int u = F2_OLD(q); const bool pair = q < NQP; \
        const int cb = u & 3, k1 = (u >> 2) & 127, b = u >> 9, gi = 2 * cb + grp; \
        LAS unsigned char* tile = (TILE_); LAS unsigned char* ntile = (NTILE_); \
        const bool more1 = q + F.G < NU, more2 = q + 2 * F.G < NU; \
        if (more2) { _Pragma("unroll") for (int it = 0; it < 4; ++it) PF_LOAD(PL_[it], f2_src(HS1, F2_OLD(q + 2 * F.G), tid + NTHR * it)); } \
        bf16x8 uf[4]; \
        _Pragma("unroll") for (int hp = 0; hp < 2; ++hp) { f32x4 r0 = {0.f, 0.f, 0.f, 0.f}, r1 = r0, i0 = r0, i1 = r0; \
            _Pragma("unroll") for (int t = 0; t < 4; ++t) { const bf16x8 d0 = dft_frag(tile, t, 4 * grp + 2 * hp, lane), d1 = dft_frag(tile, t, 4 * grp + 2 * hp + 1, lane); \
                r0 = mfma16(d0, w2r[t], r0); r1 = mfma16(d1, w2r[t], r1); i0 = mfma16(d0, w2i[t], i0); i1 = mfma16(d1, w2i[t], i1); } \
            DBG_CHK(r0[0] + r1[1] + i0[2] + i1[3], 6); \
            v4u wr_, wi_; wr_.x = pk2(r0[0], r0[1]); wr_.y = pk2(r0[2], r0[3]); wr_.z = pk2(r1[0], r1[1]); wr_.w = pk2(r1[2], r1[3]); \
            wi_.x = pk2(i0[0], i0[1]); wi_.y = pk2(i0[2], i0[3]); wi_.z = pk2(i1[0], i1[1]); wi_.w = pk2(i1[2], i1[3]); \
            uf[hp] = __builtin_bit_cast(bf16x8, wr_); uf[2 + hp] = __builtin_bit_cast(bf16x8, wi_); } \
        if (more1) { PF_WAIT(PW_, more2); \
            _Pragma("unroll") for (int it = 0; it < 4; ++it) { const int ch = tid + NTHR * it; *(LAS v4u*)(ntile + (ch >> 4) * FRS + 16 * (ch & 15)) = PW_[it]; } } \
        bf16* orow = A4 + (size_t)(b * SEQ + k1 + 128 * (16 * kq + li)) * 1024 + 64 * gi; \
        bf16* orow2 = A4 + (size_t)(b * SEQ + (128 - k1) + 128 * (63 - (16 * kq + li))) * 1024 + 64 * gi; \
        if (gi != cur_gi) { cur_gi = gi; const bf16* pq = PQF + (size_t)gi * 8192 + lane * 8; \
            _Pragma("unroll") for (int q = 0; q < 16; ++q) pqr[q] = glb_frag(pq + q * 512); \
            VM_DONE(); } \
        _Pragma("unroll") for (int nd = 0; nd < 4; ++nd) { f32x4 pa = {0.f, 0.f, 0.f, 0.f}, pb = pa;        \
            pa = mfma16(pqr[nd * 4 + 0], uf[0], pa); pb = mfma16(pqr[nd * 4 + 2], uf[2], pb); pa = mfma16(pqr[nd * 4 + 1], uf[1], pa); pb = mfma16(pqr[nd * 4 + 3], uf[3], pb); \
            st4bf(orow + 16 * nd + 4 * g, pa + pb); if (pair) st4bf(orow2 + 16 * nd + 4 * g, pa - pb); } \
        lds_barrier(); } while (0)
    for (int q = F.vcu; q < NU; q += F.G) {
        F2_BODY(F.lds, F.lds + TB, preB, preA);
        q += F.G; if (q >= NU) break;
        F2_BODY(F.lds + TB, F.lds, preA, preB);
    }
#undef F2_BODY
#undef F2_OLD
#undef PF_LOAD
#undef PF_WAIT
}
__device__ __forceinline__ void ctx_fourier(Frame& F, int l) {
    const bf16* UXF = WSP(bf16, WS_Y); bf16* A4 = WSP(bf16, WS_A4);
    const bf16* WC = (const bf16*)(F.ws + WS_WC); const bf16* PQF = (const bf16*)(F.ws + WS_TAB + TAB_PQF) + (size_t)l * 8 * 8192;
    const int wv = F.wave, kq = wv & 3, grp = wv >> 2;
    for (int it = (F.G == 256) ? F.vcu - 128 : F.vcu; it < NB * 4 * 4; it += F.G) {
        if (it < 0) continue;
        int tid = F.tid; asm volatile("" : "+v"(tid)); const int lane = tid & 63, li = lane & 15, g = lane >> 4;
        const int kt = it & 3, cb = (it >> 2) & 3, b = it >> 4, gi = 2 * cb + grp;
#pragma unroll
        for (int i8 = 0; i8 < 8; ++i8) { const int ch = tid + NTHR * i8, row = ch >> 4, c16 = ch & 15;
            *(LAS v4u*)(F.lds + row * FRS + 16 * c16) = *(const v4u*)(UXF + (size_t)(TL + b * CTXL + row) * 512 + 128 * cb + 8 * c16); }
        bf16x8 wr[8], wi[8], pqr[16];
#pragma unroll
        for (int t = 0; t < 8; ++t) { wr[t] = glb_frag(WC + ((((size_t)(kt * 4 + kq) * 2 + 0) * 8 + t) * 64 + lane) * 8); wi[t] = glb_frag(WC + ((((size_t)(kt * 4 + kq) * 2 + 1) * 8 + t) * 64 + lane) * 8); }
#pragma unroll
        for (int q = 0; q < 16; ++q) pqr[q] = glb_frag(PQF + (size_t)gi * 8192 + lane * 8 + q * 512);
        lds_barrier();
        bf16x8 uf[4];
#pragma unroll
        for (int hp = 0; hp < 2; ++hp) { f32x4 r0 = {0.f, 0.f, 0.f, 0.f}, r1 = r0, i0 = r0, i1 = r0;
#pragma unroll
            for (int t = 0; t < 8; ++t) { const bf16x8 d0 = dft_frag(F.lds, t, 4 * grp + 2 * hp, lane), d1 = dft_frag(F.lds, t, 4 * grp + 2 * hp + 1, lane);
                r0 = mfma16(d0, wr[t], r0); r1 = mfma16(d1, wr[t], r1); i0 = mfma16(d0, wi[t], i0); i1 = mfma16(d1, wi[t], i1); }
            v4u wr_, wi_; wr_.x = pk2(r0[0], r0[1]); wr_.y = pk2(r0[2], r0[3]); wr_.z = pk2(r1[0], r1[1]); wr_.w = pk2(r1[2], r1[3]);
            wi_.x = pk2(i0[0], i0[1]); wi_.y = pk2(i0[2], i0[3]); wi_.z = pk2(i1[0], i1[1]); wi_.w = pk2(i1[2], i1[3]);
            uf[hp] = __builtin_bit_cast(bf16x8, wr_); uf[2 + hp] = __builtin_bit_cast(bf16x8, wi_); }
        bf16* orow = A4 + (size_t)(TL + b * CTXL + 64 * kt + 16 * kq + li) * 1024 + 64 * gi;
#pragma unroll
        for (int nd = 0; nd < 4; ++nd) { f32x4 a = {0.f, 0.f, 0.f, 0.f};
#pragma unroll
            for (int ks = 0; ks < 4; ++ks) a = mfma16(pqr[nd * 4 + ks], uf[ks], a);
            DBG_CHK(a[0] + a[1] + a[2] + a[3], 11); st4bf(orow + 16 * nd + 4 * g, a); }
        lds_barrier();
    }
    lds_barrier();
}

struct Args { const float* in[17]; float* out; unsigned char* ws; int ph_lo, ph_hi; };
constexpr int NPHASES = 2 + DEPTH * 12;
__global__ void __launch_bounds__(NTHR, 2) mega_fwd(Args args) {
    extern __shared__ __attribute__((aligned(16))) unsigned char lds[];
    Frame F;
    F.lds = (LAS unsigned char*)lds;
    F.MISC = (volatile LAS unsigned*)(F.lds + MISC_OFF);
    F.tid = threadIdx.x; F.lane = F.tid & 63; F.wave = __builtin_amdgcn_readfirstlane(F.tid >> 6);
    F.G = gridDim.x; { const int bx = blockIdx.x; F.vcu = (F.G % 8 == 0) ? (bx % 8) * (F.G / 8) + bx / 8 : bx; }
    F.ws = args.ws; F.ctl = (gu32*)(args.ws + WS_CTL);
    if (F.tid < 16) ((LAS unsigned*)(F.lds + MISC_OFF))[F.tid] = 0u;
    if (F.tid == 64) { LAS unsigned long long* pt = (LAS unsigned long long*)(F.lds + PTAB_OFF);
#pragma unroll
        for (int i = 0; i < 17; ++i) pt[i] = (unsigned long long)args.in[i];
        pt[17] = (unsigned long long)args.out; pt[18] = (unsigned long long)args.ws; }
    __syncthreads();
    XcdBarrier bar = xcd_barrier_post((unsigned*)(F.ctl + CW_BAR), F.MISC + 8);
    const int lo = args.ph_lo, hi = args.ph_hi;
    const int vcu_s = F.vcu; const int wave_s = F.wave;
    int pid = 0;
#define PH_BEGIN if (lo <= pid && pid < hi) { { int t_; asm volatile("v_mbcnt_lo_u32_b32 %0, -1, 0\n\tv_mbcnt_hi_u32_b32 %0, -1, %0" : "=v"(t_)); t_ += wave_s * 64; { int g_ = (int)gridDim.x, v_ = vcu_s, b_ = (int)blockIdx.x; asm volatile("" : "+s"(g_), "+s"(v_), "+s"(b_)); F.G = g_; F.vcu = v_; F.bid = b_; } F.tid = t_; F.lane = t_ & 63; F.wave = __builtin_amdgcn_readfirstlane(t_ >> 6); { LAS unsigned char* lp_ = (LAS unsigned char*)lds; asm volatile("" : "+s"(lp_)); F.lds = lp_; } F.ws = (unsigned char*)(GAS unsigned char*)ptab(F, 18); F.ctl = (gu32*)(F.ws + WS_CTL); }
#define PH_END   if (pid + 1 < hi) { int tb_; asm volatile("v_mbcnt_lo_u32_b32 %0, -1, 0\n\tv_mbcnt_hi_u32_b32 %0, -1, %0" : "=v"(tb_)); xcd_barrier(bar.bar, bar.x, bar.st, tb_ + wave_s * 64, gridDim.x); } } ++pid;
#define XC WSP(float, WS_XC)
#define Hb ((bf16*)FOUT)
#define XB WSP(bf16, WS_XB)
#define Yb WSP(bf16, WS_Y)
#define ACT WSP(bf16, WS_ACT)
#define A4 WSP(bf16, WS_A4)
#define MOD WSP(float, WS_MOD)

    PH_BEGIN mod_first(F); PH_END
    PH_BEGIN { REP(0) p0_prologue(F, 3, F.vcu, F.G);
      if (F.G != 256) { int tb_; asm volatile("v_mbcnt_lo_u32_b32 %0, -1, 0\n\tv_mbcnt_hi_u32_b32 %0, -1, %0" : "=v"(tb_)); xcd_barrier(bar.bar, bar.x, bar.st, tb_ + wave_s * 64, gridDim.x); }
      REP(1) { const Thin P{FIN(I_X), FIN(I_CTX), XB, XC, nullptr, nullptr, nullptr, nullptr, Hb, FIN(I_NORMW) + 0 * DM, MOD + 1 * DM, MOD + 0 * DM, 0.f, 0, TT, 0, 1}; thin_phase(F, P, 0); } } PH_END

#pragma unroll 1
    for (int hl = 0; hl < 2 * DEPTH; ++hl) {
        const int l = hl >> 1, f = hl & 1; const bool last = (l == DEPTH - 1);

        const int Mrows = (last && f == 1) ? TL : TT;
        PH_BEGIN REP(2) { pg8::Gemm gm{Hb, WSP(bf16, WS_WFFIN) + (size_t)(l * 2 + f) * 2 * DFF * DM, Mrows, 2 * DFF, DM, DM, 0, 0}; pg8::StaticOrder S; S.init(Mrows, 2 * DFF, F.G, F.bid);
            pg8::EpiSwiGLU E{ACT, DFF}; pg8::gemm_phase<pg8::EpiSwiGLU, pg8::StaticOrder, true, true>(F.lds, gm, S, E, F.tid);
            if (false && l == 0) { const int nfull = (Mrows / 256) * (2 * DFF / 256) % F.G; if (nfull > 0 && F.bid >= nfull) p0_prologue(F, 1 + f, F.bid - nfull, F.G - nfull); } } PH_END
        PH_BEGIN REP(3) { { pg8::Gemm gm{ACT, WSP(bf16, WS_WFFOUT) + (size_t)(l * 2 + f) * DM * DFF, TL, DM, DFF, DFF, 1, 1}; pg8::StaticOrder S; S.init(TL, DM, F.G, F.bid, 1);
            pg8::EpiPlain E{Yb, DM}; pg8::gemm_phase<pg8::EpiPlain, pg8::StaticOrder, true, true>(F.lds, gm, S, E, F.tid); }
            if (Mrows > TL) {
                pg8::Gemm gm{ACT, WSP(bf16, WS_WFFOUT) + (size_t)(l * 2 + f) * DM * DFF, TT, DM, DFF, 256, 1, 1}; pg8::SplitKOrder S; S.init(TL / 256, 4, 4, 11, F.G, F.bid);
                pg8::EpiSlab E{WSP(float, WS_SLAB2), DM, TL / 256, (size_t)TC * DM}; pg8::gemm_phase<pg8::EpiSlab, pg8::SplitKOrder, true, true>(F.lds, gm, S, E, F.tid); } } PH_END
        PH_BEGIN { const int j = f ? 2 : 0;
            const float* nw = FIN(I_NORMW) + (size_t)l * 6 * DM; const float* modl = MOD + (size_t)l * 5 * NMOD * DM; const bool fin = last && f == 1;
            bf16* const Hp = (f == 0 || !last) ? Hb : nullptr;
            const float* const nwp = (f == 0) ? nw + 2 * DM : nw + 6 * DM;
            const float* const scp = (f == 0) ? modl + 4 * DM : modl + (size_t)5 * NMOD * DM + 1 * DM;
            const float* const shp = (f == 0) ? modl + 3 * DM : modl + (size_t)5 * NMOD * DM;
            const Thin P{XB, XC, fin ? (void*)FOUT : (void*)XB, XC, Yb, WSP(float, WS_SLAB2), nw + (f ? 5 : 1) * DM, modl + (3 * j + 2) * DM, Hp, nwp, scp, shp, 0.5f, (Mrows > TL) ? 11 : 0, Mrows, 1, fin ? 0 : 1};
            REP(4) thin_phase(F, P, l == 0 ? (f ? 3 : 1) : (f ? 6 : 4), rep_ == 0 && ((DUPMASK >> 4) & 1));
#ifdef DBG_FLAGS
            if (last && f == 1) { __syncthreads(); if (blockIdx.x == 0 && F.tid == 0) { const unsigned m = __hip_atomic_load((unsigned*)(F.ctl + 64), __ATOMIC_RELAXED, __HIP_MEMORY_SCOPE_AGENT); if (m) FOUT[0] = 1.0e6f * (float)(__builtin_ctz(m) + 1); } }
#endif
            } PH_END
        if (f == 0) {
            PH_BEGIN REP(5) { pg8::Gemm gm{Hb, WSP(bf16, WS_WIN) + (size_t)l * DIN_PAD * DM, TT, DIN_PAD, DM, DM, 0, 0}; pg8::StaticOrder S; S.init(TT, DIN_PAD, F.G, F.bid);
                pg8::EpiInProj E{Yb, Yb + (size_t)TT * 512, A4, WSP(float, WS_GT)}; pg8::gemm_phase<pg8::EpiInProj, pg8::StaticOrder, true, true>(F.lds, gm, S, E, F.tid); } PH_END
            PH_BEGIN { REP(6) m1_phase(F, l); REP(12) f1_phase(F); } PH_END
            PH_BEGIN { REP(7) m2_phase(F, rep_ == 0 && ((DUPMASK >> 7) & 1)); REP(13) f2_phase(F, l); } PH_END
            PH_BEGIN { REP(8) m3_phase(F, l, last ? 256 : NCG, rep_ == 0 && ((DUPMASK >> 8) & 1)); if (!last) ctx_fourier(F, l); } PH_END
            { const int M4 = last ? TL : TT;
            PH_BEGIN REP(9) { { pg8::Gemm gm{A4, WSP(bf16, WS_WOUT) + (size_t)l * DM * DM, TL, DM, DM, DM, 0, 0}; pg8::StaticOrder S; S.init(TL, DM, F.G, F.bid);
                pg8::EpiPlain E{Yb, DM}; pg8::gemm_phase<pg8::EpiPlain, pg8::StaticOrder, true, true>(F.lds, gm, S, E, F.tid); }
                if (M4 > TL) { pg8::Gemm gm{A4, WSP(bf16, WS_WOUT) + (size_t)l * DM * DM, TT, DM, DM, 256, 0, 0}; pg8::SplitKOrder S; S.init(TL / 256, 4, 4, 4, F.G, F.bid);
                    pg8::EpiSlab E{WSP(float, WS_SLAB4), DM, TL / 256, (size_t)TC * DM}; pg8::gemm_phase<pg8::EpiSlab, pg8::SplitKOrder, true, true>(F.lds, gm, S, E, F.tid); } } PH_END
            PH_BEGIN { const float* nw = FIN(I_NORMW) + (size_t)l * 6 * DM; const float* modl = MOD + (size_t)l * 5 * NMOD * DM;
                const Thin P{XB, XC, XB, XC, Yb, WSP(float, WS_SLAB4), nw + 3 * DM, modl + 5 * DM, Hb, nw + 4 * DM, modl + 7 * DM, modl + 6 * DM, 1.0f, (M4 > TL) ? 4 : 0, M4, 1, 1}; REP(10) thin_phase(F, P, l == 0 ? 2 : 5, rep_ == 0 && ((DUPMASK >> 10) & 1)); } PH_END
            }
        }
    }
#undef XC
#undef Hb
#undef XB
#undef Yb
#undef ACT
#undef A4
#undef MOD
#undef PH_BEGIN
#undef PH_END
}

#ifndef MK_PER_PHASE
#define MK_PER_PHASE 0
#endif
extern "C" void kernel_launch(void* const* d_in, const int* in_sizes, int n_in, void* d_out, int out_size, void* d_ws, size_t ws_size, hipStream_t stream) {
    static int grid = 0;
    if (grid == 0) {
        if (n_in != 17 || out_size != TL * DM || ws_size < WS_END) { fprintf(stderr, "kernel_launch: unexpected problem (n_in %d, out %d, ws %zu); nothing launched\n", n_in, out_size, ws_size); grid = -1; return; }
        int dev = 0, cus = 0, per_cu = 0;
        if (hipGetDevice(&dev) != hipSuccess || hipDeviceGetAttribute(&cus, hipDeviceAttributeMultiprocessorCount, dev) != hipSuccess) { grid = -1; return; }
        if (hipFuncSetAttribute((const void*)mega_fwd, hipFuncAttributeMaxDynamicSharedMemorySize, LDS_BYTES) != hipSuccess) { fprintf(stderr, "kernel_launch: hipFuncSetAttribute failed\n"); grid = -1; return; }
        if (hipOccupancyMaxActiveBlocksPerMultiprocessor(&per_cu, (const void*)mega_fwd, NTHR, LDS_BYTES) != hipSuccess || per_cu < 1) fprintf(stderr, "kernel_launch: occupancy query reports %d\n", per_cu);
        (void)hipGetLastError();
        grid = cus;
    }
    if (grid < 0) return;
    if (hipMemsetAsync((char*)d_ws + WS_CTL, 0, CTL_ZERO_BYTES, stream) != hipSuccess) return;
    Args a{};
    for (int i = 0; i < 17; ++i) a.in[i] = (const float*)d_in[i];
    a.out = (float*)d_out; a.ws = (unsigned char*)d_ws;
#if MK_PER_PHASE
    for (int p = 0; p < NPHASES; ++p) { a.ph_lo = p; a.ph_hi = p + 1; hipLaunchKernelGGL(mega_fwd, dim3(grid), dim3(NTHR), LDS_BYTES, stream, a); }
#else
    a.ph_lo = 0; a.ph_hi = NPHASES;
    hipLaunchKernelGGL(mega_fwd, dim3(grid), dim3(NTHR), LDS_BYTES, stream, a);
#endif
}
```

```cpp
#include <hip/hip_runtime.h>
#include <cstdio>
#include <cstdint>
namespace pg8 {
#define PG8_LAS __attribute__((address_space(3)))
typedef unsigned short bf16_t;
typedef short bf16x8 __attribute__((ext_vector_type(8)));
typedef float f32x4 __attribute__((ext_vector_type(4)));
typedef unsigned u32x4 __attribute__((ext_vector_type(4)));
constexpr int BM = 256, BK = 64, HALF = 128, HTB = HALF * BK * 2  , STAGE_BYTES = 8 * HTB, NXCD = 8, WGM = 8;

__host__ __device__ __forceinline__ int lds_byte(int r, int c) { const int st = (r >> 4) * 2 + (c >> 5), rr = r & 15, cc = c & 31, ob = rr * 64 + cc * 2; return st * 1024 + (ob ^ (((ob >> 9) & 1) << 5)); }
__host__ __device__ __forceinline__ void stage_rc(int b, int& R, int& C) { const int st = b / 1024, sb = b % 1024, swz = sb ^ (((sb >> 9) & 1) << 5); R = (st >> 1) * 16 + swz / 64; C = (st & 1) * 32 + (swz % 64) / 2; }
__host__ __device__ __forceinline__ int perm32(int rho) { const int n = rho >> 4, i = rho & 15; return 8 * (i >> 2) + 4 * n + (i & 3); }

struct Unit { int pm, pn, ks; };
struct Gemm { const bf16_t* A; const bf16_t* Bt; int M, N, K, Klen; int atm, btm; };

struct StaticOrder {
    int nM, nN, nwg, G, c, rev;
    __host__ __device__ void init(int M, int N, int G_, int c_, int rev_ = 0) { nM = M / BM; nN = N / BM; nwg = nM * nN; G = G_; c = c_; rev = rev_; }
    __host__ __device__ bool next(int i, Unit& u) const {
        const long L = (long)i * G + c; if (L >= nwg) return false;
        int wgid = (int)L; { const int q = nwg / NXCD, r = nwg % NXCD, xcd = wgid % NXCD, off = wgid / NXCD; wgid = (xcd < r ? xcd * (q + 1) : r * (q + 1) + (xcd - r) * q) + off; }
        const int nig = WGM * nN, gid = wgid / nig, fm = gid * WGM, gsz = (nM - fm) < WGM ? (nM - fm) : WGM;
        u.pm = fm + ((wgid % nig) % gsz); u.pn = (wgid % nig) / gsz; u.ks = 0; if (rev) u.pm = nM - 1 - u.pm; return true;
    }
    __device__ __forceinline__ void a_ready(const Unit&) const {}
    __device__ __forceinline__ void done(const Unit&) const {}
};

struct SplitKOrder {
    int pm0, nN, nS, nU, G, c;
    __host__ __device__ void init(int pm0_, int nP, int nN_, int nS_, int G_, int c_) { pm0 = pm0_; nN = nN_; nS = nS_; nU = nP * nN_ * nS_; G = G_; c = c_; }
    __host__ __device__ bool next(int i, Unit& u) const { const int L = i * G + c; if (L >= nU) return false; u.ks = L % nS; u.pn = (L / nS) % nN; u.pm = pm0 + L / (nS * nN); return true; }
    __device__ __forceinline__ void a_ready(const Unit&) const {}
    __device__ __forceinline__ void done(const Unit&) const {}
};

__device__ __forceinline__ unsigned cvt_pk_bf16(float lo, float hi) { unsigned r; asm volatile("v_cvt_pk_bf16_f32 %0, %1, %2" : "=v"(r) : "v"(lo), "v"(hi)); return r; }
typedef float f32x2 __attribute__((ext_vector_type(2)));
__device__ __forceinline__ float fast_sigmoid(float x) { return __builtin_amdgcn_rcpf(1.0f + __expf(-x)); }
struct EpiPlain {
    static constexpr bool PERM = true, AFTER_DRAIN = false;
    bf16_t* O; int ldo;
    __device__ __forceinline__ void operator()(const f32x4 (&acc)[2][2][4][2], const Unit& u, int wr, int wc, int fr, int fq) const {
        const int row0 = u.pm * BM + wr * 64 + fr, col0 = u.pn * BM + wc * 32 + 8 * fq;
#pragma unroll
        for (int ai = 0; ai < 2; ++ai)
#pragma unroll
            for (int m = 0; m < 4; ++m) { bf16_t* rowp = O + (size_t)(row0 + ai * HALF + m * 16) * ldo + col0;
#pragma unroll
                for (int bj = 0; bj < 2; ++bj) { const f32x4 v0 = acc[ai][bj][m][0], v1 = acc[ai][bj][m][1];
                    u32x4 w; w.x = cvt_pk_bf16(v0[0], v0[1]); w.y = cvt_pk_bf16(v0[2], v0[3]); w.z = cvt_pk_bf16(v1[0], v1[1]); w.w = cvt_pk_bf16(v1[2], v1[3]);
                    *(u32x4*)(rowp + bj * HALF) = w; } }
    }
};
struct EpiSwiGLU {
    static constexpr bool PERM = true, AFTER_DRAIN = false;
    bf16_t* O; int ldo;
    __device__ __forceinline__ void operator()(const f32x4 (&acc)[2][2][4][2], const Unit& u, int wr, int wc, int fr, int fq) const {
        const int nkt = ldo / BK, kt = u.pn * 2 + (wc >> 1), c64 = (wc & 1) * 32 + 8 * fq;
        bf16_t* base = O + ((size_t)(u.pm * nkt + kt) * BM) * BK + c64;
#pragma unroll
        for (int ai = 0; ai < 2; ++ai)
#pragma unroll
            for (int m = 0; m < 4; ++m) { bf16_t* rowp = base + (size_t)(wr * 64 + fr + ai * HALF + m * 16) * BK;
                f32x4 a0, a1;
#pragma unroll
                for (int j = 0; j < 4; ++j) { const float g0 = acc[ai][0][m][0][j], g1 = acc[ai][0][m][1][j];
                    a0[j] = g0 * fast_sigmoid(g0) * acc[ai][1][m][0][j]; a1[j] = g1 * fast_sigmoid(g1) * acc[ai][1][m][1][j]; }
                u32x4 w; w.x = cvt_pk_bf16(a0[0], a0[1]); w.y = cvt_pk_bf16(a0[2], a0[3]); w.z = cvt_pk_bf16(a1[0], a1[1]); w.w = cvt_pk_bf16(a1[2], a1[3]);
                *(u32x4*)rowp = w; }
    }
};
struct EpiInProj {
    static constexpr bool PERM = true, AFTER_DRAIN = false;
    bf16_t* XF; bf16_t* XM; bf16_t* A4; float* GT;
    __device__ __forceinline__ void operator()(const f32x4 (&acc)[2][2][4][2], const Unit& u, int wr, int wc, int fr, int fq) const {
        const int row0 = u.pm * BM + wr * 64 + fr;
        if (u.pn < 6) {
            bf16_t* base; int ldo;
            if (u.pn < 2) { base = XF + u.pn * BM; ldo = 512; } else if (u.pn < 4) { base = XM + (u.pn - 2) * BM; ldo = 512; } else { base = A4 + 512 + (u.pn - 4) * BM; ldo = 1024; }
            const int col0 = wc * 32 + 8 * fq;
#pragma unroll
            for (int ai = 0; ai < 2; ++ai)
#pragma unroll
                for (int m = 0; m < 4; ++m) { bf16_t* rowp = base + (size_t)(row0 + ai * HALF + m * 16) * ldo + col0;
#pragma unroll
                    for (int bj = 0; bj < 2; ++bj) { const f32x4 v0 = acc[ai][bj][m][0], v1 = acc[ai][bj][m][1];
                        u32x4 w; w.x = cvt_pk_bf16(v0[0], v0[1]); w.y = cvt_pk_bf16(v0[2], v0[3]); w.z = cvt_pk_bf16(v1[0], v1[1]); w.w = cvt_pk_bf16(v1[2], v1[3]);
                        *(u32x4*)(rowp + bj * HALF) = w; } }
        } else if (wc == 0 && fq < 2) {
#pragma unroll
            for (int ai = 0; ai < 2; ++ai)
#pragma unroll
                for (int m = 0; m < 4; ++m) { float* rowp = GT + (size_t)(row0 + ai * HALF + m * 16) * 16 + 8 * fq;
                    *(f32x4*)rowp = acc[ai][0][m][0]; *(f32x4*)(rowp + 4) = acc[ai][0][m][1]; }
        }
    }
};
struct EpiSlab {
    static constexpr bool PERM = false, AFTER_DRAIN = false;
    float* S; int ldo; int pm0; size_t slab_stride;
    __device__ __forceinline__ void operator()(const f32x4 (&acc)[2][2][4][2], const Unit& u, int wr, int wc, int fr, int fq) const {
        float* base = S + (size_t)u.ks * slab_stride + (size_t)((u.pm - pm0) * BM) * ldo + u.pn * BM;
        unsigned off = (unsigned)((wr * 64 + fr) * ldo + wc * 32 + 4 * fq);
#pragma unroll
        for (int ai = 0; ai < 2; ++ai)
#pragma unroll
            for (int m = 0; m < 4; ++m) { float* rowp = base + off + (unsigned)((ai * HALF + m * 16) * ldo);
#pragma unroll
                for (int bj = 0; bj < 2; ++bj)
#pragma unroll
                    for (int n = 0; n < 2; ++n) *(f32x4*)(rowp + bj * HALF + n * 16) = acc[ai][bj][m][n];
                asm volatile("" ::: "memory"); }
    }
};
template <class Epi, class Sched, bool ALIGN_EPI = false, bool SP2 = false>
__device__ __forceinline__ void gemm_phase(PG8_LAS unsigned char* lds, const Gemm g, const Sched& S, const Epi& E, int tid_in) {
    int tid_ = tid_in; asm volatile("" : "+v"(tid_)); const int tid = tid_, wid = __builtin_amdgcn_readfirstlane(tid >> 6), lane = tid & 63, wr = wid >> 2, wc = wid & 3, fr = lane & 15, fq = lane >> 4;
    const int K = g.K, nt = g.Klen / BK;
    unsigned voffA[2], voffB[2];
#pragma unroll
    for (int i = 0; i < 2; ++i) { int R, C; stage_rc(tid * 16 + i * 8192, R, C); const int Rb = Epi::PERM ? ((R & ~31) + perm32(R & 31)) : R;
        voffA[i] = (unsigned)(R * (g.atm ? BK : K) + C) * 2u; voffB[i] = (unsigned)(Rb * (g.btm ? BK : K) + C) * 2u; }
    const size_t kstepA = g.atm ? (size_t)BM * BK * 2 : (size_t)(BK * 2), hstepA = g.atm ? (size_t)HALF * BK * 2 : (size_t)HALF * K * 2, tstepA = (size_t)BM * K * 2;
    const size_t kstepB = g.btm ? (size_t)BM * BK * 2 : (size_t)(BK * 2), hstepB = g.btm ? (size_t)HALF * BK * 2 : (size_t)HALF * K * 2, tstepB = (size_t)BM * K * 2;
    const unsigned ldsw = (unsigned)wid * 1024u;
    const int aoff = lds_byte(wr * 64 + fr, fq * 8), boff = lds_byte(wc * 32 + fr, fq * 8);
#define PG8_SA(b, h) (((b) * 2 + (h)) * HTB)
#define PG8_SB(b, h) ((4 + (b) * 2 + (h)) * HTB)
#define PG8_STAGE(bufoff, gbase, voff) do { _Pragma("unroll") for (int _i = 0; _i < 2; ++_i) \
        __builtin_amdgcn_global_load_lds((const unsigned*)((const char*)(gbase) + (voff)[_i]), (PG8_LAS unsigned*)(lds + (bufoff) + ldsw + _i * 8192), 16, 0, 0); } while (0)
#define PG8_LDA(dst, b, h) do { _Pragma("unroll") for (int m = 0; m < 4; ++m) _Pragma("unroll") for (int k = 0; k < 2; ++k) dst[m][k] = *(const PG8_LAS bf16x8*)(lds + PG8_SA(b, h) + aoff + m * 2048 + k * 1024); } while (0)
#define PG8_LDB(dst, b, h) do { _Pragma("unroll") for (int n = 0; n < 2; ++n) _Pragma("unroll") for (int k = 0; k < 2; ++k) dst[n][k] = *(const PG8_LAS bf16x8*)(lds + PG8_SB(b, h) + boff + n * 2048 + k * 1024); } while (0)
#define PG8_MMA(ai, bj, At, Bt) do { __builtin_amdgcn_s_setprio(1); _Pragma("unroll") for (int m = 0; m < 4; ++m) _Pragma("unroll") for (int n = 0; n < 2; ++n) _Pragma("unroll") for (int k = 0; k < 2; ++k) \
        acc[ai][bj][m][n] = __builtin_amdgcn_mfma_f32_16x16x32_bf16(Bt[n][k], At[m][k], acc[ai][bj][m][n], 0, 0, 0); __builtin_amdgcn_s_setprio(0); } while (0)
#define PG8_WAIT_V(n) asm volatile("s_waitcnt vmcnt(" #n ")" ::: "memory")
#define PG8_WAIT_L(n) asm volatile("s_waitcnt lgkmcnt(" #n ")" ::: "memory")
#define PG8_BAR __builtin_amdgcn_s_barrier()
#define PG8_SCHED __builtin_amdgcn_sched_barrier(0)
    Unit cur, nxt; int ui = 0;
    if (!S.next(0, cur)) return;
    f32x4 acc[2][2][4][2];
#pragma unroll
    for (int a = 0; a < 2; ++a)
#pragma unroll
        for (int b = 0; b < 2; ++b)
#pragma unroll
            for (int m = 0; m < 4; ++m)
#pragma unroll
                for (int n = 0; n < 2; ++n) acc[a][b][m][n] = (f32x4){0.f, 0.f, 0.f, 0.f};
    bf16x8 At[4][2], B0[2][2], B1[2][2];
    const size_t sstepA = (size_t)(g.Klen / BK) * kstepA, sstepB = (size_t)(g.Klen / BK) * kstepB;
    const char* cA = (const char*)g.A + (size_t)cur.pm * tstepA + (size_t)cur.ks * sstepA; const char* cB = (const char*)g.Bt + (size_t)cur.pn * tstepB + (size_t)cur.ks * sstepB;
    S.a_ready(cur);
    if constexpr (SP2) {
        PG8_STAGE(PG8_SB(0, 0), cB, voffB); PG8_STAGE(PG8_SB(0, 1), cB + hstepB, voffB); PG8_STAGE(PG8_SA(0, 0), cA, voffA); PG8_STAGE(PG8_SA(0, 1), cA + hstepA, voffA);
        if (wr == 1) PG8_BAR;
        PG8_WAIT_V(2); PG8_BAR;
        PG8_STAGE(PG8_SB(1, 0), cB + kstepB, voffB); PG8_STAGE(PG8_SA(1, 0), cA + kstepA, voffA); PG8_STAGE(PG8_SB(1, 1), cB + hstepB + kstepB, voffB);
        PG8_WAIT_V(6); PG8_BAR;
    } else {
        PG8_STAGE(PG8_SB(0, 0), cB, voffB); PG8_STAGE(PG8_SA(0, 0), cA, voffA); PG8_STAGE(PG8_SB(0, 1), cB + hstepB, voffB); PG8_STAGE(PG8_SA(0, 1), cA + hstepA, voffA);
        if (wr == 1) PG8_BAR;
        PG8_WAIT_V(4); PG8_BAR;
        PG8_STAGE(PG8_SB(1, 0), cB + kstepB, voffB); PG8_STAGE(PG8_SA(1, 0), cA + kstepA, voffA); PG8_STAGE(PG8_SB(1, 1), cB + hstepB + kstepB, voffB);
        PG8_WAIT_V(6); PG8_BAR;
    }
    for (;;) {
        const bool has_next = S.next(ui + 1, nxt);
        const char* nA = has_next ? (const char*)g.A + (size_t)nxt.pm * tstepA + (size_t)nxt.ks * sstepA : cA; const char* nB = has_next ? (const char*)g.Bt + (size_t)nxt.pn * tstepB + (size_t)nxt.ks * sstepB : cB;
        for (int t = 0; t < nt; t += 2) {
            const bool last = (t == nt - 2);
            const char* a1 = cA + (size_t)(t + 1) * kstepA;
            const char* a2 = last ? nA : cA + (size_t)(t + 2) * kstepA; const char* b2 = last ? nB : cB + (size_t)(t + 2) * kstepB;
            const char* a3 = a2 + kstepA; const char* b3 = b2 + kstepB;
            if (last && has_next) S.a_ready(nxt);
            if constexpr (SP2) {
            PG8_LDB(B0, 0, 0); PG8_LDB(B1, 0, 1); PG8_SCHED; PG8_LDA(At, 0, 0); PG8_STAGE(PG8_SA(1, 1), a1 + hstepA, voffA);
            PG8_WAIT_V(8); PG8_WAIT_L(0); PG8_BAR; PG8_MMA(0, 0, At, B0); PG8_MMA(0, 1, At, B1); PG8_BAR; PG8_SCHED;
            PG8_LDA(At, 0, 1); PG8_STAGE(PG8_SB(0, 0), b2, voffB); PG8_STAGE(PG8_SB(0, 1), b2 + hstepB, voffB); PG8_STAGE(PG8_SA(0, 0), a2, voffA);
            PG8_WAIT_V(8); PG8_WAIT_L(0); PG8_BAR; PG8_MMA(1, 0, At, B0); PG8_MMA(1, 1, At, B1); PG8_BAR; PG8_SCHED;
            PG8_LDB(B0, 1, 0); PG8_LDB(B1, 1, 1); PG8_SCHED; PG8_LDA(At, 1, 0); PG8_STAGE(PG8_SA(0, 1), a2 + hstepA, voffA);
            PG8_WAIT_V(8); PG8_WAIT_L(0); PG8_BAR; PG8_MMA(0, 0, At, B0); PG8_MMA(0, 1, At, B1); PG8_BAR; PG8_SCHED;
            PG8_LDA(At, 1, 1); PG8_STAGE(PG8_SB(1, 0), b3, voffB); PG8_STAGE(PG8_SB(1, 1), b3 + hstepB, voffB); PG8_STAGE(PG8_SA(1, 0), a3, voffA);
            PG8_WAIT_V(8); PG8_WAIT_L(0); PG8_BAR; PG8_MMA(1, 0, At, B0); PG8_MMA(1, 1, At, B1); PG8_BAR; PG8_SCHED;
            } else {
            PG8_LDB(B0, 0, 0); PG8_SCHED; PG8_LDA(At, 0, 0); PG8_STAGE(PG8_SA(1, 1), a1 + hstepA, voffA);
            PG8_WAIT_L(8); PG8_BAR; PG8_WAIT_L(0); PG8_MMA(0, 0, At, B0); PG8_BAR; PG8_SCHED;
            PG8_LDB(B1, 0, 1); PG8_STAGE(PG8_SB(0, 0), b2, voffB);
            PG8_BAR; PG8_WAIT_L(0); PG8_MMA(0, 1, At, B1); PG8_BAR;
            PG8_LDA(At, 0, 1); PG8_STAGE(PG8_SA(0, 0), a2, voffA);
            PG8_BAR; PG8_WAIT_L(0); PG8_MMA(1, 0, At, B0); PG8_BAR; PG8_SCHED;
            PG8_STAGE(PG8_SB(0, 1), b2 + hstepB, voffB);
            PG8_WAIT_V(6); PG8_BAR; PG8_MMA(1, 1, At, B1); PG8_BAR;
            PG8_LDB(B0, 1, 0); PG8_SCHED; PG8_LDA(At, 1, 0); PG8_STAGE(PG8_SA(0, 1), a2 + hstepA, voffA);
            PG8_WAIT_L(8); PG8_BAR; PG8_WAIT_L(0); PG8_MMA(0, 0, At, B0); PG8_BAR; PG8_SCHED;
            PG8_LDB(B1, 1, 1); PG8_STAGE(PG8_SB(1, 0), b3, voffB);
            PG8_BAR; PG8_WAIT_L(0); PG8_MMA(0, 1, At, B1); PG8_BAR;
            PG8_LDA(At, 1, 1); PG8_STAGE(PG8_SA(1, 0), a3, voffA);
            PG8_BAR; PG8_WAIT_L(0); PG8_MMA(1, 0, At, B0); PG8_BAR; PG8_SCHED;
            PG8_STAGE(PG8_SB(1, 1), b3 + hstepB, voffB);
            PG8_WAIT_V(6); PG8_BAR; PG8_MMA(1, 1, At, B1); PG8_BAR;
            }
        }
        if constexpr (ALIGN_EPI) { if (wr == 0) PG8_BAR; }
        if constexpr (!Epi::AFTER_DRAIN) { E(acc, cur, wr, wc, fr, fq); S.done(cur); }
        if (!has_next) break;
#pragma unroll
        for (int a = 0; a < 2; ++a)
#pragma unroll
            for (int b = 0; b < 2; ++b)
#pragma unroll
                for (int m = 0; m < 4; ++m)
#pragma unroll
                    for (int n = 0; n < 2; ++n) acc[a][b][m][n] = (f32x4){0.f, 0.f, 0.f, 0.f};
        cur = nxt; cA = nA; cB = nB; ++ui;
        if constexpr (ALIGN_EPI) { if (wr == 1) PG8_BAR; }
    }
    PG8_WAIT_V(0);
    if constexpr (!ALIGN_EPI) { if (wr == 0) PG8_BAR; }
    PG8_BAR;
    if constexpr (Epi::AFTER_DRAIN) { E.fused(acc, cur, wr, wc, fr, fq, lds, wid, lane); S.done(cur); }
#undef PG8_SA
#undef PG8_SB
#undef PG8_STAGE
#undef PG8_LDA
#undef PG8_LDB
#undef PG8_MMA
#undef PG8_WAIT_V
#undef PG8_WAIT_L
#undef PG8_BAR
#undef PG8_SCHED
}
}
constexpr int NWAVES = 8, NTHR = 512;
constexpr int DM = 1024, NB = 4, SEQ = 8192, DEPTH = 2, CTXL = 256, DFF = 2816, DINP = 1552, DIN_PAD = 1792;
constexpr int TL = NB * SEQ, TC = NB * CTXL, TT = TL + TC;
constexpr int NH = 4, HD = 128, NMOD = 9;
constexpr int NCG = TT / 128;
constexpr int NUID = NCG * NH;
constexpr float EPSN = 1e-6f;

constexpr size_t MiB = 1u << 20;
constexpr size_t WS_CTL = 0, CTL_ZERO_BYTES = 1 * MiB;
constexpr size_t WS_MOD = 1 * MiB;
constexpr size_t WS_TAB = 2 * MiB;
constexpr size_t WS_WQKV = 3 * MiB;
constexpr size_t WS_XC = 4 * MiB;
constexpr size_t WS_WFFIN = 8 * MiB;
constexpr size_t WS_WFFOUT = 52 * MiB;
constexpr size_t WS_WIN = 74 * MiB;
constexpr size_t WS_WOUT = 81 * MiB;
constexpr size_t WS_XB = 88 * MiB;
constexpr size_t WS_Y = 154 * MiB;
constexpr size_t WS_R = 220 * MiB;
constexpr size_t WS_ACT = WS_R;
constexpr size_t WS_Q = WS_R;
constexpr size_t WS_K = WS_R + 33 * MiB;
constexpr size_t WS_VT = WS_R + 66 * MiB;
constexpr size_t WS_CL = WS_R + 99 * MiB;
constexpr size_t WS_A4 = WS_R + 165 * MiB;
constexpr size_t WS_GT = WS_R + 264 * MiB;
constexpr size_t WS_GA = WS_R + 267 * MiB;
constexpr size_t WS_NL = WS_R + 270 * MiB;
constexpr size_t WS_SC = WS_R + 272 * MiB;
constexpr size_t WS_WC = WS_R + 273 * MiB;
constexpr size_t WS_END = WS_R + 274 * MiB;
constexpr size_t WS_SLAB2 = WS_R + 184 * MiB;
constexpr size_t WS_SLAB4 = WS_R;
static_assert(WS_ACT + (size_t)TT * DFF * 2 <= 512 * MiB && WS_END <= 512 * MiB, "d_ws map");
static_assert((size_t)TT * 1024 * 2 <= 99 * MiB && (size_t)2 * NUID * 32768 <= 66 * MiB && (size_t)TT * 512 * 2 <= 33 * MiB, "d_ws map 2");
constexpr int CW_BAR = 4096;
constexpr size_t TAB_W1 = 0;
constexpr size_t TAB_W2 = 65536;
constexpr size_t TAB_TW = 131072;
constexpr size_t TAB_PQF = 196608;
constexpr size_t TAB_PQ32 = 458752;

constexpr int LDS_BYTES = 163840;
constexpr int MISC_OFF = LDS_BYTES - 256;
constexpr int SCR_BYTES = MISC_OFF;

#define GAS __attribute__((address_space(1)))
#define LAS __attribute__((address_space(3)))
typedef unsigned short bf16;
typedef unsigned v4u __attribute__((ext_vector_type(4)));
typedef unsigned v2u __attribute__((ext_vector_type(2)));
typedef float f32x4 __attribute__((ext_vector_type(4)));
typedef float f32x2 __attribute__((ext_vector_type(2)));
typedef short bf16x8 __attribute__((ext_vector_type(8)));
typedef short s16x4 __attribute__((ext_vector_type(4)));
typedef GAS unsigned gu32;
#define RLX_AGENT __ATOMIC_RELAXED, __HIP_MEMORY_SCOPE_AGENT
#define LDS_WAIT() asm volatile("s_waitcnt lgkmcnt(0)" ::: "memory")
#define VM_WAIT() asm volatile("s_waitcnt vmcnt(0)" ::: "memory")
#define VM_DONE() __builtin_amdgcn_s_waitcnt(0x0F70)
__device__ __forceinline__ float bf2f(unsigned b) { return __builtin_bit_cast(float, b << 16); }
typedef __bf16 bf16x2_t __attribute__((ext_vector_type(2)));
__device__ __forceinline__ unsigned pk2(float lo, float hi) { const f32x2 v = {lo, hi}; const bf16x2_t b = __builtin_convertvector(v, bf16x2_t); return __builtin_bit_cast(unsigned, b); }
__device__ __forceinline__ float wave_sum(float v) {
#pragma unroll
    for (int o = 1; o < 64; o <<= 1) v += __shfl_xor(v, o);
    return v;
}
__device__ __forceinline__ f32x4 mfma16(bf16x8 a, bf16x8 b, f32x4 c) { return __builtin_amdgcn_mfma_f32_16x16x32_bf16(a, b, c, 0, 0, 0); }
__device__ __forceinline__ float logsigf(float x) { return fminf(x, 0.f) - log1pf(__expf(-fabsf(x))); }

#ifndef DUPMASK
#define DUPMASK 0
#endif
#define REP(bit) _Pragma("unroll 1") for (int rep_ = 0; rep_ < 1 + ((DUPMASK >> (bit)) & 1); ++rep_)
__device__ __forceinline__ void lds_barrier() { asm volatile("s_waitcnt lgkmcnt(0)" ::: "memory"); __builtin_amdgcn_s_barrier(); asm volatile("" ::: "memory"); }
#define XB_TMO      128
#define XB_XCNT(j)  (256  + 64 * (j))
#define XB_XSUB(j)  (1280 + 64 * (j))
#define XB_XGEN(j)  (2304 + 64 * (j))
#define XB_TOP      3328
#define XB_TOPGEN   3392
#define XCD_BAR_WORDS 3456
#define XB_SPIN_CAP (1u << 18)

__device__ __forceinline__ unsigned xb_ld(unsigned* p)              { return __hip_atomic_load(p, __ATOMIC_RELAXED, __HIP_MEMORY_SCOPE_AGENT); }
__device__ __forceinline__ unsigned xb_add(unsigned* p, unsigned v) { return __hip_atomic_fetch_add(p, v, __ATOMIC_RELAXED, __HIP_MEMORY_SCOPE_AGENT); }
__device__ __forceinline__ unsigned xb_xcc_id() { return (unsigned)__builtin_amdgcn_s_getreg((3 << 11) | 20) & 0xFu; }
#define XB_SPIN(cond, bar) do { unsigned _sp = 0; while (cond) { __builtin_amdgcn_s_sleep(1); \
    if ((++_sp & 255u) == 0u) { if (xb_ld(&(bar)[XB_TMO])) break; if (_sp > XB_SPIN_CAP) { atomicAdd(&(bar)[XB_TMO], 1u); break; } } } } while (0)

struct XcdBarrier {
    unsigned* bar; unsigned x;
    volatile LAS unsigned* st;
};

__device__ __forceinline__ XcdBarrier xcd_barrier_post(unsigned* bar, volatile LAS unsigned* st) {
    XcdBarrier b; b.bar = bar; b.x = xb_xcc_id(); b.st = st;
    if (threadIdx.x == 0) (void)xb_add(&bar[XB_XCNT(b.x)], 1u);
    return b;
}
__device__ __forceinline__ void xcd_barrier_complete(unsigned* bar, unsigned x, unsigned& nloc, unsigned& nx, const unsigned G) {
    unsigned sum, cnt, mine, sp = 0u;
    for (;;) {
        sum = 0u; cnt = 0u; mine = 0u;
#pragma unroll
        for (unsigned j = 0; j < 16; ++j) { const unsigned c = xb_ld(&bar[XB_XCNT(j)]); sum += c; cnt += (c > 0u) ? 1u : 0u; mine = (j == x) ? c : mine; }
        if (sum == G) break;
        __builtin_amdgcn_s_sleep(1);
        if ((++sp & 255u) == 0u) { if (xb_ld(&bar[XB_TMO])) break; if (sp > XB_SPIN_CAP) { atomicAdd(&bar[XB_TMO], 1u); break; } }
    }
    nloc = mine > 0u ? mine : 1u; nx = cnt > 0u ? cnt : 1u;
}

__device__ __attribute__((noinline)) void xcd_barrier(unsigned* bar_, unsigned x_, volatile LAS unsigned* st_, int tid_, unsigned G_) { XcdBarrier b; b.bar = bar_; b.x = x_; b.st = st_;
    asm volatile("s_waitcnt vmcnt(0)" ::: "memory");
    __syncthreads();
    if (tid_ == 0) {
        unsigned* bar = b.bar;
        __builtin_amdgcn_s_waitcnt(0);
        unsigned nloc = b.st[0], nx = b.st[1];
        if (nloc == 0u) { xcd_barrier_complete(bar, b.x, nloc, nx, G_); b.st[0] = nloc; b.st[1] = nx; }
        const unsigned old = xb_add(&bar[XB_XSUB(b.x)], 1u);
        const unsigned gen = old / nloc;
        if (old + 1u == (gen + 1u) * nloc) {
            __builtin_amdgcn_fence(__ATOMIC_RELEASE, "agent");
            asm volatile("s_waitcnt vmcnt(0)" ::: "memory");
            const unsigned og = xb_add(&bar[XB_TOP], 1u);
            const unsigned tg = og / nx;
            if (og + 1u == (tg + 1u) * nx) xb_add(&bar[XB_TOPGEN], 1u);
            else XB_SPIN(xb_ld(&bar[XB_TOPGEN]) == tg, bar);
            __builtin_amdgcn_fence(__ATOMIC_ACQUIRE, "agent");
            xb_add(&bar[XB_XGEN(b.x)], 1u);
            asm volatile("s_waitcnt vmcnt(0)" ::: "memory");
        } else {
            XB_SPIN(xb_ld(&bar[XB_XGEN(b.x)]) == gen, bar);
            __builtin_amdgcn_fence(__ATOMIC_ACQUIRE, "agent");
            asm volatile("s_waitcnt vmcnt(0)" ::: "memory");
        }
    }
    __syncthreads();
}
struct Frame {
    LAS unsigned char* lds;
    volatile LAS unsigned* MISC;
    gu32* ctl;
    int tid, lane, wave;
    int vcu, G, bid;
    unsigned char* ws;
};
constexpr int PTAB_OFF = MISC_OFF + 64;
__device__ __forceinline__ unsigned long long ptab(const Frame& F, int i) { const LAS unsigned* p = (const LAS unsigned*)(F.lds + PTAB_OFF) + 2 * i;
    const unsigned lo = __builtin_amdgcn_readfirstlane(p[0]), hi = __builtin_amdgcn_readfirstlane(p[1]); return ((unsigned long long)hi << 32) | lo; }
#define FIN(i) ((const float*)(const GAS float*)ptab(F, (i)))
#define FOUT ((float*)(GAS float*)ptab(F, 17))
enum { I_X = 0, I_C, I_CTX, I_CCTX, I_WADA, I_BADA, I_NORMW, I_WFFIN, I_WFFOUT, I_WIN, I_WFMIX, I_CONVW, I_CONVB, I_WQKV, I_GATEB, I_HNW, I_WOUT };
#define WSP(T, off) ((T*)(F.ws + (off)))

__device__ __forceinline__ void p0_transpose_item(const float* W, int ldn, int nvalid, int k0, int n0, bf16* WT, int ldw, int drow, int dcol, float scale, LAS float* scr, int lane, int tm = 0) {
    const int c4 = (lane & 7) * 4; const bool ok = (n0 + c4) < nvalid;
#pragma unroll
    for (int i = 0; i < 8; ++i) { const int kk = 8 * i + (lane >> 3); const f32x4 v = ok ? *(const f32x4*)(W + (size_t)(k0 + kk) * ldn + n0 + c4) * scale : (f32x4){0.f, 0.f, 0.f, 0.f};
        LAS float* d = scr + kk * 33 + c4; d[0] = v[0]; d[1] = v[1]; d[2] = v[2]; d[3] = v[3]; }
    LDS_WAIT(); asm volatile("" ::: "memory");
    const int c = lane & 7;
#pragma unroll
    for (int j = 0; j < 4; ++j) { const int n = (lane >> 3) + 8 * j; const LAS float* s = scr + (8 * c) * 33 + n;
        v4u o; o.x = pk2(s[0 * 33], s[1 * 33]); o.y = pk2(s[2 * 33], s[3 * 33]); o.z = pk2(s[4 * 33], s[5 * 33]); o.w = pk2(s[6 * 33], s[7 * 33]);
        const int rr = drow + n, kk0 = dcol + k0;
        if (tm) *(v4u*)(WT + (((size_t)(rr >> 8) * (ldw >> 6) + (kk0 >> 6)) * 256 + (rr & 255)) * 64 + (kk0 & 63) + 8 * c) = o;
        else *(v4u*)(WT + (size_t)rr * ldw + kk0 + 8 * c) = o; }
    LDS_WAIT(); asm volatile("" ::: "memory");
}

__device__ __forceinline__ void mod_first(Frame& F) {
    const int ncol = 2048 / F.G;
    if (ncol != 8) return;
    const int c0 = 8 * F.vcu, kc = F.tid >> 1, q = F.tid & 1;
    const float* cin = FIN(I_C); const float* cctx = FIN(I_CCTX); const float* wada = FIN(I_WADA);
    f32x4 a[5];
#pragma unroll
    for (int bi = 0; bi < 5; ++bi) a[bi] = (f32x4){0.f, 0.f, 0.f, 0.f};
#pragma unroll
    for (int kk = 0; kk < 4; ++kk) { const int k = 4 * kc + kk; const f32x4 w = *(const f32x4*)(wada + (size_t)k * (NMOD * DM) + c0 + 4 * q);
#pragma unroll
        for (int bi = 0; bi < 5; ++bi) { const float v = (bi < 4) ? cin[bi * DM + k] : cctx[k]; a[bi] += w * (v / (1.f + __expf(-v))); } }
    LAS f32x4* red = (LAS f32x4*)F.lds;
#pragma unroll
    for (int bi = 0; bi < 5; ++bi) red[(kc * 2 + q) * 5 + bi] = a[bi];
    __syncthreads();
    if (F.tid < 40) { const int bi = F.tid >> 3, col = F.tid & 7; float s = FIN(I_BADA)[c0 + col];
        for (int k2 = 0; k2 < 256; ++k2) s += red[(k2 * 2 + (col >> 2)) * 5 + bi][col & 3];
        WSP(float, WS_MOD)[(size_t)bi * (NMOD * DM) + c0 + col] = s; }
    __syncthreads();
}
__device__ __forceinline__ void p0_prologue(Frame& F, const int stage, const int wgi, const int NWG) {
    const int gw = wgi * NWAVES + F.wave, NGW = NWG * NWAVES;
    const float* const p_w_ff_in = FIN(I_WFFIN); const float* const p_w_ff_out = FIN(I_WFFOUT); const float* const p_w_in = FIN(I_WIN); const float* const p_w_out = FIN(I_WOUT); const float* const p_w_qkv = FIN(I_WQKV);
    {
        LAS float* scr = (LAS float*)(F.lds + F.wave * 16384);
        constexpr int I_FI = (DM / 64) * (2 * DFF / 32);
        constexpr int I_FO = (DFF / 64) * (DM / 32);
        constexpr int I_IN = (DM / 64) * 49;
        constexpr int I_WO = (DM / 64) * (DM / 32);
        constexpr int I_QK = 12 * 2 * 4;
        constexpr int I_ZR = 224 / 4;
        constexpr int PER_L = 2 * I_FI + 2 * I_FO + I_IN + I_WO + I_QK + I_ZR;
        const int r_lo = (stage == 1) ? I_FI : 0, r_hi = (stage == 0) ? I_FI : (stage == 3 ? DEPTH * PER_L : PER_L);
        REP(22) for (int it = gw; it < r_hi - r_lo; it += NGW) {
            const int l = (stage == 3) ? (r_lo + it) / PER_L : ((stage == 2) ? 1 : 0); int r = (r_lo + it) % PER_L;
            if (r < 2 * I_FI) { const int f = r / I_FI; r %= I_FI; const int nb = r % 176, kb = r / 176; const int n0 = nb * 32;
                const int drow = (n0 < DFF) ? (256 * (n0 >> 7) + (n0 & 127)) : (256 * ((n0 - DFF) >> 7) + 128 + ((n0 - DFF) & 127));
                p0_transpose_item(p_w_ff_in + (size_t)(l * 2 + f) * DM * 2 * DFF, 2 * DFF, 2 * DFF, kb * 64, n0, WSP(bf16, WS_WFFIN) + (size_t)(l * 2 + f) * 2 * DFF * DM, DM, drow, 0, 1.f, scr, F.lane); continue; }
            r -= 2 * I_FI;
            if (r < 2 * I_FO) { const int f = r / I_FO; r %= I_FO; const int nb = r % 32, kb = r / 32;
                p0_transpose_item(p_w_ff_out + (size_t)(l * 2 + f) * DFF * DM, DM, DM, kb * 64, nb * 32, WSP(bf16, WS_WFFOUT) + (size_t)(l * 2 + f) * DM * DFF, DFF, nb * 32, 0, 1.f, scr, F.lane, 1); continue; }
            r -= 2 * I_FO;
            if (r < I_IN) { const int nb = r % 49, kb = r / 49;
                p0_transpose_item(p_w_in + (size_t)l * DM * DINP, DINP, DINP, kb * 64, nb * 32, WSP(bf16, WS_WIN) + (size_t)l * DIN_PAD * DM, DM, nb * 32, 0, 1.f, scr, F.lane); continue; }
            r -= I_IN;
            if (r < I_WO) { const int nb = r % 32, kb = r / 32;
                p0_transpose_item(p_w_out + (size_t)l * DM * DM, DM, DM, kb * 64, nb * 32, WSP(bf16, WS_WOUT) + (size_t)l * DM * DM, DM, nb * 32, 0, 1.f, scr, F.lane); continue; }
            r -= I_WO;
            if (r < I_QK) { const int mat = r / 8, q = r % 8, nb = q % 4, kb = q / 4;
                p0_transpose_item(p_w_qkv + ((size_t)l * 12 + mat) * HD * HD, HD, HD, kb * 64, nb * 32, WSP(bf16, WS_WQKV) + ((size_t)l * 12 + mat) * HD * HD, HD, nb * 32, 0, (mat / 4 == 1) ? 0.08838834764831845f : 1.f, scr, F.lane); continue; }
            r -= I_QK;
            { bf16* z = WSP(bf16, WS_WIN) + (size_t)l * DIN_PAD * DM + (size_t)(1568 + 4 * r) * DM;
#pragma unroll
              for (int j = 0; j < 8; ++j) *(v4u*)(z + (size_t)(j * 64 + F.lane) * 8) = (v4u){0u, 0u, 0u, 0u}; }
        }
    }
    __syncthreads();
    constexpr int I_MOD = DEPTH * (NMOD * DM / 64);
    constexpr int I_FW = DEPTH * 8;
    constexpr int I_TB = 112 + 256;
    const int b_lo = (stage == 0 || stage == 3) ? 0 : (stage == 1 ? I_MOD : I_MOD + I_FW / 2), b_hi = (stage == 0) ? I_MOD : (stage == 1 ? I_MOD + I_FW / 2 : I_MOD + I_FW);
    REP(23) for (int it0 = wgi; it0 < b_hi - b_lo + ((stage == 1 || stage == 3) ? I_TB : 0); it0 += NWG) {
        const int it = (b_lo + it0 < b_hi) ? b_lo + it0 : I_MOD + I_FW + (b_lo + it0 - b_hi);
        if (it < I_MOD) {
            if (it < 32 && F.G == 256) continue;
            const int l = it / 144, j0 = (it % 144) * 64;
            LAS float* sc = (LAS float*)F.lds;
            LAS float* red = (LAS float*)(F.lds + 20480);
            for (int i = F.tid; i < 5 * DM; i += NTHR) { const int bi = i >> 10, k = i & 1023; const float v = (bi < 4) ? FIN(I_C)[bi * DM + k] : FIN(I_CCTX)[k]; sc[i] = v / (1.f + __expf(-v)); }
            __syncthreads();
            const int q = F.tid & 15, kc = F.tid >> 4;
            f32x4 a[5];
#pragma unroll
            for (int bi = 0; bi < 5; ++bi) a[bi] = (f32x4){0.f, 0.f, 0.f, 0.f};
            const float* wp = FIN(I_WADA) + (size_t)l * DM * NMOD * DM + (size_t)(kc * 32) * (NMOD * DM) + j0 + 4 * q;
#pragma unroll 16
            for (int k = 0; k < 32; ++k) { const f32x4 w = *(const f32x4*)(wp + (size_t)k * (NMOD * DM));
#pragma unroll
                for (int bi = 0; bi < 5; ++bi) a[bi] += w * sc[bi * DM + kc * 32 + k]; }
#pragma unroll
            for (int bi = 0; bi < 5; ++bi) *(LAS f32x4*)(red + (kc * 5 + bi) * 64 + 4 * q) = a[bi];
            __syncthreads();
            if (F.tid < 320) { const int bi = F.tid >> 6, col = F.tid & 63; float s = FIN(I_BADA)[l * NMOD * DM + j0 + col];
                for (int k2 = 0; k2 < 32; ++k2) s += red[(k2 * 5 + bi) * 64 + col];
                WSP(float, WS_MOD)[((size_t)l * 5 + bi) * (NMOD * DM) + j0 + col] = s; }
            __syncthreads();
        } else if (it < I_MOD + I_FW) {
            const int r = it - I_MOD, g = r & 7, l = r >> 3;
            LAS float* tab = (LAS float*)F.lds;
            LAS float* FM = (LAS float*)(F.lds + 1024);
            LAS float* PQ = (LAS float*)(F.lds + 1024 + 16384);
            if (F.tid < 64) { float sv, cv; sincospif((float)F.tid * (1.f / 32.f), &sv, &cv); tab[F.tid] = 0.125f * cv; tab[64 + F.tid] = -0.125f * sv; }
            for (int i = F.tid; i < 4096; i += NTHR) FM[i] = FIN(I_WFMIX)[((size_t)l * 8 + g) * 4096 + i];
            __syncthreads();
            { const int d4 = (F.tid & 15) * 4, c0 = F.tid >> 4;
              f32x4 s0 = {0.f, 0.f, 0.f, 0.f}, s1 = s0, t0 = s0, t1 = s0;
#pragma unroll 8
              for (int e = 0; e < 64; ++e) { const f32x4 fm = *(const LAS f32x4*)(FM + e * 64 + d4); const int m0 = (c0 * e) & 63, m1 = ((c0 + 32) * e) & 63;
                  s0 += fm * tab[m0]; s1 += fm * tab[m1]; t0 += fm * tab[64 + m0]; t1 += fm * tab[64 + m1]; }
              *(LAS f32x4*)(PQ + c0 * 64 + d4) = s0; *(LAS f32x4*)(PQ + (c0 + 32) * 64 + d4) = s1; *(LAS f32x4*)(PQ + 4096 + c0 * 64 + d4) = t0; *(LAS f32x4*)(PQ + 4096 + (c0 + 32) * 64 + d4) = t1; }
            __syncthreads();
            { float* o32 = (float*)(F.ws + WS_TAB + TAB_PQ32) + ((size_t)l * 8 + g) * 8192;
              for (int i = F.tid; i < 8192; i += NTHR) o32[i] = PQ[i];
              bf16* of = (bf16*)(F.ws + WS_TAB + TAB_PQF) + ((size_t)l * 8 + g) * 8192;
              for (int i = F.tid; i < 8192; i += NTHR) { const int e = i & 7, ln = (i >> 3) & 63, ks = (i >> 9) & 3, nd = i >> 11;
                  const int d = 16 * nd + (ln & 15), c = 32 * (ks & 1) + 16 * (e >> 2) + 4 * (ln >> 4) + (e & 3);
                  of[i] = (bf16)(pk2(PQ[(ks >> 1) * 4096 + c * 64 + d], 0.f) & 0xffffu); } }
            __syncthreads();
        } else {
            const int ti = it - I_MOD - I_FW;
            if (ti < 64) {
                bf16* o = (bf16*)(F.ws + WS_TAB + TAB_W1);
                { const int i = ti * NTHR + F.tid; const int e = i & 7, ln = (i >> 3) & 63, t = (i >> 9) & 3, tl = (i >> 11) & 1, w = i >> 12;
                    const int g = ln >> 4, k1 = 16 * w + (ln & 15), s1 = 32 * t + 16 * (g >> 1) + 8 * (e >> 2) + 4 * (g & 1) + (e & 3);
                    float sv, cv; sincospif((float)((k1 * s1) & 127) * (1.f / 64.f), &sv, &cv);
                    o[i] = (bf16)(pk2(tl ? sv : cv, 0.f) & 0xffffu); }
            } else if (ti < 96) {
                bf16* o = (bf16*)(F.ws + WS_TAB + TAB_W2);
                { const int i = (ti - 64) * NTHR + F.tid; const int e = i & 7, ln = (i >> 3) & 63, t = (i >> 9) & 3, w = i >> 11;
                    const int g = ln >> 4, k2 = 16 * (w & 3) + (ln & 15), sp = 32 * t + 16 * (g >> 1) + 8 * (e >> 2) + 4 * (g & 1) + (e & 3), s2 = sp & 63, inim = sp >> 6, outim = w >> 2;
                    float sv, cv; sincospif((float)((k2 * s2) & 63) * (1.f / 32.f), &sv, &cv);
                    const float v = outim ? (inim ? cv : sv) : (inim ? -sv : cv);
                    o[i] = (bf16)(pk2(v, 0.f) & 0xffffu); }
            } else if (ti >= 112) {
                bf16* o = (bf16*)(F.ws + WS_WC);
                { const int i = (ti - 112) * NTHR + F.tid; const int e = i & 7, ln = (i >> 3) & 63, t = (i >> 9) & 7, tl = (i >> 12) & 1, w = i >> 13;
                    const int g = ln >> 4, k = 16 * w + (ln & 15), sp = 32 * t + 16 * (g >> 1) + 8 * (e >> 2) + 4 * (g & 1) + (e & 3);
                    float sv, cv; sincospif((float)((k * sp) & 255) * (1.f / 128.f), &sv, &cv);
                    o[i] = (bf16)(pk2(0.0625f * (tl ? sv : cv), 0.f) & 0xffffu); }
            } else {
                f32x2* o = (f32x2*)(F.ws + WS_TAB + TAB_TW);
                { const int i = (ti - 96) * NTHR + F.tid; const int s2 = i & 63, k1 = i >> 6; float sv, cv; sincospif((float)(k1 * s2) * (1.f / 4096.f), &sv, &cv);
                    o[i] = (f32x2){cv * 0.011048543456039806f, sv * 0.011048543456039806f}; }
            }
        }
    }
}

struct Thin {
    const void* xin_l; const float* xin_c;
    void* xout_l; float* xout_c;
    const bf16* Y;
    const float* YS;
    const float* nw_post; const float* gate;
    bf16* H; const float* nw_pre; const float* scale; const float* shift;
    float fac; int nslab; int nrows; int xin_bf, xout_bf;
};
#ifdef DBG_FLAGS
#define DBG_FLAG(bit) __hip_atomic_fetch_or((unsigned*)(F.ctl + 64), 1u << (bit), __ATOMIC_RELAXED, __HIP_MEMORY_SCOPE_AGENT)
#else
#define DBG_FLAG(bit) do {} while (0)
#endif
#ifdef DBG_FLAGS
#define DBG_CHK(val, bit) do { if (!(fabsf(val) < 1e30f)) DBG_FLAG(bit); } while (0)
#else
#define DBG_CHK(val, bit) do {} while (0)
#endif
__device__ __forceinline__ void thin_finish(Frame& F, const Thin& P, const int r, f32x4 (&x)[4], const f32x4 (&y)[4], const f32x4 (&A1)[4], const f32x4 (&A2)[4], const f32x4 (&A3)[4], const bool dry) {
    if (P.Y) { float ss = 0.f;
#pragma unroll
        for (int j = 0; j < 4; ++j) ss += (y[j].x * y[j].x + y[j].y * y[j].y) + (y[j].z * y[j].z + y[j].w * y[j].w);
        const float rs = 1.0f / sqrtf(wave_sum(ss) * (1.f / DM) + EPSN);
#pragma unroll
        for (int j = 0; j < 4; ++j) x[j] += A1[j] * (y[j] * rs); }
    if (r < TL) { if (P.xout_l) { if (P.xout_bf) { bf16* xo = (dry ? WSP(bf16, WS_ACT) : (bf16*)P.xout_l) + (size_t)r * DM;
#pragma unroll
                for (int j = 0; j < 4; ++j) { v2u w; w.x = pk2(x[j].x, x[j].y); w.y = pk2(x[j].z, x[j].w); *(v2u*)(xo + 4 * F.lane + 256 * j) = w; } }
            else { float* xo = (dry ? WSP(float, WS_ACT) : (float*)P.xout_l) + (size_t)r * DM;
#pragma unroll
                for (int j = 0; j < 4; ++j) *(f32x4*)(xo + 4 * F.lane + 256 * j) = x[j]; } } }
    else if (P.xout_c) { float* xo = (dry ? WSP(float, WS_ACT) + (size_t)TL * DM : P.xout_c) + (size_t)(r - TL) * DM;
#pragma unroll
        for (int j = 0; j < 4; ++j) *(f32x4*)(xo + 4 * F.lane + 256 * j) = x[j]; }
    if (P.H) { float ss = 0.f;
#pragma unroll
        for (int j = 0; j < 4; ++j) ss += (x[j].x * x[j].x + x[j].y * x[j].y) + (x[j].z * x[j].z + x[j].w * x[j].w);
        const float rs = 1.0f / sqrtf(wave_sum(ss) * (1.f / DM) + EPSN);
        bf16* hr = P.H + (size_t)r * DM;
#pragma unroll
        for (int j = 0; j < 4; ++j) { const f32x4 h = x[j] * rs * A2[j] + A3[j]; v2u w; w.x = pk2(h.x, h.y); w.y = pk2(h.z, h.w); *(v2u*)(hr + 4 * F.lane + 256 * j) = w; } }
}
__device__ __forceinline__ void thin_vectors(Frame& F, const Thin& P, const int bi, f32x4 (&A1)[4], f32x4 (&A2)[4], f32x4 (&A3)[4]) {
#pragma unroll
    for (int j = 0; j < 4; ++j) { const int col = 4 * F.lane + 256 * j;
        if (P.Y) A1[j] = *(const f32x4*)(P.gate + (size_t)bi * (NMOD * DM) + col) * *(const f32x4*)(P.nw_post + col) * P.fac;
        if (P.H) { A2[j] = *(const f32x4*)(P.nw_pre + col) * (*(const f32x4*)(P.scale + (size_t)bi * (NMOD * DM) + col) + 1.0f); A3[j] = *(const f32x4*)(P.shift + (size_t)bi * (NMOD * DM) + col); } }
}
__device__ __forceinline__ f32x4 bf4(v2u w) { return (f32x4){bf2f(w.x & 0xffffu), bf2f(w.x >> 16), bf2f(w.y & 0xffffu), bf2f(w.y >> 16)}; }
__device__ __forceinline__ void thin_phase(Frame& F, const Thin& P, int dbg_idx = 99, bool dry = false) {
    const int gw = F.vcu * NWAVES + F.wave, NGW = F.G * NWAVES;
    const int nlat = (P.nrows < TL) ? P.nrows : TL;
    const bool has_ctx = P.nrows > TL;
    const int CTXW = (P.nslab > 0) ? 4 : 1;
    int r0, r1;
    if (!has_ctx || NGW != 2048) { const int per = (nlat + NGW - 1) / NGW; r0 = gw * per; r1 = (r0 + per < nlat) ? r0 + per : nlat; }
    else { const int a = 16 - CTXW / 2, b = 16 + CTXW / 2;
        if (gw < 1024) { r0 = gw * a; r1 = r0 + a; } else { r0 = 1024 * a + (gw - 1024) * b; r1 = r0 + b; } }
    int cur = -1;
    f32x4 A1[4], A2[4], A3[4];
    v2u xbA[4], ybA[4], xbB[4], ybB[4], xbC[4], ybC[4]; f32x4 xfA[4], xfB[4], xfC[4];
    unsigned sh16, mhi, mall;
#define TH_LD(XB_, XF_, YB_, r_) do { const int rr_ = (r_); if (P.xin_bf) { const bf16* xr_ = (const bf16*)P.xin_l + (size_t)rr_ * DM + 4 * F.lane; _Pragma("unroll") for (int j = 0; j < 4; ++j) asm volatile("global_load_dwordx2 %0, %1, off" : "=v"(XB_[j]) : "v"(xr_ + 256 * j) : "memory"); } \
        else { const float* xr_ = (const float*)P.xin_l + (size_t)rr_ * DM + 4 * F.lane; _Pragma("unroll") for (int j = 0; j < 4; ++j) asm volatile("global_load_dwordx4 %0, %1, off" : "=v"(XF_[j]) : "v"(xr_ + 256 * j) : "memory"); } \
        if (P.Y) { const bf16* yr_ = P.Y + (size_t)rr_ * DM + 4 * F.lane; _Pragma("unroll") for (int j = 0; j < 4; ++j) asm volatile("global_load_dwordx2 %0, %1, off" : "=v"(YB_[j]) : "v"(yr_ + 256 * j) : "memory"); } } while (0)
#define TH_WAIT(n_) asm volatile("s_waitcnt vmcnt(" #n_ ")\n\ts_mov_b32 %0, 16\n\ts_mov_b32 %1, 0xffff0000\n\ts_mov_b32 %2, -1" : "=s"(sh16), "=s"(mhi), "=s"(mall) :: "memory")
#define TH_UNPK(w_) ((f32x4){__builtin_bit_cast(float, (w_).x << sh16), __builtin_bit_cast(float, (w_).x & mhi), __builtin_bit_cast(float, (w_).y << sh16), __builtin_bit_cast(float, (w_).y & mhi)})
#define TH_ROW(XB_, XF_, YB_, NXB_, NXF_, NYB_) do { \
        if (r + 2 < r1) { if (P.H && P.Y) TH_WAIT(24); else if (P.H) TH_WAIT(20); else if (P.Y) TH_WAIT(16); else TH_WAIT(12); } \
        else if (r + 1 < r1) { if (P.H) TH_WAIT(8); else TH_WAIT(4); } \
        else TH_WAIT(0); \
        if (r + 2 < r1) TH_LD(NXB_, NXF_, NYB_, r + 2); \
        f32x4 x[4], y[4]; \
        _Pragma("unroll") for (int j = 0; j < 4; ++j) { \
            if (P.xin_bf) x[j] = TH_UNPK(XB_[j]); else { const v4u b_ = __builtin_bit_cast(v4u, XF_[j]); x[j] = __builtin_bit_cast(f32x4, (v4u){b_.x & mall, b_.y & mall, b_.z & mall, b_.w & mall}); } \
            if (P.Y) y[j] = TH_UNPK(YB_[j]); else y[j] = (f32x4){0.f, 0.f, 0.f, 0.f}; } \
        const int bi = r >> 13; \
        if (bi != cur) { cur = bi; thin_vectors(F, P, bi, A1, A2, A3); VM_DONE(); } \
        thin_finish(F, P, r, x, y, A1, A2, A3, dry); } while (0)
    if (r0 < r1) { TH_LD(xbA, xfA, ybA, r0); if (r0 + 1 < r1) TH_LD(xbB, xfB, ybB, r0 + 1); asm volatile("s_waitcnt vmcnt(0)" ::: "memory"); }
    for (int r = r0; r < r1; ++r) {
        TH_ROW(xbA, xfA, ybA, xbC, xfC, ybC);
        ++r; if (r >= r1) break;
        TH_ROW(xbB, xfB, ybB, xbA, xfA, ybA);
        ++r; if (r >= r1) break;
        TH_ROW(xbC, xfC, ybC, xbB, xfB, ybB);
    }
#undef TH_LD
#undef TH_WAIT
#undef TH_UNPK
#undef TH_ROW
    if (has_ctx && gw < TC) { const int r = TL + gw;
        thin_vectors(F, P, 4, A1, A2, A3);
        f32x4 x[4], y[4]; const float* xr = P.xin_c + (size_t)gw * DM;
#pragma unroll
        for (int j = 0; j < 4; ++j) { x[j] = *(const f32x4*)(xr + 4 * F.lane + 256 * j); y[j] = (f32x4){0.f, 0.f, 0.f, 0.f}; }
        if (P.Y) { if (P.nslab > 0) {
#pragma unroll 4
                for (int ks = 0; ks < P.nslab; ++ks) { const float* sr = P.YS + ((size_t)ks * TC + gw) * DM;
#pragma unroll
                    for (int j = 0; j < 4; ++j) y[j] += *(const f32x4*)(sr + 4 * F.lane + 256 * j); } }
            else { const bf16* yr = P.Y + (size_t)r * DM;
#pragma unroll
                for (int j = 0; j < 4; ++j) y[j] = bf4(*(const v2u*)(yr + 4 * F.lane + 256 * j)); } }
        thin_finish(F, P, r, x, y, A1, A2, A3, dry);
    }
}
constexpr int RS = 272;
constexpr int TILE_B = 128 * RS;
__device__ __forceinline__ int cg_row0(int cg) { return cg * 128; }
__device__ __forceinline__ bf16x8 lds_frag(const LAS unsigned char* p) { return *(const LAS bf16x8*)p; }
__device__ __forceinline__ bf16x8 glb_frag(const bf16* p) { return *(const bf16x8*)p; }
__device__ __forceinline__ void st4bf(bf16* p, f32x4 v) { v2u w; w.x = pk2(v[0], v[1]); w.y = pk2(v[2], v[3]); *(v2u*)p = w; }
__device__ __forceinline__ void st4bf_lds(LAS unsigned char* p, f32x4 v) { v2u w; w.x = pk2(v[0], v[1]); w.y = pk2(v[2], v[3]); *(LAS v2u*)p = w; }

__device__ __forceinline__ float wscan_add_up(float v, int lane) {
#pragma unroll
    for (int o = 1; o < 64; o <<= 1) { const float t = __shfl_up(v, o); if (lane >= o) v += t; }
    return v; }
__device__ __forceinline__ float wscan_add_down(float v, int lane) {
#pragma unroll
    for (int o = 1; o < 64; o <<= 1) { const float t = __shfl_down(v, o); if (lane + o < 64) v += t; }
    return v; }
__device__ __forceinline__ float wscan_max_up(float v, int lane) {
#pragma unroll
    for (int o = 1; o < 64; o <<= 1) { const float t = __shfl_up(v, o); if (lane >= o) v = fmaxf(v, t); }
    return v; }
__device__ __forceinline__ float wscan_max_down(float v, int lane) {
#pragma unroll
    for (int o = 1; o < 64; o <<= 1) { const float t = __shfl_down(v, o); if (lane + o < 64) v = fmaxf(v, t); }
    return v; }
__device__ __forceinline__ float wave_max(float v) {
#pragma unroll
    for (int o = 1; o < 64; o <<= 1) v = fmaxf(v, __shfl_xor(v, o));
    return v; }

__device__ __forceinline__ void m1_phase(Frame& F, int l) {
    LAS unsigned char* HALO = F.lds;
    LAS unsigned char* XM = HALO + 64 * RS;
    LAS unsigned char* CV = F.lds + 2 * TILE_B;
    LAS unsigned char* VT = F.lds + 3 * TILE_B;
#define KT_ROW(dk_) (HALO + ((dk_) + (((dk_) & 64) << 1)) * RS)
    LAS float* FL = (LAS float*)(F.lds + 4 * TILE_B);
    const bf16* UXM = WSP(bf16, WS_Y) + (size_t)TT * 512;
    const float* GT = WSP(float, WS_GT);
    bf16* Qg = WSP(bf16, WS_Q); bf16* Kg = WSP(bf16, WS_K); bf16* VTg = WSP(bf16, WS_VT); bf16* CLg = WSP(bf16, WS_CL);
    float* GA = WSP(float, WS_GA); float* NL = WSP(float, WS_NL); float* SC = WSP(float, WS_SC);
    const bf16* WQ = WSP(bf16, WS_WQKV) + (size_t)l * 12 * HD * HD;
    const int wv = F.wave;
    const float* const p_conv_w = FIN(I_CONVW); const float* const p_conv_b = FIN(I_CONVB); const float* const p_gate_b = FIN(I_GATEB);
    bf16x8 wq[4], wk[4], wvv[4]; int cur_h = -1;
    for (int uid = F.vcu; uid < NUID; uid += F.G) {
        int tid = F.tid; asm volatile("" : "+v"(tid));
        const int lane = tid & 63, li = lane & 15, g = lane >> 4;
        const int cg = uid >> 2, h = uid & 3;
        const bool isc = cg >= 256;
        const int r0 = cg * 128;
        const int seq0 = isc ? (TL + ((cg - 256) >> 1) * 256) : ((cg >> 6) * SEQ);
        const int s0 = r0 - seq0;
        if (h != cur_h) { cur_h = h;
            lds_barrier();
            for (int i = tid; i < 1280; i += NTHR) { const int tap = i >> 7, ch = i & 127;
                FL[256 + i] = (tap < 9) ? p_conv_w[((size_t)l * 9 + tap) * 512 + h * 128 + ch] : p_conv_b[l * 512 + h * 128 + ch]; }
#pragma unroll
            for (int ks = 0; ks < 4; ++ks) { const int off = (16 * wv + li) * HD + 32 * ks + 8 * g;
                wq[ks] = glb_frag(WQ + (size_t)(0 * 4 + h) * HD * HD + off); wk[ks] = glb_frag(WQ + (size_t)(1 * 4 + h) * HD * HD + off); wvv[ks] = glb_frag(WQ + (size_t)(2 * 4 + h) * HD * HD + off); }
            lds_barrier(); }
        REP(16) {
        { const int L = isc ? CTXL : SEQ;
#pragma unroll
          for (int it = 0; it < 8; ++it) { const int ch = tid + NTHR * it, row = ch >> 4, c16 = ch & 15; const int s = s0 - 64 + row; const bool ok = (unsigned)s < (unsigned)L;
              const v4u v = *(const v4u*)(UXM + (size_t)(seq0 + (ok ? s : s0)) * 512 + h * 128 + 8 * c16);
              *(LAS v4u*)(HALO + row * RS + 16 * c16) = ok ? v : (v4u){0u, 0u, 0u, 0u}; } }
        lds_barrier();
        { const int cb = tid & 15, tg = tid >> 4;
          f32x2 ac[4][4];
          const f32x4 b0 = *(const LAS f32x4*)(FL + 256 + 9 * 128 + 8 * cb), b1 = *(const LAS f32x4*)(FL + 256 + 9 * 128 + 8 * cb + 4);
          const f32x2 bias[4] = {(f32x2){b0[0], b0[1]}, (f32x2){b0[2], b0[3]}, (f32x2){b1[0], b1[1]}, (f32x2){b1[2], b1[3]}};
          const bool zl = !isc && (tg & 15) == 0, zr = !isc && (tg & 15) == 15;
          const LAS unsigned char* hb = HALO + (63 + 4 * tg) * RS + 16 * cb; const int o0 = zl ? RS : 0, o5 = zr ? 4 * RS : 5 * RS;
#pragma unroll
          for (int dy = -1; dy <= 1; ++dy) {
              if (isc && dy != 0) continue;
              f32x2 xr[6][4];
#pragma unroll
              for (int j = 0; j < 6; ++j) {
                  v4u x = *(const LAS v4u*)(hb + 64 * dy * RS + (j == 0 ? o0 : (j == 5 ? o5 : j * RS)));
                  if ((j == 0 && zl) || (j == 5 && zr)) x = (v4u){0u, 0u, 0u, 0u};
                  xr[j][0] = (f32x2){__builtin_bit_cast(float, x.x << 16), __builtin_bit_cast(float, x.x & 0xffff0000u)}; xr[j][1] = (f32x2){__builtin_bit_cast(float, x.y << 16), __builtin_bit_cast(float, x.y & 0xffff0000u)};
                  xr[j][2] = (f32x2){__builtin_bit_cast(float, x.z << 16), __builtin_bit_cast(float, x.z & 0xffff0000u)}; xr[j][3] = (f32x2){__builtin_bit_cast(float, x.w << 16), __builtin_bit_cast(float, x.w & 0xffff0000u)}; }
#pragma unroll
              for (int dx = -1; dx <= 1; ++dx) { const int tap = (dy + 1) * 3 + dx + 1;
                  const f32x4 w0 = *(const LAS f32x4*)(FL + 256 + tap * 128 + 8 * cb), w1 = *(const LAS f32x4*)(FL + 256 + tap * 128 + 8 * cb + 4);
                  const f32x2 wp[4] = {(f32x2){w0[0], w0[1]}, (f32x2){w0[2], w0[3]}, (f32x2){w1[0], w1[1]}, (f32x2){w1[2], w1[3]}};
#pragma unroll
                  for (int i = 0; i < 4; ++i)
#pragma unroll
                      for (int c = 0; c < 4; ++c) ac[i][c] = wp[c] * xr[i + dx + 1][c] + ((tap == (isc ? 3 : 0)) ? bias[c] : ac[i][c]); } }
#pragma unroll
          for (int i = 0; i < 4; ++i) { float a[8] = {ac[i][0][0], ac[i][0][1], ac[i][1][0], ac[i][1][1], ac[i][2][0], ac[i][2][1], ac[i][3][0], ac[i][3][1]};
#pragma unroll
              for (int j = 0; j < 8; ++j) { a[j] = a[j] * pg8::fast_sigmoid(a[j]); DBG_CHK(a[j], 1); }
              v4u o; o.x = pk2(a[0], a[1]); o.y = pk2(a[2], a[3]); o.z = pk2(a[4], a[5]); o.w = pk2(a[6], a[7]);
              *(LAS v4u*)(CV + (4 * tg + i) * RS + 16 * cb) = o; } }
        }
        REP(17) if (wv == 0) { const float* gb = p_gate_b + l * 16; const float* gp0 = GT + (size_t)(r0 + 2 * lane) * 16; const float* gp1 = gp0 + 16;
            const float if0 = gp0[h] + gb[h], if1 = gp1[h] + gb[h], lf0 = logsigf(gp0[4 + h] + gb[4 + h]), lf1 = logsigf(gp1[4 + h] + gb[4 + h]);
            const float ib0 = gp0[8 + h] + gb[8 + h], ib1 = gp1[8 + h] + gb[8 + h], lb0 = logsigf(gp0[12 + h] + gb[12 + h]), lb1 = logsigf(gp1[12 + h] + gb[12 + h]);
            DBG_CHK(if0 + if1 + lf0 + lf1 + ib0 + ib1 + lb0 + lb1, 0);
            const float pin = wscan_add_up(lf0 + lf1, lane);
            const float bf1 = pin, bf0 = pin - lf1, btf = __shfl(pin, 63);
            const float sin_ = wscan_add_down(lb0 + lb1, lane);
            const float bb0 = sin_, bb1 = sin_ - lb0, btb = __shfl(sin_, 0);
            const float af0 = btf - bf0 + if0, af1 = btf - bf1 + if1, ab0 = btb - bb0 + ib0, ab1 = btb - bb1 + ib1;
            const float mf = wave_max(fmaxf(af0, af1)), mb = wave_max(fmaxf(ab0, ab1));
            FL[2 * lane] = __expf(af0 - mf); FL[2 * lane + 1] = __expf(af1 - mf); FL[128 + 2 * lane] = __expf(ab0 - mb); FL[128 + 2 * lane + 1] = __expf(ab1 - mb);
            *(f32x4*)(GA + ((size_t)(r0 + 2 * lane) * 4 + h) * 4) = (f32x4){bf0, if0 - bf0, bb0, ib0 - bb0};
            *(f32x4*)(GA + ((size_t)(r0 + 2 * lane + 1) * 4 + h) * 4) = (f32x4){bf1, if1 - bf1, bb1, ib1 - bb1};
            if (lane == 0) { SC[(0 * 2 + 0) * NUID + uid] = mf; SC[(0 * 2 + 1) * NUID + uid] = mb; SC[(1 * 2 + 0) * NUID + uid] = btf; SC[(1 * 2 + 1) * NUID + uid] = btb; } }
        lds_barrier();
        REP(18)
#pragma unroll 2
        for (int n = 0; n < 8; ++n) {
            bf16x8 cvf[4], xmf[4];
#pragma unroll
            for (int ks = 0; ks < 4; ++ks) { cvf[ks] = lds_frag(CV + (16 * n + li) * RS + (32 * ks + 8 * g) * 2); xmf[ks] = lds_frag(XM + (16 * n + li) * RS + (32 * ks + 8 * g) * 2); }
            f32x4 aq = {0.f, 0.f, 0.f, 0.f}, ak = aq, akt = aq, avt = aq;
#pragma unroll
            for (int ks = 0; ks < 4; ++ks) { aq = mfma16(wq[ks], cvf[ks], aq); ak = mfma16(wk[ks], cvf[ks], ak); akt = mfma16(cvf[ks], wk[ks], akt); avt = mfma16(xmf[ks], wvv[ks], avt); }
            DBG_CHK(aq[0] + aq[1] + aq[2] + aq[3] + ak[0] + ak[1] + ak[2] + ak[3] + akt[0] + akt[1] + akt[2] + akt[3] + avt[0] + avt[1] + avt[2] + avt[3], 2);
            st4bf(Qg + (size_t)(r0 + 16 * n + li) * 512 + h * 128 + 16 * wv + 4 * g, aq);
            st4bf(Kg + (size_t)(r0 + 16 * n + li) * 512 + h * 128 + 16 * wv + 4 * g, ak);
            st4bf_lds(KT_ROW(16 * wv + li) + (16 * n + 4 * g) * 2, akt);
            st4bf_lds(VT + (16 * wv + li) * RS + (16 * n + 4 * g) * 2, avt);
            st4bf(VTg + (size_t)uid * 16384 + (16 * wv + li) * 128 + 16 * n + 4 * g, avt);
        }
        lds_barrier();
        REP(19) {
            bf16x8 vf[4], vb[4];
#pragma unroll
            for (int ks = 0; ks < 4; ++ks) { const bf16x8 v = lds_frag(VT + (16 * wv + li) * RS + (32 * ks + 8 * g) * 2);
                float x[8];
#pragma unroll
                for (int e = 0; e < 8; ++e) x[e] = bf2f((unsigned short)v[e]);
                v4u a, b; const LAS float* wf = FL + 32 * ks + 8 * g; const LAS float* wb = FL + 128 + 32 * ks + 8 * g;
                a.x = pk2(x[0] * wf[0], x[1] * wf[1]); a.y = pk2(x[2] * wf[2], x[3] * wf[3]); a.z = pk2(x[4] * wf[4], x[5] * wf[5]); a.w = pk2(x[6] * wf[6], x[7] * wf[7]);
                b.x = pk2(x[0] * wb[0], x[1] * wb[1]); b.y = pk2(x[2] * wb[2], x[3] * wb[3]); b.z = pk2(x[4] * wb[4], x[5] * wb[5]); b.w = pk2(x[6] * wb[6], x[7] * wb[7]);
                vf[ks] = __builtin_bit_cast(bf16x8, a); vb[ks] = __builtin_bit_cast(bf16x8, b); }
#pragma unroll 2
            for (int n = 0; n < 8; ++n) {
                f32x4 af = {0.f, 0.f, 0.f, 0.f}, ab = af;
#pragma unroll
                for (int ks = 0; ks < 4; ++ks) { const bf16x8 kt = lds_frag(KT_ROW(16 * n + li) + (32 * ks + 8 * g) * 2); af = mfma16(kt, vf[ks], af); ab = mfma16(kt, vb[ks], ab); }
                DBG_CHK(af[0] + af[1] + af[2] + af[3] + ab[0] + ab[1] + ab[2] + ab[3], 3);
                st4bf(CLg + ((size_t)0 * NUID + uid) * 16384 + (16 * wv + li) * 128 + 16 * n + 4 * g, af);
                st4bf(CLg + ((size_t)1 * NUID + uid) * 16384 + (16 * wv + li) * 128 + 16 * n + 4 * g, ab);
            }
            if (tid < 256) { const int dir = tid >> 7, dk = tid & 127; float sacc = 0.f; const LAS float* w = FL + 128 * dir;
#pragma unroll 4
                for (int t8 = 0; t8 < 16; ++t8) { const bf16x8 kk = lds_frag(KT_ROW(dk) + 16 * t8);
#pragma unroll
                    for (int e = 0; e < 8; ++e) sacc += w[8 * t8 + e] * bf2f((unsigned short)kk[e]); }
                NL[((size_t)dir * NUID + uid) * 128 + dk] = sacc; }
        }
        lds_barrier();
    }
}

#undef KT_ROW
__device__ __forceinline__ int m2_cg(int step, int b, int dir) { return (step < 2) ? (256 + 2 * b + (dir ? 1 - step : step)) : (64 * b + (dir ? 63 - (step - 2) : (step - 2))); }
__device__ __forceinline__ void m2_phase(Frame& F, bool dry = false) {
    bf16* CLg = WSP(bf16, WS_CL); float* NL = WSP(float, WS_NL); float* SC = WSP(float, WS_SC);
    const int gid = F.vcu * NTHR + F.tid;
    const int nthreads = F.G * NTHR;
    constexpr int PF = 11, NSTEP = 66;
    for (int item = gid; item < 32 * 4096; item += nthreads) {
        const int chain = item >> 12, e4 = item & 4095;
        const int dir = chain & 1, h = (chain >> 1) & 3, b = chain >> 3;
        float zero_ = 0.f; asm volatile("" : "+v"(zero_));
        float C0 = zero_, C1 = zero_, C2 = zero_, C3 = zero_, m = zero_;
        f32x4 nvec = {zero_, zero_, zero_, zero_};
        const bool do_n = e4 < 32; const int en = do_n ? e4 : 0;
        v2u w[PF]; float ml[PF], bt[PF]; f32x4 nl[PF];
#pragma unroll
        for (int p = 0; p < PF; ++p) { const int uid = m2_cg(p, b, dir) * 4 + h;
            w[p] = *(const v2u*)(CLg + ((size_t)dir * NUID + uid) * 16384 + 4 * e4); ml[p] = SC[(0 * 2 + dir) * NUID + uid]; bt[p] = SC[(1 * 2 + dir) * NUID + uid];
            nl[p] = *(const f32x4*)(NL + ((size_t)dir * NUID + uid) * 128 + 4 * en); }
#pragma unroll
        for (int s0 = 0; s0 < NSTEP; s0 += PF) {
#pragma unroll
            for (int p = 0; p < PF; ++p) { const int step = s0 + p; const int uid = m2_cg(step, b, dir) * 4 + h;
                bf16* cp = CLg + ((size_t)dir * NUID + uid) * 16384 + 4 * e4;
                const v2u wc = w[p]; const float mlc = ml[p], btc = bt[p]; const f32x4 nlc = nl[p];
                if (!dry) { v2u o; o.x = pk2(C0, C1); o.y = pk2(C2, C3); *(v2u*)cp = o; } else asm volatile("" :: "v"(C0), "v"(C1), "v"(C2), "v"(C3), "v"(m), "v"(nvec[0]));
                if (do_n && !dry) *(f32x4*)(NL + ((size_t)dir * NUID + uid) * 128 + 4 * e4) = nvec;
                if (e4 == 0 && !dry) SC[(2 * 2 + dir) * NUID + uid] = m;
                { const int uid2 = m2_cg((step + PF < NSTEP) ? step + PF : NSTEP - 1, b, dir) * 4 + h;
                    w[p] = *(const v2u*)(CLg + ((size_t)dir * NUID + uid2) * 16384 + 4 * e4); ml[p] = SC[(0 * 2 + dir) * NUID + uid2]; bt[p] = SC[(1 * 2 + dir) * NUID + uid2];
                    nl[p] = *(const f32x4*)(NL + ((size_t)dir * NUID + uid2) * 128 + 4 * en); }
                const float mn = fmaxf(btc + m, mlc), dec = __expf(btc + m - mn), inj = __expf(mlc - mn);
                C0 = dec * C0 + inj * bf2f(wc.x & 0xffffu); C1 = dec * C1 + inj * bf2f(wc.x >> 16); C2 = dec * C2 + inj * bf2f(wc.y & 0xffffu); C3 = dec * C3 + inj * bf2f(wc.y >> 16);
                nvec = nvec * dec + nlc * inj; m = mn; DBG_CHK(C0 + C1 + C2 + C3 + m + nvec[0] + nvec[1] + nvec[2] + nvec[3], 5);
            }
        }
    }
}

__device__ __forceinline__ void m3_phase(Frame& F, int l, int ncg, bool dry = false) {
    LAS unsigned char* KS = F.lds;
    LAS unsigned char* VT = F.lds + TILE_B;
    LAS unsigned char* CF = F.lds + 2 * TILE_B;
    LAS unsigned char* CB = F.lds + 3 * TILE_B;
    LAS float* FL = (LAS float*)(F.lds + 4 * TILE_B);
    const bf16* Qg = WSP(bf16, WS_Q); const bf16* Kg = WSP(bf16, WS_K); const bf16* VTg = WSP(bf16, WS_VT); const bf16* CLg = WSP(bf16, WS_CL);
    const float* GA = WSP(float, WS_GA); const float* NL = WSP(float, WS_NL); const float* SC = WSP(float, WS_SC);
    bf16* A4 = WSP(bf16, WS_A4);
    const int wv = F.wave;
    v4u pk_[4], pv_[4], pf_[4], pb_[4];
#define M3_LOAD(uid_) do { const int u_ = (uid_), cg_ = u_ >> 2, h_ = u_ & 3, rr_ = cg_ * 128; _Pragma("unroll") for (int it = 0; it < 4; ++it) { const int ch = tid0 + NTHR * it, row = ch >> 4, c16 = ch & 15; \
        pk_[it] = *(const v4u*)(Kg + (size_t)(rr_ + row) * 512 + h_ * 128 + 8 * c16); \
        pf_[it] = *(const v4u*)(CLg + ((size_t)0 * NUID + u_) * 16384 + row * 128 + 8 * c16); } } while (0)
#define M3_STORE() do { _Pragma("unroll") for (int it = 0; it < 4; ++it) { const int ch = tid0 + NTHR * it, row = ch >> 4, c16 = ch & 15; \
        *(LAS v4u*)(KS + row * RS + 16 * c16) = pk_[it]; *(LAS v4u*)(CF + row * RS + 16 * c16) = pf_[it]; } } while (0)
    { const int tid0 = F.tid; if (F.vcu < ncg * 4) { M3_LOAD(F.vcu); M3_STORE(); } }
    for (int uid = F.vcu; uid < ncg * 4; uid += F.G) {
        int tid = F.tid; asm volatile("" : "+v"(tid));
        const int lane = tid & 63, li = lane & 15, g = lane >> 4; const int tid0 = tid;
        const int cg = uid >> 2, h = uid & 3, r0 = cg * 128;
        const bool more = uid + F.G < ncg * 4;
        const int t = 16 * wv + li;
        f32x4 sm4; float sm1;
        { const float* p4 = (tid < 128) ? GA + ((size_t)(r0 + tid) * 4 + h) * 4 : FIN(I_HNW) + l * 512 + h * 128 + 4 * ((tid - 128) & 31);
          const int e1 = tid - 160; const float* p1 = ((unsigned)e1 < 256u) ? NL + ((size_t)(e1 >> 7) * NUID + uid) * 128 + (e1 & 127) : SC + (2 * 2 + (tid & 1)) * NUID + uid;
          sm4 = *(const f32x4*)p4; sm1 = *p1; }
        bf16x8 qf[4];
#pragma unroll
        for (int ks = 0; ks < 4; ++ks) qf[ks] = glb_frag(Qg + (size_t)(r0 + t) * 512 + h * 128 + 32 * ks + 8 * g);
#pragma unroll
        for (int it = 0; it < 4; ++it) { const int ch = tid + NTHR * it; pv_[it] = *(const v4u*)(VTg + (size_t)uid * 16384 + (ch >> 4) * 128 + 8 * (ch & 15)); pb_[it] = *(const v4u*)(CLg + ((size_t)1 * NUID + uid) * 16384 + (ch >> 4) * 128 + 8 * (ch & 15)); }
        if (tid < 128) *(LAS f32x4*)(FL + 4 * tid) = sm4; else if (tid < 160) *(LAS f32x4*)(FL + 1040 + 4 * (tid - 128)) = sm4;
        if ((unsigned)(tid - 160) < 256u) FL[512 + (tid - 160)] = sm1; else if ((unsigned)(tid - 416) < 2u) FL[1024 + (tid - 416)] = sm1;
        lds_barrier();
        if (wv == 0) { const float u0 = FL[4 * (2 * lane) + 1], u1 = FL[4 * (2 * lane + 1) + 1];
            const float pm = wscan_max_up(fmaxf(u0, u1), lane), pe = __shfl_up(pm, 1); const float excl = (lane > 0) ? pe : -3.0e38f, mp = FL[1024];
            FL[768 + 2 * lane] = fmaxf(mp, fmaxf(excl, u0)); FL[768 + 2 * lane + 1] = fmaxf(mp, pm); }
        else if (wv == 1) { const float u0 = FL[4 * (2 * lane) + 3], u1 = FL[4 * (2 * lane + 1) + 3];
            const float sm = wscan_max_down(fmaxf(u0, u1), lane), se = __shfl_down(sm, 1); const float excl = (lane < 63) ? se : -3.0e38f, mp = FL[1025];
            FL[896 + 2 * lane + 1] = fmaxf(mp, fmaxf(excl, u1)); FL[896 + 2 * lane] = fmaxf(mp, sm); }
        lds_barrier();
        M3_LOAD(more ? uid + F.G : uid);
        REP(21) {
            const bool dry_ = dry || (rep_ == 0 && ((DUPMASK >> 21) & 1));
            bf16x8 sfr[4], sbr[4];
            const float Mf = FL[768 + t], Mb = FL[896 + t], mpf = FL[1024], mpb = FL[1025];
            float rsf = 0.f, rsb = 0.f; const int d = wv >> 1;
#pragma unroll
            for (int kp = 0; kp < 4; ++kp) { f32x4 a0 = {0.f, 0.f, 0.f, 0.f}, a1 = a0;
#pragma unroll
                for (int ks = 0; ks < 4; ++ks) { a0 = mfma16(lds_frag(KS + (32 * kp + li) * RS + (32 * ks + 8 * g) * 2), qf[ks], a0); a1 = mfma16(lds_frag(KS + (32 * kp + 16 + li) * RS + (32 * ks + 8 * g) * 2), qf[ks], a1); }
                DBG_CHK(a0[0] + a0[1] + a0[2] + a0[3] + a1[0] + a1[1] + a1[2] + a1[3], 7);
                __builtin_amdgcn_sched_barrier(0);
                float pf_[8], pb_[8];
                if (kp < d) {
#pragma unroll
                    for (int e = 0; e < 8; ++e) { const int s = 32 * kp + 16 * (e >> 2) + 4 * g + (e & 3); const float a = (e < 4) ? a0[e & 3] : a1[e & 3];
                        pf_[e] = a * __expf(FL[4 * s + 1] - Mf); pb_[e] = 0.f; rsf += pf_[e]; }
                } else if (kp > d) {
#pragma unroll
                    for (int e = 0; e < 8; ++e) { const int s = 32 * kp + 16 * (e >> 2) + 4 * g + (e & 3); const float a = (e < 4) ? a0[e & 3] : a1[e & 3];
                        pb_[e] = a * __expf(FL[4 * s + 3] - Mb); pf_[e] = 0.f; rsb += pb_[e]; }
                } else {
#pragma unroll
                    for (int e = 0; e < 8; ++e) { const int s = 32 * kp + 16 * (e >> 2) + 4 * g + (e & 3); const float a = (e < 4) ? a0[e & 3] : a1[e & 3]; const float uf = FL[4 * s + 1], ub = FL[4 * s + 3];
                        const int dts = t - s; const float pen_f = (float)min(dts, 0) * 1.0e30f, pen_b = (float)min(-dts, 0) * 1.0e30f;
                        const float wf = __expf(uf - Mf + pen_f), wb = __expf(ub - Mb + pen_b);
                        pf_[e] = a * wf; pb_[e] = a * wb; rsf += pf_[e]; rsb += pb_[e]; }
                }
                v4u wa, wb4; wa.x = pk2(pf_[0], pf_[1]); wa.y = pk2(pf_[2], pf_[3]); wa.z = pk2(pf_[4], pf_[5]); wa.w = pk2(pf_[6], pf_[7]);
                wb4.x = pk2(pb_[0], pb_[1]); wb4.y = pk2(pb_[2], pb_[3]); wb4.z = pk2(pb_[4], pb_[5]); wb4.w = pk2(pb_[6], pb_[7]);
                sfr[kp] = __builtin_bit_cast(bf16x8, wa); sbr[kp] = __builtin_bit_cast(bf16x8, wb4);
                __builtin_amdgcn_sched_barrier(0); }
            rsf += __shfl_xor(rsf, 16); rsf += __shfl_xor(rsf, 32); rsb += __shfl_xor(rsb, 16); rsb += __shfl_xor(rsb, 32);
            float qnf = 0.f, qnb = 0.f;
#pragma unroll
            for (int ks = 0; ks < 4; ++ks)
#pragma unroll
                for (int e = 0; e < 8; ++e) { const float qv = bf2f((unsigned short)qf[ks][e]); const int d = 32 * ks + 8 * g + e; qnf += qv * FL[512 + d]; qnb += qv * FL[640 + d]; }
            qnf += __shfl_xor(qnf, 16); qnf += __shfl_xor(qnf, 32); qnb += __shfl_xor(qnb, 16); qnb += __shfl_xor(qnb, 32);
            const f32x4 gat = *(const LAS f32x4*)(FL + 4 * t);
            const float wif = __expf(mpf - Mf), wib = __expf(mpb - Mb);
            const float denf = rsf + wif * qnf, denb = rsb + wib * qnb;
            const float rf = 1.0f / fmaxf(fabsf(denf), __expf(-(gat[0] + Mf))), rb = 1.0f / fmaxf(fabsf(denb), __expf(-(gat[2] + Mb)));
            const float alf = rf * wif, alb = rb * wib; DBG_CHK(rf + rb + alf + alb, 8);
            if (rep_ == 0) {
#pragma unroll
                for (int it = 0; it < 4; ++it) { const int ch = tid + NTHR * it; *(LAS v4u*)(VT + (ch >> 4) * RS + 16 * (ch & 15)) = pv_[it]; *(LAS v4u*)(CB + (ch >> 4) * RS + 16 * (ch & 15)) = pb_[it]; } }
            lds_barrier();
            f32x4 o[8]; float sum = 0.f;
#pragma unroll
            for (int n = 0; n < 8; ++n) { f32x4 apf = {0.f, 0.f, 0.f, 0.f}, apb = apf, acf = apf, acb = apf;
#pragma unroll
                for (int kp = 0; kp < 4; ++kp) { const v2u lo = *(const LAS v2u*)(VT + (16 * n + li) * RS + (32 * kp + 4 * g) * 2), hi = *(const LAS v2u*)(VT + (16 * n + li) * RS + (32 * kp + 16 + 4 * g) * 2);
                    const v4u vv = {lo.x, lo.y, hi.x, hi.y}; const bf16x8 vfr = __builtin_bit_cast(bf16x8, vv); if (kp <= d) apf = mfma16(vfr, sfr[kp], apf); if (kp >= d) apb = mfma16(vfr, sbr[kp], apb); }
#pragma unroll
                for (int ks = 0; ks < 4; ++ks) { acf = mfma16(lds_frag(CF + (16 * n + li) * RS + (32 * ks + 8 * g) * 2), qf[ks], acf); acb = mfma16(lds_frag(CB + (16 * n + li) * RS + (32 * ks + 8 * g) * 2), qf[ks], acb); }
                const f32x4 a = apf * rf + apb * rb + acf * alf + acb * alb;
                o[n] = a; sum += (a[0] + a[1]) + (a[2] + a[3]);
                __builtin_amdgcn_sched_barrier(0); }
            DBG_CHK(sum, 9);
            bf16* zrow = A4 + (size_t)(r0 + t) * 1024 + 512 + h * 128;
            v2u zz[8];
#pragma unroll
            for (int n = 0; n < 8; ++n) zz[n] = *(const v2u*)(zrow + 16 * n + 4 * g);
            sum += __shfl_xor(sum, 16); sum += __shfl_xor(sum, 32);
            const float mu = sum * (1.f / 128.f); float var = 0.f;
#pragma unroll
            for (int n = 0; n < 8; ++n) { o[n] = o[n] - mu; var += (o[n][0] * o[n][0] + o[n][1] * o[n][1]) + (o[n][2] * o[n][2] + o[n][3] * o[n][3]); }
            var += __shfl_xor(var, 16); var += __shfl_xor(var, 32);
            const float rstd = 1.0f / sqrtf(var * (1.f / 128.f) + EPSN);
#pragma unroll
            for (int n = 0; n < 8; ++n) { const int dv = 16 * n + 4 * g; const f32x4 w4 = *(const LAS f32x4*)(FL + 1040 + dv);
                f32x4 y; y[0] = o[n][0] * rstd * w4[0] * pg8::fast_sigmoid(bf2f(zz[n].x & 0xffffu)); y[1] = o[n][1] * rstd * w4[1] * pg8::fast_sigmoid(bf2f(zz[n].x >> 16));
                y[2] = o[n][2] * rstd * w4[2] * pg8::fast_sigmoid(bf2f(zz[n].y & 0xffffu)); y[3] = o[n][3] * rstd * w4[3] * pg8::fast_sigmoid(bf2f(zz[n].y >> 16));
                DBG_CHK(y[0] + y[1] + y[2] + y[3], 10); if (!dry_) st4bf(zrow + dv, y); else asm volatile("" :: "v"(y[0]), "v"(y[1]), "v"(y[2]), "v"(y[3])); }
        }
        lds_barrier();
        M3_STORE();
        lds_barrier();
    }
#undef M3_LOAD
#undef M3_STORE
}
constexpr int FRS = 288;
__device__ __forceinline__ s16x4 tr_read(const LAS unsigned char* p) { typedef short v4i16_t __attribute__((ext_vector_type(4))); return __builtin_bit_cast(s16x4, __builtin_amdgcn_ds_read_tr16_b64_v4i16((LAS v4i16_t*)p)); }
__device__ __forceinline__ bf16x8 dft_frag(const LAS unsigned char* tile, int t, int nt, int lane) {
    const int g = lane >> 4, q = (lane & 15) >> 2, p = lane & 3;
    const LAS unsigned char* a = tile + (32 * t + 16 * (g >> 1) + 4 * (g & 1) + q) * FRS + (16 * nt + 4 * p) * 2;
    const s16x4 lo = tr_read(a), hi = tr_read(a + 8 * FRS);
    bf16x8 r; r[0] = lo[0]; r[1] = lo[1]; r[2] = lo[2]; r[3] = lo[3]; r[4] = hi[0]; r[5] = hi[1]; r[6] = hi[2]; r[7] = hi[3]; return r;
}
__device__ __forceinline__ const bf16* f1_src(const bf16* UXF, int u, int ch) { const int cb = u & 3, s2 = (u >> 2) & 63, b = u >> 8, row = ch >> 4, c16 = ch & 15; return UXF + (size_t)(b * SEQ + 64 * row + s2) * 512 + 128 * cb + 8 * c16; }
__device__ __forceinline__ void f1_phase(Frame& F) {
    const bf16* UXF = WSP(bf16, WS_Y); bf16* HS1 = (bf16*)FOUT;
    const bf16* W1 = (const bf16*)(F.ws + WS_TAB + TAB_W1); const f32x2* TW = (const f32x2*)(F.ws + WS_TAB + TAB_TW);
    const int lane0 = F.lane, wv = F.wave;
    bf16x8 wre[4], wim[4];
#pragma unroll
    for (int t = 0; t < 4; ++t) { wre[t] = glb_frag(W1 + ((((size_t)wv * 2 + 0) * 4 + t) * 64 + lane0) * 8); wim[t] = glb_frag(W1 + ((((size_t)wv * 2 + 1) * 4 + t) * 64 + lane0) * 8); }
    int ub, un, us;
    if (F.G == 256) { us = 1; const int v = F.vcu; if (v < 32) { ub = v; un = 1; } else { const int w = v - 32; if (w < 96) { ub = 32 + 5 * w; un = 5; } else { ub = 32 + 480 + 4 * (w - 96); un = 4; } } }
    else { ub = F.vcu; us = F.G; un = (NB * 64 * 4 - F.vcu + F.G - 1) / F.G; }
    constexpr int TB = 128 * FRS;
    f32x2 twn = {0.f, 0.f};
    if (un > 0) { const int tid = F.tid;
#pragma unroll
        for (int it = 0; it < 4; ++it) { const int ch = tid + NTHR * it; *(LAS v4u*)(F.lds + (ch >> 4) * FRS + 16 * (ch & 15)) = *(const v4u*)f1_src(UXF, ub, ch); }
        twn = TW[(16 * wv + (lane0 & 15)) * 64 + ((ub >> 2) & 63)]; }
    VM_DONE();
    lds_barrier();
    for (int ui = 0; ui < un; ++ui) {
        const int u = ub + ui * us;
        int tid = F.tid; asm volatile("" : "+v"(tid)); const int lane = tid & 63, li = lane & 15, g = lane >> 4;
        const int cb = u & 3, s2 = (u >> 2) & 63, b = u >> 8;
        LAS unsigned char* tile = F.lds + (ui & 1) * TB; LAS unsigned char* ntile = F.lds + ((ui + 1) & 1) * TB;
        v4u pre[4]; const bool more = ui + 1 < un;
        const int k1 = 16 * wv + li; const f32x2 tw = twn;
        if (more) {
#pragma unroll
            for (int it = 0; it < 4; ++it) pre[it] = *(const v4u*)f1_src(UXF, u + us, tid + NTHR * it);
            twn = TW[k1 * 64 + (((u + us) >> 2) & 63)]; }
        bf16* ore = HS1 + (size_t)(b * SEQ + 64 * k1 + s2) * 1024 + 128 * cb;
#pragma unroll
        for (int nt = 0; nt < 8; ++nt) { f32x4 are = {0.f, 0.f, 0.f, 0.f}, aim = are;
#pragma unroll
            for (int t = 0; t < 4; ++t) { const bf16x8 d = dft_frag(tile, t, nt, lane); are = mfma16(d, wre[t], are); aim = mfma16(d, wim[t], aim); }
            DBG_CHK(are[0] + are[1] + are[2] + are[3] + aim[0] + aim[1] + aim[2] + aim[3], 4);
            st4bf(ore + 16 * nt + 4 * g, are * tw.x - aim * tw.y);
            st4bf(ore + 512 + 16 * nt + 4 * g, are * tw.y + aim * tw.x); }
        if (more) {
#pragma unroll
            for (int it = 0; it < 4; ++it) { const int ch = tid + NTHR * it; *(LAS v4u*)(ntile + (ch >> 4) * FRS + 16 * (ch & 15)) = pre[it]; } }
        lds_barrier();
    }
}
__device__ __forceinline__ const bf16* f2_src(const bf16* HS1, int u, int ch) { const int cb = u & 3, k1 = (u >> 2) & 127, b = u >> 9, row = ch >> 4, c16 = ch & 15;
    return HS1 + (size_t)(b * SEQ + 64 * k1 + (row & 63)) * 1024 + (row >> 6) * 512 + 128 * cb + 8 * c16; }
__device__ __forceinline__ void f2_phase(Frame& F, int l) {
    const bf16* HS1 = (const bf16*)FOUT; bf16* A4 = WSP(bf16, WS_A4);
    const bf16* W2 = (const bf16*)(F.ws + WS_TAB + TAB_W2); const bf16* PQF = (const bf16*)(F.ws + WS_TAB + TAB_PQF) + (size_t)l * 8 * 8192;
    const int lane0 = F.lane, wv = F.wave, kq = wv & 3, grp = wv >> 2;
    bf16x8 w2r[4], w2i[4];
#pragma unroll
    for (int t = 0; t < 4; ++t) { w2r[t] = glb_frag(W2 + (((size_t)kq * 4 + t) * 64 + lane0) * 8); w2i[t] = glb_frag(W2 + (((size_t)(kq + 4) * 4 + t) * 64 + lane0) * 8); }
    constexpr int TB = 128 * FRS;
    constexpr int NQP = NB * 63 * 4, NU = NQP + NB * 2 * 4;
#define F2_OLD(q_) (((q_) < NQP) ? ((((q_) >> 2) / 63 * 128 + 1 + ((q_) >> 2) % 63) << 2) | ((q_) & 3) : ((((((q_) - NQP) >> 3) * 128 + ((((q_) - NQP) >> 2) & 1) * 64)) << 2) | ((q_) & 3))
    bf16x8 pqr[16]; int cur_gi = 2 * (F.vcu & 3) + grp;
    { const bf16* pq = PQF + (size_t)cur_gi * 8192 + lane0 * 8;
#pragma unroll
      for (int q = 0; q < 16; ++q) pqr[q] = glb_frag(pq + q * 512); }
    if (F.vcu < NU) { const int tid = F.tid;
#pragma unroll
        for (int it = 0; it < 4; ++it) { const int ch = tid + NTHR * it; *(LAS v4u*)(F.lds + (ch >> 4) * FRS + 16 * (ch & 15)) = *(const v4u*)f2_src(HS1, F2_OLD(F.vcu), ch); } }
    VM_DONE();
    v4u preA[4], preB[4];
#define PF_LOAD(dst_, ptr_) asm volatile("global_load_dwordx4 %0, %1, off" : "=v"(dst_) : "v"(ptr_) : "memory")
#define PF_WAIT(P_, younger4_) do { if (younger4_) asm volatile("s_waitcnt vmcnt(4)" :: "v"(P_[0]), "v"(P_[1]), "v"(P_[2]), "v"(P_[3]) : "memory"); \
        else asm volatile("s_waitcnt vmcnt(0)" :: "v"(P_[0]), "v"(P_[1]), "v"(P_[2]), "v"(P_[3]) : "memory"); } while (0)
    if (F.vcu + F.G < NU) { const int tid = F.tid;
#pragma unroll
        for (int it = 0; it < 4; ++it) PF_LOAD(preA[it], f2_src(HS1, F2_OLD(F.vcu + F.G), tid + NTHR * it)); }
    lds_barrier();
#define F2_BODY(TILE_, NTILE_, PL_, PW_) do { \
        int tid = F.tid; asm volatile("" : "+v"(tid)); const int lane = tid & 63, li = lane & 15, g = lane >> 4; \
        const int u = F2_OLD(q); const bool pair = q < NQP; \
        const int cb = u & 3, k1 = (u >> 2) & 127, b = u >> 9, gi = 2 * cb + grp; \
        LAS unsigned char* tile = (TILE_); LAS unsigned char* ntile = (NTILE_); \
        const bool more1 = q + F.G < NU, more2 = q + 2 * F.G < NU; \
        if (more2) { _Pragma("unroll") for (int it = 0; it < 4; ++it) PF_LOAD(PL_[it], f2_src(HS1, F2_OLD(q + 2 * F.G), tid + NTHR * it)); } \
        bf16x8 uf[4]; \
        _Pragma("unroll") for (int hp = 0; hp < 2; ++hp) { f32x4 r0 = {0.f, 0.f, 0.f, 0.f}, r1 = r0, i0 = r0, i1 = r0; \
            _Pragma("unroll") for (int t = 0; t < 4; ++t) { const bf16x8 d0 = dft_frag(tile, t, 4 * grp + 2 * hp, lane), d1 = dft_frag(tile, t, 4 * grp + 2 * hp + 1, lane); \
                r0 = mfma16(d0, w2r[t], r0); r1 = mfma16(d1, w2r[t], r1); i0 = mfma16(d0, w2i[t], i0); i1 = mfma16(d1, w2i[t], i1); } \
            DBG_CHK(r0[0] + r1[1] + i0[2] + i1[3], 6); \
            v4u wr_, wi_; wr_.x = pk2(r0[0], r0[1]); wr_.y = pk2(r0[2], r0[3]); wr_.z = pk2(r1[0], r1[1]); wr_.w = pk2(r1[2], r1[3]); \
            wi_.x = pk2(i0[0], i0[1]); wi_.y = pk2(i0[2], i0[3]); wi_.z = pk2(i1[0], i1[1]); wi_.w = pk2(i1[2], i1[3]); \
            uf[hp] = __builtin_bit_cast(bf16x8, wr_); uf[2 + hp] = __builtin_bit_cast(bf16x8, wi_); } \
        if (more1) { PF_WAIT(PW_, more2); \
            _Pragma("unroll") for (int it = 0; it < 4; ++it) { const int ch = tid + NTHR * it; *(LAS v4u*)(ntile + (ch >> 4) * FRS + 16 * (ch & 15)) = PW_[it]; } } \
        bf16* orow = A4 + (size_t)(b * SEQ + k1 + 128 * (16 * kq + li)) * 1024 + 64 * gi; \
        bf16* orow2 = A4 + (size_t)(b * SEQ + (128 - k1) + 128 * (63 - (16 * kq + li))) * 1024 + 64 * gi; \
        if (gi != cur_gi) { cur_gi = gi; const bf16* pq = PQF + (size_t)gi * 8192 + lane * 8; \
            _Pragma("unroll") for (int q = 0; q < 16; ++q) pqr[q] = glb_frag(pq + q * 512); \
            VM_DONE(); } \
        _Pragma("unroll") for (int nd = 0; nd < 4; ++nd) { f32x4 pa = {0.f, 0.f, 0.f, 0.f}, pb = pa;        \
            pa = mfma16(pqr[nd * 4 + 0], uf[0], pa); pb = mfma16(pqr[nd * 4 + 2], uf[2], pb); pa = mfma16(pqr[nd * 4 + 1], uf[1], pa); pb = mfma16(pqr[nd * 4 + 3], uf[3], pb); \
            st4bf(orow + 16 * nd + 4 * g, pa + pb); if (pair) st4bf(orow2 + 16 * nd + 4 * g, pa - pb); } \
        lds_barrier(); } while (0)
    for (int q = F.vcu; q < NU; q += F.G) {
        F2_BODY(F.lds, F.lds + TB, preB, preA);
        q += F.G; if (q >= NU) break;
        F2_BODY(F.lds + TB, F.lds, preA, preB);
    }
#undef F2_BODY
#undef F2_OLD
#undef PF_LOAD
#undef PF_WAIT
}
__device__ __forceinline__ void ctx_fourier(Frame& F, int l) {
    const bf16* UXF = WSP(bf16, WS_Y); bf16* A4 = WSP(bf16, WS_A4);
    const bf16* WC = (const bf16*)(F.ws + WS_WC); const bf16* PQF = (const bf16*)(F.ws + WS_TAB + TAB_PQF) + (size_t)l * 8 * 8192;
    const int wv = F.wave, kq = wv & 3, grp = wv >> 2;
    for (int it = (F.G == 256) ? F.vcu - 128 : F.vcu; it < NB * 4 * 4; it += F.G) {
        if (it < 0) continue;
        int tid = F.tid; asm volatile("" : "+v"(tid)); const int lane = tid & 63, li = lane & 15, g = lane >> 4;
        const int kt = it & 3, cb = (it >> 2) & 3, b = it >> 4, gi = 2 * cb + grp;
#pragma unroll
        for (int i8 = 0; i8 < 8; ++i8) { const int ch = tid + NTHR * i8, row = ch >> 4, c16 = ch & 15;
            *(LAS v4u*)(F.lds + row * FRS + 16 * c16) = *(const v4u*)(UXF + (size_t)(TL + b * CTXL + row) * 512 + 128 * cb + 8 * c16); }
        bf16x8 wr[8], wi[8], pqr[16];
#pragma unroll
        for (int t = 0; t < 8; ++t) { wr[t] = glb_frag(WC + ((((size_t)(kt * 4 + kq) * 2 + 0) * 8 + t) * 64 + lane) * 8); wi[t] = glb_frag(WC + ((((size_t)(kt * 4 + kq) * 2 + 1) * 8 + t) * 64 + lane) * 8); }
#pragma unroll
        for (int q = 0; q < 16; ++q) pqr[q] = glb_frag(PQF + (size_t)gi * 8192 + lane * 8 + q * 512);
        lds_barrier();
        bf16x8 uf[4];
#pragma unroll
        for (int hp = 0; hp < 2; ++hp) { f32x4 r0 = {0.f, 0.f, 0.f, 0.f}, r1 = r0, i0 = r0, i1 = r0;
#pragma unroll
            for (int t = 0; t < 8; ++t) { const bf16x8 d0 = dft_frag(F.lds, t, 4 * grp + 2 * hp, lane), d1 = dft_frag(F.lds, t, 4 * grp + 2 * hp + 1, lane);
                r0 = mfma16(d0, wr[t], r0); r1 = mfma16(d1, wr[t], r1); i0 = mfma16(d0, wi[t], i0); i1 = mfma16(d1, wi[t], i1); }
            v4u wr_, wi_; wr_.x = pk2(r0[0], r0[1]); wr_.y = pk2(r0[2], r0[3]); wr_.z = pk2(r1[0], r1[1]); wr_.w = pk2(r1[2], r1[3]);
            wi_.x = pk2(i0[0], i0[1]); wi_.y = pk2(i0[2], i0[3]); wi_.z = pk2(i1[0], i1[1]); wi_.w = pk2(i1[2], i1[3]);
            uf[hp] = __builtin_bit_cast(bf16x8, wr_); uf[2 + hp] = __builtin_bit_cast(bf16x8, wi_); }
        bf16* orow = A4 + (size_t)(TL + b * CTXL + 64 * kt + 16 * kq + li) * 1024 + 64 * gi;
#pragma unroll
        for (int nd = 0; nd < 4; ++nd) { f32x4 a = {0.f, 0.f, 0.f, 0.f};
#pragma unroll
            for (int ks = 0; ks < 4; ++ks) a = mfma16(pqr[nd * 4 + ks], uf[ks], a);
            DBG_CHK(a[0] + a[1] + a[2] + a[3], 11); st4bf(orow + 16 * nd + 4 * g, a); }
        lds_barrier();
    }
    lds_barrier();
}

struct Args { const float* in[17]; float* out; unsigned char* ws; int ph_lo, ph_hi; };
constexpr int NPHASES = 2 + DEPTH * 12;
__global__ void __launch_bounds__(NTHR, 2) mega_fwd(Args args) {
    extern __shared__ __attribute__((aligned(16))) unsigned char lds[];
    Frame F;
    F.lds = (LAS unsigned char*)lds;
    F.MISC = (volatile LAS unsigned*)(F.lds + MISC_OFF);
    F.tid = threadIdx.x; F.lane = F.tid & 63; F.wave = __builtin_amdgcn_readfirstlane(F.tid >> 6);
    F.G = gridDim.x; { const int bx = blockIdx.x; F.vcu = (F.G % 8 == 0) ? (bx % 8) * (F.G / 8) + bx / 8 : bx; }
    F.ws = args.ws; F.ctl = (gu32*)(args.ws + WS_CTL);
    if (F.tid < 16) ((LAS unsigned*)(F.lds + MISC_OFF))[F.tid] = 0u;
    if (F.tid == 64) { LAS unsigned long long* pt = (LAS unsigned long long*)(F.lds + PTAB_OFF);
#pragma unroll
        for (int i = 0; i < 17; ++i) pt[i] = (unsigned long long)args.in[i];
        pt[17] = (unsigned long long)args.out; pt[18] = (unsigned long long)args.ws; }
    __syncthreads();
    XcdBarrier bar = xcd_barrier_post((unsigned*)(F.ctl + CW_BAR), F.MISC + 8);
    const int lo = args.ph_lo, hi = args.ph_hi;
    const int vcu_s = F.vcu; const int wave_s = F.wave;
    int pid = 0;
#define PH_BEGIN if (lo <= pid && pid < hi) { { int t_; asm volatile("v_mbcnt_lo_u32_b32 %0, -1, 0\n\tv_mbcnt_hi_u32_b32 %0, -1, %0" : "=v"(t_)); t_ += wave_s * 64; { int g_ = (int)gridDim.x, v_ = vcu_s, b_ = (int)blockIdx.x; asm volatile("" : "+s"(g_), "+s"(v_), "+s"(b_)); F.G = g_; F.vcu = v_; F.bid = b_; } F.tid = t_; F.lane = t_ & 63; F.wave = __builtin_amdgcn_readfirstlane(t_ >> 6); { LAS unsigned char* lp_ = (LAS unsigned char*)lds; asm volatile("" : "+s"(lp_)); F.lds = lp_; } F.ws = (unsigned char*)(GAS unsigned char*)ptab(F, 18); F.ctl = (gu32*)(F.ws + WS_CTL); }
#define PH_END   if (pid + 1 < hi) { int tb_; asm volatile("v_mbcnt_lo_u32_b32 %0, -1, 0\n\tv_mbcnt_hi_u32_b32 %0, -1, %0" : "=v"(tb_)); xcd_barrier(bar.bar, bar.x, bar.st, tb_ + wave_s * 64, gridDim.x); } } ++pid;
#define XC WSP(float, WS_XC)
#define Hb ((bf16*)FOUT)
#define XB WSP(bf16, WS_XB)
#define Yb WSP(bf16, WS_Y)
#define ACT WSP(bf16, WS_ACT)
#define A4 WSP(bf16, WS_A4)
#define MOD WSP(float, WS_MOD)

    PH_BEGIN mod_first(F); PH_END
    PH_BEGIN { REP(0) p0_prologue(F, 3, F.vcu, F.G);
      if (F.G != 256) { int tb_; asm volatile("v_mbcnt_lo_u32_b32 %0, -1, 0\n\tv_mbcnt_hi_u32_b32 %0, -1, %0" : "=v"(tb_)); xcd_barrier(bar.bar, bar.x, bar.st, tb_ + wave_s * 64, gridDim.x); }
      REP(1) { const Thin P{FIN(I_X), FIN(I_CTX), XB, XC, nullptr, nullptr, nullptr, nullptr, Hb, FIN(I_NORMW) + 0 * DM, MOD + 1 * DM, MOD + 0 * DM, 0.f, 0, TT, 0, 1}; thin_phase(F, P, 0); } } PH_END

#pragma unroll 1
    for (int hl = 0; hl < 2 * DEPTH; ++hl) {
        const int l = hl >> 1, f = hl & 1; const bool last = (l == DEPTH - 1);

        const int Mrows = (last && f == 1) ? TL : TT;
        PH_BEGIN REP(2) { pg8::Gemm gm{Hb, WSP(bf16, WS_WFFIN) + (size_t)(l * 2 + f) * 2 * DFF * DM, Mrows, 2 * DFF, DM, DM, 0, 0}; pg8::StaticOrder S; S.init(Mrows, 2 * DFF, F.G, F.bid);
            pg8::EpiSwiGLU E{ACT, DFF}; pg8::gemm_phase<pg8::EpiSwiGLU, pg8::StaticOrder, true, true>(F.lds, gm, S, E, F.tid);
            if (false && l == 0) { const int nfull = (Mrows / 256) * (2 * DFF / 256) % F.G; if (nfull > 0 && F.bid >= nfull) p0_prologue(F, 1 + f, F.bid - nfull, F.G - nfull); } } PH_END
        PH_BEGIN REP(3) { { pg8::Gemm gm{ACT, WSP(bf16, WS_WFFOUT) + (size_t)(l * 2 + f) * DM * DFF, TL, DM, DFF, DFF, 1, 1}; pg8::StaticOrder S; S.init(TL, DM, F.G, F.bid, 1);
            pg8::EpiPlain E{Yb, DM}; pg8::gemm_phase<pg8::EpiPlain, pg8::StaticOrder, true, true>(F.lds, gm, S, E, F.tid); }
            if (Mrows > TL) {
                pg8::Gemm gm{ACT, WSP(bf16, WS_WFFOUT) + (size_t)(l * 2 + f) * DM * DFF, TT, DM, DFF, 256, 1, 1}; pg8::SplitKOrder S; S.init(TL / 256, 4, 4, 11, F.G, F.bid);
                pg8::EpiSlab E{WSP(float, WS_SLAB2), DM, TL / 256, (size_t)TC * DM}; pg8::gemm_phase<pg8::EpiSlab, pg8::SplitKOrder, true, true>(F.lds, gm, S, E, F.tid); } } PH_END
        PH_BEGIN { const int j = f ? 2 : 0;
            const float* nw = FIN(I_NORMW) + (size_t)l * 6 * DM; const float* modl = MOD + (size_t)l * 5 * NMOD * DM; const bool fin = last && f == 1;
            bf16* const Hp = (f == 0 || !last) ? Hb : nullptr;
            const float* const nwp = (f == 0) ? nw + 2 * DM : nw + 6 * DM;
            const float* const scp = (f == 0) ? modl + 4 * DM : modl + (size_t)5 * NMOD * DM + 1 * DM;
            const float* const shp = (f == 0) ? modl + 3 * DM : modl + (size_t)5 * NMOD * DM;
            const Thin P{XB, XC, fin ? (void*)FOUT : (void*)XB, XC, Yb, WSP(float, WS_SLAB2), nw + (f ? 5 : 1) * DM, modl + (3 * j + 2) * DM, Hp, nwp, scp, shp, 0.5f, (Mrows > TL) ? 11 : 0, Mrows, 1, fin ? 0 : 1};
            REP(4) thin_phase(F, P, l == 0 ? (f ? 3 : 1) : (f ? 6 : 4), rep_ == 0 && ((DUPMASK >> 4) & 1));
#ifdef DBG_FLAGS
            if (last && f == 1) { __syncthreads(); if (blockIdx.x == 0 && F.tid == 0) { const unsigned m = __hip_atomic_load((unsigned*)(F.ctl + 64), __ATOMIC_RELAXED, __HIP_MEMORY_SCOPE_AGENT); if (m) FOUT[0] = 1.0e6f * (float)(__builtin_ctz(m) + 1); } }
#endif
            } PH_END
        if (f == 0) {
            PH_BEGIN REP(5) { pg8::Gemm gm{Hb, WSP(bf16, WS_WIN) + (size_t)l * DIN_PAD * DM, TT, DIN_PAD, DM, DM, 0, 0}; pg8::StaticOrder S; S.init(TT, DIN_PAD, F.G, F.bid);
                pg8::EpiInProj E{Yb, Yb + (size_t)TT * 512, A4, WSP(float, WS_GT)}; pg8::gemm_phase<pg8::EpiInProj, pg8::StaticOrder, true, true>(F.lds, gm, S, E, F.tid); } PH_END
            PH_BEGIN { REP(6) m1_phase(F, l); REP(12) f1_phase(F); } PH_END
            PH_BEGIN { REP(7) m2_phase(F, rep_ == 0 && ((DUPMASK >> 7) & 1)); REP(13) f2_phase(F, l); } PH_END
            PH_BEGIN { REP(8) m3_phase(F, l, last ? 256 : NCG, rep_ == 0 && ((DUPMASK >> 8) & 1)); if (!last) ctx_fourier(F, l); } PH_END
            { const int M4 = last ? TL : TT;
            PH_BEGIN REP(9) { { pg8::Gemm gm{A4, WSP(bf16, WS_WOUT) + (size_t)l * DM * DM, TL, DM, DM, DM, 0, 0}; pg8::StaticOrder S; S.init(TL, DM, F.G, F.bid);
                pg8::EpiPlain E{Yb, DM}; pg8::gemm_phase<pg8::EpiPlain, pg8::StaticOrder, true, true>(F.lds, gm, S, E, F.tid); }
                if (M4 > TL) { pg8::Gemm gm{A4, WSP(bf16, WS_WOUT) + (size_t)l * DM * DM, TT, DM, DM, 256, 0, 0}; pg8::SplitKOrder S; S.init(TL / 256, 4, 4, 4, F.G, F.bid);
                    pg8::EpiSlab E{WSP(float, WS_SLAB4), DM, TL / 256, (size_t)TC * DM}; pg8::gemm_phase<pg8::EpiSlab, pg8::SplitKOrder, true, true>(F.lds, gm, S, E, F.tid); } } PH_END
            PH_BEGIN { const float* nw = FIN(I_NORMW) + (size_t)l * 6 * DM; const float* modl = MOD + (size_t)l * 5 * NMOD * DM;
                const Thin P{XB, XC, XB, XC, Yb, WSP(float, WS_SLAB4), nw + 3 * DM, modl + 5 * DM, Hb, nw + 4 * DM, modl + 7 * DM, modl + 6 * DM, 1.0f, (M4 > TL) ? 4 : 0, M4, 1, 1}; REP(10) thin_phase(F, P, l == 0 ? 2 : 5, rep_ == 0 && ((DUPMASK >> 10) & 1)); } PH_END
            }
        }
    }
#undef XC
#undef Hb
#undef XB
#undef Yb
#undef ACT
#undef A4
#undef MOD
#undef PH_BEGIN
#undef PH_END
}

#ifndef MK_PER_PHASE
#define MK_PER_PHASE 0
#endif
extern "C" void kernel_launch(void* const* d_in, const int* in_sizes, int n_in, void* d_out, int out_size, void* d_ws, size_t ws_size, hipStream_t stream) {
    static int grid = 0;
    if (grid == 0) {
        if (n_in != 17 || out_size != TL * DM || ws_size < WS_END) { fprintf(stderr, "kernel_launch: unexpected problem (n_in %d, out %d, ws %zu); nothing launched\n", n_in, out_size, ws_size); grid = -1; return; }
        int dev = 0, cus = 0, per_cu = 0;
        if (hipGetDevice(&dev) != hipSuccess || hipDeviceGetAttribute(&cus, hipDeviceAttributeMultiprocessorCount, dev) != hipSuccess) { grid = -1; return; }
        if (hipFuncSetAttribute((const void*)mega_fwd, hipFuncAttributeMaxDynamicSharedMemorySize, LDS_BYTES) != hipSuccess) { fprintf(stderr, "kernel_launch: hipFuncSetAttribute failed\n"); grid = -1; return; }
        if (hipOccupancyMaxActiveBlocksPerMultiprocessor(&per_cu, (const void*)mega_fwd, NTHR, LDS_BYTES) != hipSuccess || per_cu < 1) fprintf(stderr, "kernel_launch: occupancy query reports %d\n", per_cu);
        (void)hipGetLastError();
        grid = cus;
    }
    if (grid < 0) return;
    if (hipMemsetAsync((char*)d_ws + WS_CTL, 0, CTL_ZERO_BYTES, stream) != hipSuccess) return;
    Args a{};
    for (int i = 0; i < 17; ++i) a.in[i] = (const float*)d_in[i];
    a.out = (float*)d_out; a.ws = (unsigned char*)d_ws;
#if MK_PER_PHASE
    for (int p = 0; p < NPHASES; ++p) { a.ph_lo = p; a.ph_hi = p + 1; hipLaunchKernelGGL(mega_fwd, dim3(grid), dim3(NTHR), LDS_BYTES, stream, a); }
#else
    a.ph_lo = 0; a.ph_hi = NPHASES;
    hipLaunchKernelGGL(mega_fwd, dim3(grid), dim3(NTHR), LDS_BYTES, stream, a);
#endif
}
```

```cpp
#include <hip/hip_runtime.h>
#include <cstdio>
#include <cstdint>
namespace pg8 {
#define PG8_LAS __attribute__((address_space(3)))
typedef unsigned short bf16_t;
typedef short bf16x8 __attribute__((ext_vector_type(8)));
typedef float f32x4 __attribute__((ext_vector_type(4)));
typedef unsigned u32x4 __attribute__((ext_vector_type(4)));
constexpr int BM = 256, BK = 64, HALF = 128, HTB = HALF * BK * 2  , STAGE_BYTES = 8 * HTB, NXCD = 8, WGM = 8;

__host__ __device__ __forceinline__ int lds_byte(int r, int c) { const int st = (r >> 4) * 2 + (c >> 5), rr = r & 15, cc = c & 31, ob = rr * 64 + cc * 2; return st * 1024 + (ob ^ (((ob >> 9) & 1) << 5)); }
__host__ __device__ __forceinline__ void stage_rc(int b, int& R, int& C) { const int st = b / 1024, sb = b % 1024, swz = sb ^ (((sb >> 9) & 1) << 5); R = (st >> 1) * 16 + swz / 64; C = (st & 1) * 32 + (swz % 64) / 2; }
__host__ __device__ __forceinline__ int perm32(int rho) { const int n = rho >> 4, i = rho & 15; return 8 * (i >> 2) + 4 * n + (i & 3); }

struct Unit { int pm, pn, ks; };
struct Gemm { const bf16_t* A; const bf16_t* Bt; int M, N, K, Klen; int atm, btm; };

struct StaticOrder {
    int nM, nN, nwg, G, c, rev;
    __host__ __device__ void init(int M, int N, int G_, int c_, int rev_ = 0) { nM = M / BM; nN = N / BM; nwg = nM * nN; G = G_; c = c_; rev = rev_; }
    __host__ __device__ bool next(int i, Unit& u) const {
        const long L = (long)i * G + c; if (L >= nwg) return false;
        int wgid = (int)L; { const int q = nwg / NXCD, r = nwg % NXCD, xcd = wgid % NXCD, off = wgid / NXCD; wgid = (xcd < r ? xcd * (q + 1) : r * (q + 1) + (xcd - r) * q) + off; }
        const int nig = WGM * nN, gid = wgid / nig, fm = gid * WGM, gsz = (nM - fm) < WGM ? (nM - fm) : WGM;
        u.pm = fm + ((wgid % nig) % gsz); u.pn = (wgid % nig) / gsz; u.ks = 0; if (rev) u.pm = nM - 1 - u.pm; return true;
    }
    __device__ __forceinline__ void a_ready(const Unit&) const {}
    __device__ __forceinline__ void done(const Unit&) const {}
};

struct SplitKOrder {
    int pm0, nN, nS, nU, G, c;
    __host__ __device__ void init(int pm0_, int nP, int nN_, int nS_, int G_, int c_) { pm0 = pm0_; nN = nN_; nS = nS_; nU = nP * nN_ * nS_; G = G_; c = c_; }
    __host__ __device__ bool next(int i, Unit& u) const { const int L = i * G + c; if (L >= nU) return false; u.ks = L % nS; u.pn = (L / nS) % nN; u.pm = pm0 + L / (nS * nN); return true; }
    __device__ __forceinline__ void a_ready(const Unit&) const {}
    __device__ __forceinline__ void done(const Unit&) const {}
};

__device__ __forceinline__ unsigned cvt_pk_bf16(float lo, float hi) { unsigned r; asm volatile("v_cvt_pk_bf16_f32 %0, %1, %2" : "=v"(r) : "v"(lo), "v"(hi)); return r; }
typedef float f32x2 __attribute__((ext_vector_type(2)));
__device__ __forceinline__ float fast_sigmoid(float x) { return __builtin_amdgcn_rcpf(1.0f + __expf(-x)); }
struct EpiPlain {
    static constexpr bool PERM = true, AFTER_DRAIN = false;
    bf16_t* O; int ldo;
    __device__ __forceinline__ void operator()(const f32x4 (&acc)[2][2][4][2], const Unit& u, int wr, int wc, int fr, int fq) const {
        const int row0 = u.pm * BM + wr * 64 + fr, col0 = u.pn * BM + wc * 32 + 8 * fq;
#pragma unroll
        for (int ai = 0; ai < 2; ++ai)
#pragma unroll
            for (int m = 0; m < 4; ++m) { bf16_t* rowp = O + (size_t)(row0 + ai * HALF + m * 16) * ldo + col0;
#pragma unroll
                for (int bj = 0; bj < 2; ++bj) { const f32x4 v0 = acc[ai][bj][m][0], v1 = acc[ai][bj][m][1];
                    u32x4 w; w.x = cvt_pk_bf16(v0[0], v0[1]); w.y = cvt_pk_bf16(v0[2], v0[3]); w.z = cvt_pk_bf16(v1[0], v1[1]); w.w = cvt_pk_bf16(v1[2], v1[3]);
                    *(u32x4*)(rowp + bj * HALF) = w; } }
    }
};
struct EpiSwiGLU {
    static constexpr bool PERM = true, AFTER_DRAIN = false;
    bf16_t* O; int ldo;
    __device__ __forceinline__ void operator()(const f32x4 (&acc)[2][2][4][2], const Unit& u, int wr, int wc, int fr, int fq) const {
        const int nkt = ldo / BK, kt = u.pn * 2 + (wc >> 1), c64 = (wc & 1) * 32 + 8 * fq;
        bf16_t* base = O + ((size_t)(u.pm * nkt + kt) * BM) * BK + c64;
#pragma unroll
        for (int ai = 0; ai < 2; ++ai)
#pragma unroll
            for (int m = 0; m < 4; ++m) { bf16_t* rowp = base + (size_t)(wr * 64 + fr + ai * HALF + m * 16) * BK;
                f32x4 a0, a1;
#pragma unroll
                for (int j = 0; j < 4; ++j) { const float g0 = acc[ai][0][m][0][j], g1 = acc[ai][0][m][1][j];
                    a0[j] = g0 * fast_sigmoid(g0) * acc[ai][1][m][0][j]; a1[j] = g1 * fast_sigmoid(g1) * acc[ai][1][m][1][j]; }
                u32x4 w; w.x = cvt_pk_bf16(a0[0], a0[1]); w.y = cvt_pk_bf16(a0[2], a0[3]); w.z = cvt_pk_bf16(a1[0], a1[1]); w.w = cvt_pk_bf16(a1[2], a1[3]);
                *(u32x4*)rowp = w; }
    }
};
struct EpiInProj {
    static constexpr bool PERM = true, AFTER_DRAIN = false;
    bf16_t* XF; bf16_t* XM; bf16_t* A4; float* GT;
    __device__ __forceinline__ void operator()(const f32x4 (&acc)[2][2][4][2], const Unit& u, int wr, int wc, int fr, int fq) const {
        const int row0 = u.pm * BM + wr * 64 + fr;
        if (u.pn < 6) {
            bf16_t* base; int ldo;
            if (u.pn < 2) { base = XF + u.pn * BM; ldo = 512; } else if (u.pn < 4) { base = XM + (u.pn - 2) * BM; ldo = 512; } else { base = A4 + 512 + (u.pn - 4) * BM; ldo = 1024; }
            const int col0 = wc * 32 + 8 * fq;
#pragma unroll
            for (int ai = 0; ai < 2; ++ai)
#pragma unroll
                for (int m = 0; m < 4; ++m) { bf16_t* rowp = base + (size_t)(row0 + ai * HALF + m * 16) * ldo + col0;
#pragma unroll
                    for (int bj = 0; bj < 2; ++bj) { const f32x4 v0 = acc[ai][bj][m][0], v1 = acc[ai][bj][m][1];
                        u32x4 w; w.x = cvt_pk_bf16(v0[0], v0[1]); w.y = cvt_pk_bf16(v0[2], v0[3]); w.z = cvt_pk_bf16(v1[0], v1[1]); w.w = cvt_pk_bf16(v1[2], v1[3]);
                        *(u32x4*)(rowp + bj * HALF) = w; } }
        } else if (wc == 0 && fq < 2) {
#pragma unroll
            for (int ai = 0; ai < 2; ++ai)
#pragma unroll
                for (int m = 0; m < 4; ++m) { float* rowp = GT + (size_t)(row0 + ai * HALF + m * 16) * 16 + 8 * fq;
                    *(f32x4*)rowp = acc[ai][0][m][0]; *(f32x4*)(rowp + 4) = acc[ai][0][m][1]; }
        }
    }
};
struct EpiSlab {
    static constexpr bool PERM = false, AFTER_DRAIN = false;
    float* S; int ldo; int pm0; size_t slab_stride;
    __device__ __forceinline__ void operator()(const f32x4 (&acc)[2][2][4][2], const Unit& u, int wr, int wc, int fr, int fq) const {
        float* base = S + (size_t)u.ks * slab_stride + (size_t)((u.pm - pm0) * BM) * ldo + u.pn * BM;
        unsigned off = (unsigned)((wr * 64 + fr) * ldo + wc * 32 + 4 * fq);
#pragma unroll
        for (int ai = 0; ai < 2; ++ai)
#pragma unroll
            for (int m = 0; m < 4; ++m) { float* rowp = base + off + (unsigned)((ai * HALF + m * 16) * ldo);
#pragma unroll
                for (int bj = 0; bj < 2; ++bj)
#pragma unroll
                    for (int n = 0; n < 2; ++n) *(f32x4*)(rowp + bj * HALF + n * 16) = acc[ai][bj][m][n];
                asm volatile("" ::: "memory"); }
    }
};
template <class Epi, class Sched, bool ALIGN_EPI = false, bool SP2 = false>
__device__ __forceinline__ void gemm_phase(PG8_LAS unsigned char* lds, const Gemm g, const Sched& S, const Epi& E, int tid_in) {
    int tid_ = tid_in; asm volatile("" : "+v"(tid_)); const int tid = tid_, wid = __builtin_amdgcn_readfirstlane(tid >> 6), lane = tid & 63, wr = wid >> 2, wc = wid & 3, fr = lane & 15, fq = lane >> 4;
    const int K = g.K, nt = g.Klen / BK;
    unsigned voffA[2], voffB[2];
#pragma unroll
    for (int i = 0; i < 2; ++i) { int R, C; stage_rc(tid * 16 + i * 8192, R, C); const int Rb = Epi::PERM ? ((R & ~31) + perm32(R & 31)) : R;
        voffA[i] = (unsigned)(R * (g.atm ? BK : K) + C) * 2u; voffB[i] = (unsigned)(Rb * (g.btm ? BK : K) + C) * 2u; }
    const size_t kstepA = g.atm ? (size_t)BM * BK * 2 : (size_t)(BK * 2), hstepA = g.atm ? (size_t)HALF * BK * 2 : (size_t)HALF * K * 2, tstepA = (size_t)BM * K * 2;
    const size_t kstepB = g.btm ? (size_t)BM * BK * 2 : (size_t)(BK * 2), hstepB = g.btm ? (size_t)HALF * BK * 2 : (size_t)HALF * K * 2, tstepB = (size_t)BM * K * 2;
    const unsigned ldsw = (unsigned)wid * 1024u;
    const int aoff = lds_byte(wr * 64 + fr, fq * 8), boff = lds_byte(wc * 32 + fr, fq * 8);
#define PG8_SA(b, h) (((b) * 2 + (h)) * HTB)
#define PG8_SB(b, h) ((4 + (b) * 2 + (h)) * HTB)
#define PG8_STAGE(bufoff, gbase, voff) do { _Pragma("unroll") for (int _i = 0; _i < 2; ++_i) \
        __builtin_amdgcn_global_load_lds((const unsigned*)((const char*)(gbase) + (voff)[_i]), (PG8_LAS unsigned*)(lds + (bufoff) + ldsw + _i * 8192), 16, 0, 0); } while (0)
#define PG8_LDA(dst, b, h) do { _Pragma("unroll") for (int m = 0; m < 4; ++m) _Pragma("unroll") for (int k = 0; k < 2; ++k) dst[m][k] = *(const PG8_LAS bf16x8*)(lds + PG8_SA(b, h) + aoff + m * 2048 + k * 1024); } while (0)
#define PG8_LDB(dst, b, h) do { _Pragma("unroll") for (int n = 0; n < 2; ++n) _Pragma("unroll") for (int k = 0; k < 2; ++k) dst[n][k] = *(const PG8_LAS bf16x8*)(lds + PG8_SB(b, h) + boff + n * 2048 + k * 1024); } while (0)
#define PG8_MMA(ai, bj, At, Bt) do { __builtin_amdgcn_s_setprio(1); _Pragma("unroll") for (int m = 0; m < 4; ++m) _Pragma("unroll") for (int n = 0; n < 2; ++n) _Pragma("unroll") for (int k = 0; k < 2; ++k) \
        acc[ai][bj][m][n] = __builtin_amdgcn_mfma_f32_16x16x32_bf16(Bt[n][k], At[m][k], acc[ai][bj][m][n], 0, 0, 0); __builtin_amdgcn_s_setprio(0); } while (0)
#define PG8_WAIT_V(n) asm volatile("s_waitcnt vmcnt(" #n ")" ::: "memory")
#define PG8_WAIT_L(n) asm volatile("s_waitcnt lgkmcnt(" #n ")" ::: "memory")
#define PG8_BAR __builtin_amdgcn_s_barrier()
#define PG8_SCHED __builtin_amdgcn_sched_barrier(0)
    Unit cur, nxt; int ui = 0;
    if (!S.next(0, cur)) return;
    f32x4 acc[2][2][4][2];
#pragma unroll
    for (int a = 0; a < 2; ++a)
#pragma unroll
        for (int b = 0; b < 2; ++b)
#pragma unroll
            for (int m = 0; m < 4; ++m)
#pragma unroll
                for (int n = 0; n < 2; ++n) acc[a][b][m][n] = (f32x4){0.f, 0.f, 0.f, 0.f};
    bf16x8 At[4][2], B0[2][2], B1[2][2];
    const size_t sstepA = (size_t)(g.Klen / BK) * kstepA, sstepB = (size_t)(g.Klen / BK) * kstepB;
    const char* cA = (const char*)g.A + (size_t)cur.pm * tstepA + (size_t)cur.ks * sstepA; const char* cB = (const char*)g.Bt + (size_t)cur.pn * tstepB + (size_t)cur.ks * sstepB;
    S.a_ready(cur);
    if constexpr (SP2) {
        PG8_STAGE(PG8_SB(0, 0), cB, voffB); PG8_STAGE(PG8_SB(0, 1), cB + hstepB, voffB); PG8_STAGE(PG8_SA(0, 0), cA, voffA); PG8_STAGE(PG8_SA(0, 1), cA + hstepA, voffA);
        if (wr == 1) PG8_BAR;
        PG8_WAIT_V(2); PG8_BAR;
        PG8_STAGE(PG8_SB(1, 0), cB + kstepB, voffB); PG8_STAGE(PG8_SA(1, 0), cA + kstepA, voffA); PG8_STAGE(PG8_SB(1, 1), cB + hstepB + kstepB, voffB);
        PG8_WAIT_V(6); PG8_BAR;
    } else {
        PG8_STAGE(PG8_SB(0, 0), cB, voffB); PG8_STAGE(PG8_SA(0, 0), cA, voffA); PG8_STAGE(PG8_SB(0, 1), cB + hstepB, voffB); PG8_STAGE(PG8_SA(0, 1), cA + hstepA, voffA);
        if (wr == 1) PG8_BAR;
        PG8_WAIT_V(4); PG8_BAR;
        PG8_STAGE(PG8_SB(1, 0), cB + kstepB, voffB); PG8_STAGE(PG8_SA(1, 0), cA + kstepA, voffA); PG8_STAGE(PG8_SB(1, 1), cB + hstepB + kstepB, voffB);
        PG8_WAIT_V(6); PG8_BAR;
    }
    for (;;) {
        const bool has_next = S.next(ui + 1, nxt);
        const char* nA = has_next ? (const char*)g.A + (size_t)nxt.pm * tstepA + (size_t)nxt.ks * sstepA : cA; const char* nB = has_next ? (const char*)g.Bt + (size_t)nxt.pn * tstepB + (size_t)nxt.ks * sstepB : cB;
        for (int t = 0; t < nt; t += 2) {
            const bool last = (t == nt - 2);
            const char* a1 = cA + (size_t)(t + 1) * kstepA;
            const char* a2 = last ? nA : cA + (size_t)(t + 2) * kstepA; const char* b2 = last ? nB : cB + (size_t)(t + 2) * kstepB;
            const char* a3 = a2 + kstepA; const char* b3 = b2 + kstepB;
            if (last && has_next) S.a_ready(nxt);
            if constexpr (SP2) {
            PG8_LDB(B0, 0, 0); PG8_LDB(B1, 0, 1); PG8_SCHED; PG8_LDA(At, 0, 0); PG8_STAGE(PG8_SA(1, 1), a1 + hstepA, voffA);
            PG8_WAIT_V(8); PG8_WAIT_L(0); PG8_BAR; PG8_MMA(0, 0, At, B0); PG8_MMA(0, 1, At, B1); PG8_BAR; PG8_SCHED;
            PG8_LDA(At, 0, 1); PG8_STAGE(PG8_SB(0, 0), b2, voffB); PG8_STAGE(PG8_SB(0, 1), b2 + hstepB, voffB); PG8_STAGE(PG8_SA(0, 0), a2, voffA);
            PG8_WAIT_V(8); PG8_WAIT_L(0); PG8_BAR; PG8_MMA(1, 0, At, B0); PG8_MMA(1, 1, At, B1); PG8_BAR; PG8_SCHED;
            PG8_LDB(B0, 1, 0); PG8_LDB(B1, 1, 1); PG8_SCHED; PG8_LDA(At, 1, 0); PG8_STAGE(PG8_SA(0, 1), a2 + hstepA, voffA);
            PG8_WAIT_V(8); PG8_WAIT_L(0); PG8_BAR; PG8_MMA(0, 0, At, B0); PG8_MMA(0, 1, At, B1); PG8_BAR; PG8_SCHED;
            PG8_LDA(At, 1, 1); PG8_STAGE(PG8_SB(1, 0), b3, voffB); PG8_STAGE(PG8_SB(1, 1), b3 + hstepB, voffB); PG8_STAGE(PG8_SA(1, 0), a3, voffA);
            PG8_WAIT_V(8); PG8_WAIT_L(0); PG8_BAR; PG8_MMA(1, 0, At, B0); PG8_MMA(1, 1, At, B1); PG8_BAR; PG8_SCHED;
            } else {
            PG8_LDB(B0, 0, 0); PG8_SCHED; PG8_LDA(At, 0, 0); PG8_STAGE(PG8_SA(1, 1), a1 + hstepA, voffA);
            PG8_WAIT_L(8); PG8_BAR; PG8_WAIT_L(0); PG8_MMA(0, 0, At, B0); PG8_BAR; PG8_SCHED;
            PG8_LDB(B1, 0, 1); PG8_STAGE(PG8_SB(0, 0), b2, voffB);
            PG8_BAR; PG8_WAIT_L(0); PG8_MMA(0, 1, At, B1); PG8_BAR;
            PG8_LDA(At, 0, 1); PG8_STAGE(PG8_SA(0, 0), a2, voffA);
            PG8_BAR; PG8_WAIT_L(0); PG8_MMA(1, 0, At, B0); PG8_BAR; PG8_SCHED;
            PG8_STAGE(PG8_SB(0, 1), b2 + hstepB, voffB);
            PG8_WAIT_V(6); PG8_BAR; PG8_MMA(1, 1, At, B1); PG8_BAR;
            PG8_LDB(B0, 1, 0); PG8_SCHED; PG8_LDA(At, 1, 0); PG8_STAGE(PG8_SA(0, 1), a2 + hstepA, voffA);
            PG8_WAIT_L(8); PG8_BAR; PG8_WAIT_L(0); PG8_MMA(0, 0, At, B0); PG8_BAR; PG8_SCHED;
            PG8_LDB(B1, 1, 1); PG8_STAGE(PG8_SB(1, 0), b3, voffB);
            PG8_BAR; PG8_WAIT_L(0); PG8_MMA(0, 1, At, B1); PG8_BAR;
            PG8_LDA(At, 1, 1); PG8_STAGE(PG8_SA(1, 0), a3, voffA);
            PG8_BAR; PG8_WAIT_L(0); PG8_MMA(1, 0, At, B0); PG8_BAR; PG8_SCHED;
            PG8_STAGE(PG8_SB(1, 1), b3 + hstepB, voffB);
            PG8_WAIT_V(6); PG8_BAR; PG8_MMA(1, 1, At, B1); PG8_BAR;
            }
        }
        if constexpr (ALIGN_EPI) { if (wr == 0) PG8_BAR; }
        if constexpr (!Epi::AFTER_DRAIN) { E(acc, cur, wr, wc, fr, fq); S.done(cur); }
        if (!has_next) break;
#pragma unroll
        for (int a = 0; a < 2; ++a)
#pragma unroll
            for (int b = 0; b < 2; ++b)
#pragma unroll
                for (int m = 0; m < 4; ++m)
#pragma unroll
                    for (int n = 0; n < 2; ++n) acc[a][b][m][n] = (f32x4){0.f, 0.f, 0.f, 0.f};
        cur = nxt; cA = nA; cB = nB; ++ui;
        if constexpr (ALIGN_EPI) { if (wr == 1) PG8_BAR; }
    }
    PG8_WAIT_V(0);
    if constexpr (!ALIGN_EPI) { if (wr == 0) PG8_BAR; }
    PG8_BAR;
    if constexpr (Epi::AFTER_DRAIN) { E.fused(acc, cur, wr, wc, fr, fq, lds, wid, lane); S.done(cur); }
#undef PG8_SA
#undef PG8_SB
#undef PG8_STAGE
#undef PG8_LDA
#undef PG8_LDB
#undef PG8_MMA
#undef PG8_WAIT_V
#undef PG8_WAIT_L
#undef PG8_BAR
#undef PG8_SCHED
}
}
constexpr int NWAVES = 8, NTHR = 512;
constexpr int DM = 1024, NB = 4, SEQ = 8192, DEPTH = 2, CTXL = 256, DFF = 2816, DINP = 1552, DIN_PAD = 1792;
constexpr int TL = NB * SEQ, TC = NB * CTXL, TT = TL + TC;
constexpr int NH = 4, HD = 128, NMOD = 9;
constexpr int NCG = TT / 128;
constexpr int NUID = NCG * NH;
constexpr float EPSN = 1e-6f;

constexpr size_t MiB = 1u << 20;
constexpr size_t WS_CTL = 0, CTL_ZERO_BYTES = 1 * MiB;
constexpr size_t WS_MOD = 1 * MiB;
constexpr size_t WS_TAB = 2 * MiB;
constexpr size_t WS_WQKV = 3 * MiB;
constexpr size_t WS_XC = 4 * MiB;
constexpr size_t WS_WFFIN = 8 * MiB;
constexpr size_t WS_WFFOUT = 52 * MiB;
constexpr size_t WS_WIN = 74 * MiB;
constexpr size_t WS_WOUT = 81 * MiB;
constexpr size_t WS_XB = 88 * MiB;
constexpr size_t WS_Y = 154 * MiB;
constexpr size_t WS_R = 220 * MiB;
constexpr size_t WS_ACT = WS_R;
constexpr size_t WS_Q = WS_R;
constexpr size_t WS_K = WS_R + 33 * MiB;
constexpr size_t WS_VT = WS_R + 66 * MiB;
constexpr size_t WS_CL = WS_R + 99 * MiB;
constexpr size_t WS_A4 = WS_R + 165 * MiB;
constexpr size_t WS_GT = WS_R + 264 * MiB;
constexpr size_t WS_GA = WS_R + 267 * MiB;
constexpr size_t WS_NL = WS_R + 270 * MiB;
constexpr size_t WS_SC = WS_R + 272 * MiB;
constexpr size_t WS_WC = WS_R + 273 * MiB;
constexpr size_t WS_END = WS_R + 274 * MiB;
constexpr size_t WS_SLAB2 = WS_R + 184 * MiB;
constexpr size_t WS_SLAB4 = WS_R;
static_assert(WS_ACT + (size_t)TT * DFF * 2 <= 512 * MiB && WS_END <= 512 * MiB, "d_ws map");
static_assert((size_t)TT * 1024 * 2 <= 99 * MiB && (size_t)2 * NUID * 32768 <= 66 * MiB && (size_t)TT * 512 * 2 <= 33 * MiB, "d_ws map 2");
constexpr int CW_BAR = 4096;
constexpr size_t TAB_W1 = 0;
constexpr size_t TAB_W2 = 65536;
constexpr size_t TAB_TW = 131072;
constexpr size_t TAB_PQF = 196608;
constexpr size_t TAB_PQ32 = 458752;

constexpr int LDS_BYTES = 163840;
constexpr int MISC_OFF = LDS_BYTES - 256;
constexpr int SCR_BYTES = MISC_OFF;

#define GAS __attribute__((address_space(1)))
#define LAS __attribute__((address_space(3)))
typedef unsigned short bf16;
typedef unsigned v4u __attribute__((ext_vector_type(4)));
typedef unsigned v2u __attribute__((ext_vector_type(2)));
typedef float f32x4 __attribute__((ext_vector_type(4)));
typedef float f32x2 __attribute__((ext_vector_type(2)));
typedef short bf16x8 __attribute__((ext_vector_type(8)));
typedef short s16x4 __attribute__((ext_vector_type(4)));
typedef GAS unsigned gu32;
#define RLX_AGENT __ATOMIC_RELAXED, __HIP_MEMORY_SCOPE_AGENT
#define LDS_WAIT() asm volatile("s_waitcnt lgkmcnt(0)" ::: "memory")
#define VM_WAIT() asm volatile("s_waitcnt vmcnt(0)" ::: "memory")
#define VM_DONE() __builtin_amdgcn_s_waitcnt(0x0F70)
__device__ __forceinline__ float bf2f(unsigned b) { return __builtin_bit_cast(float, b << 16); }
typedef __bf16 bf16x2_t __attribute__((ext_vector_type(2)));
__device__ __forceinline__ unsigned pk2(float lo, float hi) { const f32x2 v = {lo, hi}; const bf16x2_t b = __builtin_convertvector(v, bf16x2_t); return __builtin_bit_cast(unsigned, b); }
__device__ __forceinline__ float wave_sum(float v) {
#pragma unroll
    for (int o = 1; o < 64; o <<= 1) v += __shfl_xor(v, o);
    return v;
}
__device__ __forceinline__ f32x4 mfma16(bf16x8 a, bf16x8 b, f32x4 c) { return __builtin_amdgcn_mfma_f32_16x16x32_bf16(a, b, c, 0, 0, 0); }
__device__ __forceinline__ float logsigf(float x) { return fminf(x, 0.f) - log1pf(__expf(-fabsf(x))); }

#ifndef DUPMASK
#define DUPMASK 0
#endif
#define REP(bit) _Pragma("unroll 1") for (int rep_ = 0; rep_ < 1 + ((DUPMASK >> (bit)) & 1); ++rep_)
__device__ __forceinline__ void lds_barrier() { asm volatile("s_waitcnt lgkmcnt(0)" ::: "memory"); __builtin_amdgcn_s_barrier(); asm volatile("" ::: "memory"); }
#define XB_TMO      128
#define XB_XCNT(j)  (256  + 64 * (j))
#define XB_XSUB(j)  (1280 + 64 * (j))
#define XB_XGEN(j)  (2304 + 64 * (j))
#define XB_TOP      3328
#define XB_TOPGEN   3392
#define XCD_BAR_WORDS 3456
#define XB_SPIN_CAP (1u << 18)

__device__ __forceinline__ unsigned xb_ld(unsigned* p)              { return __hip_atomic_load(p, __ATOMIC_RELAXED, __HIP_MEMORY_SCOPE_AGENT); }
__device__ __forceinline__ unsigned xb_add(unsigned* p, unsigned v) { return __hip_atomic_fetch_add(p, v, __ATOMIC_RELAXED, __HIP_MEMORY_SCOPE_AGENT); }
__device__ __forceinline__ unsigned xb_xcc_id() { return (unsigned)__builtin_amdgcn_s_getreg((3 << 11) | 20) & 0xFu; }
#define XB_SPIN(cond, bar) do { unsigned _sp = 0; while (cond) { __builtin_amdgcn_s_sleep(1); \
    if ((++_sp & 255u) == 0u) { if (xb_ld(&(bar)[XB_TMO])) break; if (_sp > XB_SPIN_CAP) { atomicAdd(&(bar)[XB_TMO], 1u); break; } } } } while (0)

struct XcdBarrier {
    unsigned* bar; unsigned x;
    volatile LAS unsigned* st;
};

__device__ __forceinline__ XcdBarrier xcd_barrier_post(unsigned* bar, volatile LAS unsigned* st) {
    XcdBarrier b; b.bar = bar; b.x = xb_xcc_id(); b.st = st;
    if (threadIdx.x == 0) (void)xb_add(&bar[XB_XCNT(b.x)], 1u);
    return b;
}
__device__ __forceinline__ void xcd_barrier_complete(unsigned* bar, unsigned x, unsigned& nloc, unsigned& nx, const unsigned G) {
    unsigned sum, cnt, mine, sp = 0u;
    for (;;) {
        sum = 0u; cnt = 0u; mine = 0u;
#pragma unroll
        for (unsigned j = 0; j < 16; ++j) { const unsigned c = xb_ld(&bar[XB_XCNT(j)]); sum += c; cnt += (c > 0u) ? 1u : 0u; mine = (j == x) ? c : mine; }
        if (sum == G) break;
        __builtin_amdgcn_s_sleep(1);
        if ((++sp & 255u) == 0u) { if (xb_ld(&bar[XB_TMO])) break; if (sp > XB_SPIN_CAP) { atomicAdd(&bar[XB_TMO], 1u); break; } }
    }
    nloc = mine > 0u ? mine : 1u; nx = cnt > 0u ? cnt : 1u;
}

__device__ __attribute__((noinline)) void xcd_barrier(unsigned* bar_, unsigned x_, volatile LAS unsigned* st_, int tid_, unsigned G_) { XcdBarrier b; b.bar = bar_; b.x = x_; b.st = st_;
    asm volatile("s_waitcnt vmcnt(0)" ::: "memory");
    __syncthreads();
    if (tid_ == 0) {
        unsigned* bar = b.bar;
        __builtin_amdgcn_s_waitcnt(0);
        unsigned nloc = b.st[0], nx = b.st[1];
        if (nloc == 0u) { xcd_barrier_complete(bar, b.x, nloc, nx, G_); b.st[0] = nloc; b.st[1] = nx; }
        const unsigned old = xb_add(&bar[XB_XSUB(b.x)], 1u);
        const unsigned gen = old / nloc;
        if (old + 1u == (gen + 1u) * nloc) {
            __builtin_amdgcn_fence(__ATOMIC_RELEASE, "agent");
            asm volatile("s_waitcnt vmcnt(0)" ::: "memory");
            const unsigned og = xb_add(&bar[XB_TOP], 1u);
            const unsigned tg = og / nx;
            if (og + 1u == (tg + 1u) * nx) xb_add(&bar[XB_TOPGEN], 1u);
            else XB_SPIN(xb_ld(&bar[XB_TOPGEN]) == tg, bar);
            __builtin_amdgcn_fence(__ATOMIC_ACQUIRE, "agent");
            xb_add(&bar[XB_XGEN(b.x)], 1u);
            asm volatile("s_waitcnt vmcnt(0)" ::: "memory");
        } else {
            XB_SPIN(xb_ld(&bar[XB_XGEN(b.x)]) == gen, bar);
            __builtin_amdgcn_fence(__ATOMIC_ACQUIRE, "agent");
            asm volatile("s_waitcnt vmcnt(0)" ::: "memory");
        }
    }
    __syncthreads();
}
struct Frame {
    LAS unsigned char* lds;
    volatile LAS unsigned* MISC;
    gu32* ctl;
    int tid, lane, wave;
    int vcu, G, bid;
    unsigned char* ws;
};
constexpr int PTAB_OFF = MISC_OFF + 64;
__device__ __forceinline__ unsigned long long ptab(const Frame& F, int i) { const LAS unsigned* p = (const LAS unsigned*)(F.lds + PTAB_OFF) + 2 * i;
    const unsigned lo = __builtin_amdgcn_readfirstlane(p[0]), hi = __builtin_amdgcn_readfirstlane(p[1]); return ((unsigned long long)hi << 32) | lo; }
#define FIN(i) ((const float*)(const GAS float*)ptab(F, (i)))
#define FOUT ((float*)(GAS float*)ptab(F, 17))
enum { I_X = 0, I_C, I_CTX, I_CCTX, I_WADA, I_BADA, I_NORMW, I_WFFIN, I_WFFOUT, I_WIN, I_WFMIX, I_CONVW, I_CONVB, I_WQKV, I_GATEB, I_HNW, I_WOUT };
#define WSP(T, off) ((T*)(F.ws + (off)))

__device__ __forceinline__ void p0_transpose_item(const float* W, int ldn, int nvalid, int k0, int n0, bf16* WT, int ldw, int drow, int dcol, float scale, LAS float* scr, int lane, int tm = 0) {
    const int c4 = (lane & 7) * 4; const bool ok = (n0 + c4) < nvalid;
#pragma unroll
    for (int i = 0; i < 8; ++i) { const int kk = 8 * i + (lane >> 3); const f32x4 v = ok ? *(const f32x4*)(W + (size_t)(k0 + kk) * ldn + n0 + c4) * scale : (f32x4){0.f, 0.f, 0.f, 0.f};
        LAS float* d = scr + kk * 33 + c4; d[0] = v[0]; d[1] = v[1]; d[2] = v[2]; d[3] = v[3]; }
    LDS_WAIT(); asm volatile("" ::: "memory");
    const int c = lane & 7;
#pragma unroll
    for (int j = 0; j < 4; ++j) { const int n = (lane >> 3) + 8 * j; const LAS float* s = scr + (8 * c) * 33 + n;
        v4u o; o.x = pk2(s[0 * 33], s[1 * 33]); o.y = pk2(s[2 * 33], s[3 * 33]); o.z = pk2(s[4 * 33], s[5 * 33]); o.w = pk2(s[6 * 33], s[7 * 33]);
        const int rr = drow + n, kk0 = dcol + k0;
        if (tm) *(v4u*)(WT + (((size_t)(rr >> 8) * (ldw >> 6) + (kk0 >> 6)) * 256 + (rr & 255)) * 64 + (kk0 & 63) + 8 * c) = o;
        else *(v4u*)(WT + (size_t)rr * ldw + kk0 + 8 * c) = o; }
    LDS_WAIT(); asm volatile("" ::: "memory");
}

__device__ __forceinline__ void mod_first(Frame& F) {
    const int ncol = 2048 / F.G;
    if (ncol != 8) return;
    const int c0 = 8 * F.vcu, kc = F.tid >> 1, q = F.tid & 1;
    const float* cin = FIN(I_C); const float* cctx = FIN(I_CCTX); const float* wada = FIN(I_WADA);
    f32x4 a[5];
#pragma unroll
    for (int bi = 0; bi < 5; ++bi) a[bi] = (f32x4){0.f, 0.f, 0.f, 0.f};
#pragma unroll
    for (int kk = 0; kk < 4; ++kk) { const int k = 4 * kc + kk; const f32x4 w = *(const f32x4*)(wada + (size_t)k * (NMOD * DM) + c0 + 4 * q);
#pragma unroll
        for (int bi = 0; bi < 5; ++bi) { const float v = (bi < 4) ? cin[bi * DM + k] : cctx[k]; a[bi] += w * (v / (1.f + __expf(-v))); } }
    LAS f32x4* red = (LAS f32x4*)F.lds;
#pragma unroll
    for (int bi = 0; bi < 5; ++bi) red[(kc * 2 + q) * 5 + bi] = a[bi];
    __syncthreads();
    if (F.tid < 40) { const int bi = F.tid >> 3, col = F.tid & 7; float s = FIN(I_BADA)[c0 + col];
        for (int k2 = 0; k2 < 256; ++k2) s += red[(k2 * 2 + (col >> 2)) * 5 + bi][col & 3];
        WSP(float, WS_MOD)[(size_t)bi * (NMOD * DM) + c0 + col] = s; }
    __syncthreads();
}
__device__ __forceinline__ void p0_prologue(Frame& F, const int stage, const int wgi, const int NWG) {
    const int gw = wgi * NWAVES + F.wave, NGW = NWG * NWAVES;
    const float* const p_w_ff_in = FIN(I_WFFIN); const float* const p_w_ff_out = FIN(I_WFFOUT); const float* const p_w_in = FIN(I_WIN); const float* const p_w_out = FIN(I_WOUT); const float* const p_w_qkv = FIN(I_WQKV);
    {
        LAS float* scr = (LAS float*)(F.lds + F.wave * 16384);
        constexpr int I_FI = (DM / 64) * (2 * DFF / 32);
        constexpr int I_FO = (DFF / 64) * (DM / 32);
        constexpr int I_IN = (DM / 64) * 49;
        constexpr int I_WO = (DM / 64) * (DM / 32);
        constexpr int I_QK = 12 * 2 * 4;
        constexpr int I_ZR = 224 / 4;
        constexpr int PER_L = 2 * I_FI + 2 * I_FO + I_IN + I_WO + I_QK + I_ZR;
        const int r_lo = (stage == 1) ? I_FI : 0, r_hi = (stage == 0) ? I_FI : (stage == 3 ? DEPTH * PER_L : PER_L);
        REP(22) for (int it = gw; it < r_hi - r_lo; it += NGW) {
            const int l = (stage == 3) ? (r_lo + it) / PER_L : ((stage == 2) ? 1 : 0); int r = (r_lo + it) % PER_L;
            if (r < 2 * I_FI) { const int f = r / I_FI; r %= I_FI; const int nb = r % 176, kb = r / 176; const int n0 = nb * 32;
                const int drow = (n0 < DFF) ? (256 * (n0 >> 7) + (n0 & 127)) : (256 * ((n0 - DFF) >> 7) + 128 + ((n0 - DFF) & 127));
                p0_transpose_item(p_w_ff_in + (size_t)(l * 2 + f) * DM * 2 * DFF, 2 * DFF, 2 * DFF, kb * 64, n0, WSP(bf16, WS_WFFIN) + (size_t)(l * 2 + f) * 2 * DFF * DM, DM, drow, 0, 1.f, scr, F.lane); continue; }
            r -= 2 * I_FI;
            if (r < 2 * I_FO) { const int f = r / I_FO; r %= I_FO; const int nb = r % 32, kb = r / 32;
                p0_transpose_item(p_w_ff_out + (size_t)(l * 2 + f) * DFF * DM, DM, DM, kb * 64, nb * 32, WSP(bf16, WS_WFFOUT) + (size_t)(l * 2 + f) * DM * DFF, DFF, nb * 32, 0, 1.f, scr, F.lane, 1); continue; }
            r -= 2 * I_FO;
            if (r < I_IN) { const int nb = r % 49, kb = r / 49;
                p0_transpose_item(p_w_in + (size_t)l * DM * DINP, DINP, DINP, kb * 64, nb * 32, WSP(bf16, WS_WIN) + (size_t)l * DIN_PAD * DM, DM, nb * 32, 0, 1.f, scr, F.lane); continue; }
            r -= I_IN;
            if (r < I_WO) { const int nb = r % 32, kb = r / 32;
                p0_transpose_item(p_w_out + (size_t)l * DM * DM, DM, DM, kb * 64, nb * 32, WSP(bf16, WS_WOUT) + (size_t)l * DM * DM, DM, nb * 32, 0, 1.f, scr, F.lane); continue; }
            r -= I_WO;
            if (r < I_QK) { const int mat = r / 8, q = r % 8, nb = q % 4, kb = q / 4;
                p0_transpose_item(p_w_qkv + ((size_t)l * 12 + mat) * HD * HD, HD, HD, kb * 64, nb * 32, WSP(bf16, WS_WQKV) + ((size_t)l * 12 + mat) * HD * HD, HD, nb * 32, 0, (mat / 4 == 1) ? 0.08838834764831845f : 1.f, scr, F.lane); continue; }
            r -= I_QK;
            { bf16* z = WSP(bf16, WS_WIN) + (size_t)l * DIN_PAD * DM + (size_t)(1568 + 4 * r) * DM;
#pragma unroll
              for (int j = 0; j < 8; ++j) *(v4u*)(z + (size_t)(j * 64 + F.lane) * 8) = (v4u){0u, 0u, 0u, 0u}; }
        }
    }
    __syncthreads();
    constexpr int I_MOD = DEPTH * (NMOD * DM / 64);
    constexpr int I_FW = DEPTH * 8;
    constexpr int I_TB = 112 + 256;
    const int b_lo = (stage == 0 || stage == 3) ? 0 : (stage == 1 ? I_MOD : I_MOD + I_FW / 2), b_hi = (stage == 0) ? I_MOD : (stage == 1 ? I_MOD + I_FW / 2 : I_MOD + I_FW);
    REP(23) for (int it0 = wgi; it0 < b_hi - b_lo + ((stage == 1 || stage == 3) ? I_TB : 0); it0 += NWG) {
        const int it = (b_lo + it0 < b_hi) ? b_lo + it0 : I_MOD + I_FW + (b_lo + it0 - b_hi);
        if (it < I_MOD) {
            if (it < 32 && F.G == 256) continue;
            const int l = it / 144, j0 = (it % 144) * 64;
            LAS float* sc = (LAS float*)F.lds;
            LAS float* red = (LAS float*)(F.lds + 20480);
            for (int i = F.tid; i < 5 * DM; i += NTHR) { const int bi = i >> 10, k = i & 1023; const float v = (bi < 4) ? FIN(I_C)[bi * DM + k] : FIN(I_CCTX)[k]; sc[i] = v / (1.f + __expf(-v)); }
            __syncthreads();
            const int q = F.tid & 15, kc = F.tid >> 4;
            f32x4 a[5];
#pragma unroll
            for (int bi = 0; bi < 5; ++bi) a[bi] = (f32x4){0.f, 0.f, 0.f, 0.f};
            const float* wp = FIN(I_WADA) + (size_t)l * DM * NMOD * DM + (size_t)(kc * 32) * (NMOD * DM) + j0 + 4 * q;
#pragma unroll 16
            for (int k = 0; k < 32; ++k) { const f32x4 w = *(const f32x4*)(wp + (size_t)k * (NMOD * DM));
#pragma unroll
                for (int bi = 0; bi < 5; ++bi) a[bi] += w * sc[bi * DM + kc * 32 + k]; }
#pragma unroll
            for (int bi = 0; bi < 5; ++bi) *(LAS f32x4*)(red + (kc * 5 + bi) * 64 + 4 * q) = a[bi];
            __syncthreads();
            if (F.tid < 320) { const int bi = F.tid >> 6, col = F.tid & 63; float s = FIN(I_BADA)[l * NMOD * DM + j0 + col];
                for (int k2 = 0; k2 < 32; ++k2) s += red[(k2 * 5 + bi) * 64 + col];
                WSP(float, WS_MOD)[((size_t)l * 5 + bi) * (NMOD * DM) + j0 + col] = s; }
            __syncthreads();
        } else if (it < I_MOD + I_FW) {
            const int r = it - I_MOD, g = r & 7, l = r >> 3;
            LAS float* tab = (LAS float*)F.lds;
            LAS float* FM = (LAS float*)(F.lds + 1024);
            LAS float* PQ = (LAS float*)(F.lds + 1024 + 16384);
            if (F.tid < 64) { float sv, cv; sincospif((float)F.tid * (1.f / 32.f), &sv, &cv); tab[F.tid] = 0.125f * cv; tab[64 + F.tid] = -0.125f * sv; }
            for (int i = F.tid; i < 4096; i += NTHR) FM[i] = FIN(I_WFMIX)[((size_t)l * 8 + g) * 4096 + i];
            __syncthreads();
            { const int d4 = (F.tid & 15) * 4, c0 = F.tid >> 4;
              f32x4 s0 = {0.f, 0.f, 0.f, 0.f}, s1 = s0, t0 = s0, t1 = s0;
#pragma unroll 8
              for (int e = 0; e < 64; ++e) { const f32x4 fm = *(const LAS f32x4*)(FM + e * 64 + d4); const int m0 = (c0 * e) & 63, m1 = ((c0 + 32) * e) & 63;
                  s0 += fm * tab[m0]; s1 += fm * tab[m1]; t0 += fm * tab[64 + m0]; t1 += fm * tab[64 + m1]; }
              *(LAS f32x4*)(PQ + c0 * 64 + d4) = s0; *(LAS f32x4*)(PQ + (c0 + 32) * 64 + d4) = s1; *(LAS f32x4*)(PQ + 4096 + c0 * 64 + d4) = t0; *(LAS f32x4*)(PQ + 4096 + (c0 + 32) * 64 + d4) = t1; }
            __syncthreads();
            { float* o32 = (float*)(F.ws + WS_TAB + TAB_PQ32) + ((size_t)l * 8 + g) * 8192;
              for (int i = F.tid; i < 8192; i += NTHR) o32[i] = PQ[i];
              bf16* of = (bf16*)(F.ws + WS_TAB + TAB_PQF) + ((size_t)l * 8 + g) * 8192;
              for (int i = F.tid; i < 8192; i += NTHR) { const int e = i & 7, ln = (i >> 3) & 63, ks = (i >> 9) & 3, nd = i >> 11;
                  const int d = 16 * nd + (ln & 15), c = 32 * (ks & 1) + 16 * (e >> 2) + 4 * (ln >> 4) + (e & 3);
                  of[i] = (bf16)(pk2(PQ[(ks >> 1) * 4096 + c * 64 + d], 0.f) & 0xffffu); } }
            __syncthreads();
        } else {
            const int ti = it - I_MOD - I_FW;
            if (ti < 64) {
                bf16* o = (bf16*)(F.ws + WS_TAB + TAB_W1);
                { const int i = ti * NTHR + F.tid; const int e = i & 7, ln = (i >> 3) & 63, t = (i >> 9) & 3, tl = (i >> 11) & 1, w = i >> 12;
                    const int g = ln >> 4, k1 = 16 * w + (ln & 15), s1 = 32 * t + 16 * (g >> 1) + 8 * (e >> 2) + 4 * (g & 1) + (e & 3);
                    float sv, cv; sincospif((float)((k1 * s1) & 127) * (1.f / 64.f), &sv, &cv);
                    o[i] = (bf16)(pk2(tl ? sv : cv, 0.f) & 0xffffu); }
            } else if (ti < 96) {
                bf16* o = (bf16*)(F.ws + WS_TAB + TAB_W2);
                { const int i = (ti - 64) * NTHR + F.tid; const int e = i & 7, ln = (i >> 3) & 63, t = (i >> 9) & 3, w = i >> 11;
                    const int g = ln >> 4, k2 = 16 * (w & 3) + (ln & 15), sp = 32 * t + 16 * (g >> 1) + 8 * (e >> 2) + 4 * (g & 1) + (e & 3), s2 = sp & 63, inim = sp >> 6, outim = w >> 2;
                    float sv, cv; sincospif((float)((k2 * s2) & 63) * (1.f / 32.f), &sv, &cv);
                    const float v = outim ? (inim ? cv : sv) : (inim ? -sv : cv);
                    o[i] = (bf16)(pk2(v, 0.f) & 0xffffu); }
            } else if (ti >= 112) {
                bf16* o = (bf16*)(F.ws + WS_WC);
                { const int i = (ti - 112) * NTHR + F.tid; const int e = i & 7, ln = (i >> 3) & 63, t = (i >> 9) & 7, tl = (i >> 12) & 1, w = i >> 13;
                    const int g = ln >> 4, k = 16 * w + (ln & 15), sp = 32 * t + 16 * (g >> 1) + 8 * (e >> 2) + 4 * (g & 1) + (e & 3);
                    float sv, cv; sincospif((float)((k * sp) & 255) * (1.f / 128.f), &sv, &cv);
                    o[i] = (bf16)(pk2(0.0625f * (tl ? sv : cv), 0.f) & 0xffffu); }
            } else {
                f32x2* o = (f32x2*)(F.ws + WS_TAB + TAB_TW);
                { const int i = (ti - 96) * NTHR + F.tid; const int s2 = i & 63, k1 = i >> 6; float sv, cv; sincospif((float)(k1 * s2) * (1.f / 4096.f), &sv, &cv);
                    o[i] = (f32x2){cv * 0.011048543456039806f, sv * 0.011048543456039806f}; }
            }
        }
    }
}

struct Thin {
    const void* xin_l; const float* xin_c;
    void* xout_l; float* xout_c;
    const bf16* Y;
    const float* YS;
    const float* nw_post; const float* gate;
    bf16* H; const float* nw_pre; const float* scale; const float* shift;
    float fac; int nslab; int nrows; int xin_bf, xout_bf;
};
#ifdef DBG_FLAGS
#define DBG_FLAG(bit) __hip_atomic_fetch_or((unsigned*)(F.ctl + 64), 1u << (bit), __ATOMIC_RELAXED, __HIP_MEMORY_SCOPE_AGENT)
#else
#define DBG_FLAG(bit) do {} while (0)
#endif
#ifdef DBG_FLAGS
#define DBG_CHK(val, bit) do { if (!(fabsf(val) < 1e30f)) DBG_FLAG(bit); } while (0)
#else
#define DBG_CHK(val, bit) do {} while (0)
#endif
__device__ __forceinline__ void thin_finish(Frame& F, const Thin& P, const int r, f32x4 (&x)[4], const f32x4 (&y)[4], const f32x4 (&A1)[4], const f32x4 (&A2)[4], const f32x4 (&A3)[4], const bool dry) {
    if (P.Y) { float ss = 0.f;
#pragma unroll
        for (int j = 0; j < 4; ++j) ss += (y[j].x * y[j].x + y[j].y * y[j].y) + (y[j].z * y[j].z + y[j].w * y[j].w);
        const float rs = 1.0f / sqrtf(wave_sum(ss) * (1.f / DM) + EPSN);
#pragma unroll
        for (int j = 0; j < 4; ++j) x[j] += A1[j] * (y[j] * rs); }
    if (r < TL) { if (P.xout_l) { if (P.xout_bf) { bf16* xo = (dry ? WSP(bf16, WS_ACT) : (bf16*)P.xout_l) + (size_t)r * DM;
#pragma unroll
                for (int j = 0; j < 4; ++j) { v2u w; w.x = pk2(x[j].x, x[j].y); w.y = pk2(x[j].z, x[j].w); *(v2u*)(xo + 4 * F.lane + 256 * j) = w; } }
            else { float* xo = (dry ? WSP(float, WS_ACT) : (float*)P.xout_l) + (size_t)r * DM;
#pragma unroll
                for (int j = 0; j < 4; ++j) *(f32x4*)(xo + 4 * F.lane + 256 * j) = x[j]; } } }
    else if (P.xout_c) { float* xo = (dry ? WSP(float, WS_ACT) + (size_t)TL * DM : P.xout_c) + (size_t)(r - TL) * DM;
#pragma unroll
        for (int j = 0; j < 4; ++j) *(f32x4*)(xo + 4 * F.lane + 256 * j) = x[j]; }
    if (P.H) { float ss = 0.f;
#pragma unroll
        for (int j = 0; j < 4; ++j) ss += (x[j].x * x[j].x + x[j].y * x[j].y) + (x[j].z * x[j].z + x[j].w * x[j].w);
        const float rs = 1.0f / sqrtf(wave_sum(ss) * (1.f / DM) + EPSN);
        bf16* hr = P.H + (size_t)r * DM;
#pragma unroll
        for (int j = 0; j < 4; ++j) { const f32x4 h = x[j] * rs * A2[j] + A3[j]; v2u w; w.x = pk2(h.x, h.y); w.y = pk2(h.z, h.w); *(v2u*)(hr + 4 * F.lane + 256 * j) = w; } }
}
__device__ __forceinline__ void thin_vectors(Frame& F, const Thin& P, const int bi, f32x4 (&A1)[4], f32x4 (&A2)[4], f32x4 (&A3)[4]) {
#pragma unroll
    for (int j = 0; j < 4; ++j) { const int col = 4 * F.lane + 256 * j;
        if (P.Y) A1[j] = *(const f32x4*)(P.gate + (size_t)bi * (NMOD * DM) + col) * *(const f32x4*)(P.nw_post + col) * P.fac;
        if (P.H) { A2[j] = *(const f32x4*)(P.nw_pre + col) * (*(const f32x4*)(P.scale + (size_t)bi * (NMOD * DM) + col) + 1.0f); A3[j] = *(const f32x4*)(P.shift + (size_t)bi * (NMOD * DM) + col); } }
}
__device__ __forceinline__ f32x4 bf4(v2u w) { return (f32x4){bf2f(w.x & 0xffffu), bf2f(w.x >> 16), bf2f(w.y & 0xffffu), bf2f(w.y >> 16)}; }
__device__ __forceinline__ void thin_phase(Frame& F, const Thin& P, int dbg_idx = 99, bool dry = false) {
    const int gw = F.vcu * NWAVES + F.wave, NGW = F.G * NWAVES;
    const int nlat = (P.nrows < TL) ? P.nrows : TL;
    const bool has_ctx = P.nrows > TL;
    const int CTXW = (P.nslab > 0) ? 4 : 1;
    int r0, r1;
    if (!has_ctx || NGW != 2048) { const int per = (nlat + NGW - 1) / NGW; r0 = gw * per; r1 = (r0 + per < nlat) ? r0 + per : nlat; }
    else { const int a = 16 - CTXW / 2, b = 16 + CTXW / 2;
        if (gw < 1024) { r0 = gw * a; r1 = r0 + a; } else { r0 = 1024 * a + (gw - 1024) * b; r1 = r0 + b; } }
    int cur = -1;
    f32x4 A1[4], A2[4], A3[4];
    v2u nxb[4], nyb[4]; f32x4 nxf[4];
#define THIN_LOAD(r_) do { const int rr_ = (r_); if (P.xin_bf) { const bf16* xr_ = (const bf16*)P.xin_l + (size_t)rr_ * DM; _Pragma("unroll") for (int j = 0; j < 4; ++j) nxb[j] = *(const v2u*)(xr_ + 4 * F.lane + 256 * j); } \
        else { const float* xr_ = (const float*)P.xin_l + (size_t)rr_ * DM; _Pragma("unroll") for (int j = 0; j < 4; ++j) nxf[j] = *(const f32x4*)(xr_ + 4 * F.lane + 256 * j); } \
        if (P.Y) { const bf16* yr_ = P.Y + (size_t)rr_ * DM; _Pragma("unroll") for (int j = 0; j < 4; ++j) nyb[j] = *(const v2u*)(yr_ + 4 * F.lane + 256 * j); } } while (0)
    if (r0 < r1) THIN_LOAD(r0);
    for (int r = r0; r < r1; ++r) {
        f32x4 x[4], y[4];
#pragma unroll
        for (int j = 0; j < 4; ++j) { x[j] = P.xin_bf ? bf4(nxb[j]) : nxf[j]; y[j] = P.Y ? bf4(nyb[j]) : (f32x4){0.f, 0.f, 0.f, 0.f}; }
        if (r + 1 < r1) THIN_LOAD(r + 1);
        const int bi = r >> 13;
        if (bi != cur) { cur = bi; thin_vectors(F, P, bi, A1, A2, A3); VM_DONE(); }
        thin_finish(F, P, r, x, y, A1, A2, A3, dry);
    }
#undef THIN_LOAD
    if (has_ctx && gw < TC) { const int r = TL + gw;
        thin_vectors(F, P, 4, A1, A2, A3);
        f32x4 x[4], y[4]; const float* xr = P.xin_c + (size_t)gw * DM;
#pragma unroll
        for (int j = 0; j < 4; ++j) { x[j] = *(const f32x4*)(xr + 4 * F.lane + 256 * j); y[j] = (f32x4){0.f, 0.f, 0.f, 0.f}; }
        if (P.Y) { if (P.nslab > 0) {
#pragma unroll 4
                for (int ks = 0; ks < P.nslab; ++ks) { const float* sr = P.YS + ((size_t)ks * TC + gw) * DM;
#pragma unroll
                    for (int j = 0; j < 4; ++j) y[j] += *(const f32x4*)(sr + 4 * F.lane + 256 * j); } }
            else { const bf16* yr = P.Y + (size_t)r * DM;
#pragma unroll
                for (int j = 0; j < 4; ++j) y[j] = bf4(*(const v2u*)(yr + 4 * F.lane + 256 * j)); } }
        thin_finish(F, P, r, x, y, A1, A2, A3, dry);
    }
}
constexpr int RS = 272;
constexpr int TILE_B = 128 * RS;
__device__ __forceinline__ int cg_row0(int cg) { return cg * 128; }
__device__ __forceinline__ bf16x8 lds_frag(const LAS unsigned char* p) { return *(const LAS bf16x8*)p; }
__device__ __forceinline__ bf16x8 glb_frag(const bf16* p) { return *(const bf16x8*)p; }
__device__ __forceinline__ void st4bf(bf16* p, f32x4 v) { v2u w; w.x = pk2(v[0], v[1]); w.y = pk2(v[2], v[3]); *(v2u*)p = w; }
__device__ __forceinline__ void st4bf_lds(LAS unsigned char* p, f32x4 v) { v2u w; w.x = pk2(v[0], v[1]); w.y = pk2(v[2], v[3]); *(LAS v2u*)p = w; }

template <int CTRL, int RM> __device__ __forceinline__ float dpp_f(float idv, float v) { return __builtin_bit_cast(float, __builtin_amdgcn_update_dpp(__builtin_bit_cast(int, idv), __builtin_bit_cast(int, v), CTRL, RM, 0xf, false)); }
__device__ __forceinline__ float dscan_add(float v) {
    v += dpp_f<0x111, 0xf>(0.f, v); v += dpp_f<0x112, 0xf>(0.f, v); v += dpp_f<0x114, 0xf>(0.f, v); v += dpp_f<0x118, 0xf>(0.f, v);
    v += dpp_f<0x142, 0xa>(0.f, v); v += dpp_f<0x143, 0xc>(0.f, v); return v; }
__device__ __forceinline__ float dscan_max(float v) { const float ni = -3.0e38f;
    v = fmaxf(v, dpp_f<0x111, 0xf>(ni, v)); v = fmaxf(v, dpp_f<0x112, 0xf>(ni, v)); v = fmaxf(v, dpp_f<0x114, 0xf>(ni, v)); v = fmaxf(v, dpp_f<0x118, 0xf>(ni, v));
    v = fmaxf(v, dpp_f<0x142, 0xa>(ni, v)); v = fmaxf(v, dpp_f<0x143, 0xc>(ni, v)); return v; }
__device__ __forceinline__ float lane63(float v) { return __builtin_bit_cast(float, __builtin_amdgcn_readlane(__builtin_bit_cast(int, v), 63)); }
__device__ __forceinline__ float wscan_add_up(float v, int lane) {
#pragma unroll
    for (int o = 1; o < 64; o <<= 1) { const float t = __shfl_up(v, o); if (lane >= o) v += t; }
    return v; }
__device__ __forceinline__ float wscan_add_down(float v, int lane) {
#pragma unroll
    for (int o = 1; o < 64; o <<= 1) { const float t = __shfl_down(v, o); if (lane + o < 64) v += t; }
    return v; }
__device__ __forceinline__ float wscan_max_up(float v, int lane) {
#pragma unroll
    for (int o = 1; o < 64; o <<= 1) { const float t = __shfl_up(v, o); if (lane >= o) v = fmaxf(v, t); }
    return v; }
__device__ __forceinline__ float wscan_max_down(float v, int lane) {
#pragma unroll
    for (int o = 1; o < 64; o <<= 1) { const float t = __shfl_down(v, o); if (lane + o < 64) v = fmaxf(v, t); }
    return v; }
__device__ __forceinline__ float wave_max(float v) {
#pragma unroll
    for (int o = 1; o < 64; o <<= 1) v = fmaxf(v, __shfl_xor(v, o));
    return v; }

__device__ __forceinline__ void m1_phase(Frame& F, int l) {
    LAS unsigned char* HALO = F.lds;
    LAS unsigned char* XM = HALO + 64 * RS;
    LAS unsigned char* CV = F.lds + 2 * TILE_B;
    LAS unsigned char* VT = F.lds + 3 * TILE_B;
#define KT_ROW(dk_) (HALO + ((dk_) + (((dk_) & 64) << 1)) * RS)
    LAS float* FL = (LAS float*)(F.lds + 4 * TILE_B);
    const bf16* UXM = WSP(bf16, WS_Y) + (size_t)TT * 512;
    const float* GT = WSP(float, WS_GT);
    bf16* Qg = WSP(bf16, WS_Q); bf16* Kg = WSP(bf16, WS_K); bf16* VTg = WSP(bf16, WS_VT); bf16* CLg = WSP(bf16, WS_CL);
    float* GA = WSP(float, WS_GA); float* NL = WSP(float, WS_NL); float* SC = WSP(float, WS_SC);
    const bf16* WQ = WSP(bf16, WS_WQKV) + (size_t)l * 12 * HD * HD;
    const int wv = F.wave;
    const float* const p_conv_w = FIN(I_CONVW); const float* const p_conv_b = FIN(I_CONVB); const float* const p_gate_b = FIN(I_GATEB);
    bf16x8 wq[4], wk[4], wvv[4]; int cur_h = -1;
    v4u hpre[8];
#define M1_HALO_ISSUE(uid_) do { const int u_ = (uid_), cg_ = u_ >> 2, h_ = u_ & 3; const bool isc_ = cg_ >= 256; const int r0_ = cg_ * 128; \
        const int seq0_ = isc_ ? (TL + ((cg_ - 256) >> 1) * 256) : ((cg_ >> 6) * SEQ); const int s0_ = r0_ - seq0_, L_ = isc_ ? CTXL : SEQ; \
        _Pragma("unroll") for (int it = 0; it < 8; ++it) { const int ch = tid_i + NTHR * it, row = ch >> 4, c16 = ch & 15; const int s_ = s0_ - 64 + row; const bool ok_ = (unsigned)s_ < (unsigned)L_; \
            asm volatile("global_load_dwordx4 %0, %1, off" : "=v"(hpre[it]) : "v"(UXM + (size_t)(seq0_ + (ok_ ? s_ : s0_)) * 512 + h_ * 128 + 8 * c16) : "memory"); } } while (0)
    bool first_unit = true;
    if (F.vcu < NUID) { const int tid_i = F.tid; M1_HALO_ISSUE(F.vcu); }
    for (int uid = F.vcu; uid < NUID; uid += F.G) {
        int tid = F.tid; asm volatile("" : "+v"(tid));
        const int lane = tid & 63, li = lane & 15, g = lane >> 4;
        const int cg = uid >> 2, h = uid & 3;
        const bool isc = cg >= 256;
        const int r0 = cg * 128;
        const int seq0 = isc ? (TL + ((cg - 256) >> 1) * 256) : ((cg >> 6) * SEQ);
        const int s0 = r0 - seq0;
        if (h != cur_h) { cur_h = h;
            lds_barrier();
            for (int i = tid; i < 1280; i += NTHR) { const int tap = i >> 7, ch = i & 127;
                FL[256 + i] = (tap < 9) ? p_conv_w[((size_t)l * 9 + tap) * 512 + h * 128 + ch] : p_conv_b[l * 512 + h * 128 + ch]; }
#pragma unroll
            for (int ks = 0; ks < 4; ++ks) { const int off = (16 * wv + li) * HD + 32 * ks + 8 * g;
                wq[ks] = glb_frag(WQ + (size_t)(0 * 4 + h) * HD * HD + off); wk[ks] = glb_frag(WQ + (size_t)(1 * 4 + h) * HD * HD + off); wvv[ks] = glb_frag(WQ + (size_t)(2 * 4 + h) * HD * HD + off); }
            lds_barrier(); }
        float gpv[8];
        if (wv == 0) { const float* gp0 = GT + (size_t)(r0 + 2 * lane) * 16;
#pragma unroll
            for (int q = 0; q < 4; ++q) { gpv[2 * q] = gp0[4 * q + h]; gpv[2 * q + 1] = gp0[16 + 4 * q + h]; } }
        REP(16) {
        { const int L = isc ? CTXL : SEQ; unsigned mall;
          if (first_unit) asm volatile("s_waitcnt vmcnt(0)\n\ts_mov_b32 %0, -1" : "=s"(mall) :: "memory"); else asm volatile("s_waitcnt vmcnt(40)\n\ts_mov_b32 %0, -1" : "=s"(mall) :: "memory");
          first_unit = false;
#pragma unroll
          for (int it = 0; it < 8; ++it) { const int ch = tid + NTHR * it, row = ch >> 4, c16 = ch & 15; const int s = s0 - 64 + row; const unsigned m_ = ((unsigned)s < (unsigned)L) ? mall : 0u;
              *(LAS v4u*)(HALO + row * RS + 16 * c16) = (v4u){hpre[it].x & m_, hpre[it].y & m_, hpre[it].z & m_, hpre[it].w & m_}; } }
        lds_barrier();
        { const int cb = tid & 15, tg = tid >> 4;
          f32x2 ac[4][4];
          const f32x4 b0 = *(const LAS f32x4*)(FL + 256 + 9 * 128 + 8 * cb), b1 = *(const LAS f32x4*)(FL + 256 + 9 * 128 + 8 * cb + 4);
          const f32x2 bias[4] = {(f32x2){b0[0], b0[1]}, (f32x2){b0[2], b0[3]}, (f32x2){b1[0], b1[1]}, (f32x2){b1[2], b1[3]}};
          const bool zl = !isc && (tg & 15) == 0, zr = !isc && (tg & 15) == 15;
          const LAS unsigned char* hb = HALO + (63 + 4 * tg) * RS + 16 * cb; const int o0 = zl ? RS : 0, o5 = zr ? 4 * RS : 5 * RS;
#pragma unroll
          for (int dy = -1; dy <= 1; ++dy) {
              if (isc && dy != 0) continue;
              f32x2 xr[6][4];
#pragma unroll
              for (int j = 0; j < 6; ++j) {
                  v4u x = *(const LAS v4u*)(hb + 64 * dy * RS + (j == 0 ? o0 : (j == 5 ? o5 : j * RS)));
                  if ((j == 0 && zl) || (j == 5 && zr)) x = (v4u){0u, 0u, 0u, 0u};
                  xr[j][0] = (f32x2){__builtin_bit_cast(float, x.x << 16), __builtin_bit_cast(float, x.x & 0xffff0000u)}; xr[j][1] = (f32x2){__builtin_bit_cast(float, x.y << 16), __builtin_bit_cast(float, x.y & 0xffff0000u)};
                  xr[j][2] = (f32x2){__builtin_bit_cast(float, x.z << 16), __builtin_bit_cast(float, x.z & 0xffff0000u)}; xr[j][3] = (f32x2){__builtin_bit_cast(float, x.w << 16), __builtin_bit_cast(float, x.w & 0xffff0000u)}; }
#pragma unroll
              for (int dx = -1; dx <= 1; ++dx) { const int tap = (dy + 1) * 3 + dx + 1;
                  const f32x4 w0 = *(const LAS f32x4*)(FL + 256 + tap * 128 + 8 * cb), w1 = *(const LAS f32x4*)(FL + 256 + tap * 128 + 8 * cb + 4);
                  const f32x2 wp[4] = {(f32x2){w0[0], w0[1]}, (f32x2){w0[2], w0[3]}, (f32x2){w1[0], w1[1]}, (f32x2){w1[2], w1[3]}};
#pragma unroll
                  for (int i = 0; i < 4; ++i)
#pragma unroll
                      for (int c = 0; c < 4; ++c) ac[i][c] = wp[c] * xr[i + dx + 1][c] + ((tap == (isc ? 3 : 0)) ? bias[c] : ac[i][c]); } }
#pragma unroll
          for (int i = 0; i < 4; ++i) { float a[8] = {ac[i][0][0], ac[i][0][1], ac[i][1][0], ac[i][1][1], ac[i][2][0], ac[i][2][1], ac[i][3][0], ac[i][3][1]};
#pragma unroll
              for (int j = 0; j < 8; ++j) { a[j] = a[j] * pg8::fast_sigmoid(a[j]); DBG_CHK(a[j], 1); }
              v4u o; o.x = pk2(a[0], a[1]); o.y = pk2(a[2], a[3]); o.z = pk2(a[4], a[5]); o.w = pk2(a[6], a[7]);
              *(LAS v4u*)(CV + (4 * tg + i) * RS + 16 * cb) = o; } }
        }
        REP(17) if (wv == 0) { const float* gb = p_gate_b + l * 16;
            const float if0 = gpv[0] + gb[h], if1 = gpv[1] + gb[h], lf0 = logsigf(gpv[2] + gb[4 + h]), lf1 = logsigf(gpv[3] + gb[4 + h]);
            const float ib0 = gpv[4] + gb[8 + h], ib1 = gpv[5] + gb[8 + h], lb0 = logsigf(gpv[6] + gb[12 + h]), lb1 = logsigf(gpv[7] + gb[12 + h]);
            DBG_CHK(if0 + if1 + lf0 + lf1 + ib0 + ib1 + lb0 + lb1, 0);
            const float pin = dscan_add(lf0 + lf1);
            const float bf1 = pin, bf0 = pin - lf1, btf = lane63(pin);
            const float pb_ = dscan_add(lb0 + lb1), btb = lane63(pb_);
            const float sin_ = btb - pb_ + (lb0 + lb1);
            const float bb0 = sin_, bb1 = sin_ - lb0;
            const float af0 = btf - bf0 + if0, af1 = btf - bf1 + if1, ab0 = btb - bb0 + ib0, ab1 = btb - bb1 + ib1;
            const float mf = lane63(dscan_max(fmaxf(af0, af1))), mb = lane63(dscan_max(fmaxf(ab0, ab1)));
            FL[2 * lane] = __expf(af0 - mf); FL[2 * lane + 1] = __expf(af1 - mf); FL[128 + 2 * lane] = __expf(ab0 - mb); FL[128 + 2 * lane + 1] = __expf(ab1 - mb);
            *(f32x4*)(GA + ((size_t)(r0 + 2 * lane) * 4 + h) * 4) = (f32x4){bf0, if0 - bf0, bb0, ib0 - bb0};
            *(f32x4*)(GA + ((size_t)(r0 + 2 * lane + 1) * 4 + h) * 4) = (f32x4){bf1, if1 - bf1, bb1, ib1 - bb1};
            if (lane == 0) { SC[(0 * 2 + 0) * NUID + uid] = mf; SC[(0 * 2 + 1) * NUID + uid] = mb; SC[(1 * 2 + 0) * NUID + uid] = btf; SC[(1 * 2 + 1) * NUID + uid] = btb; } }
        lds_barrier();
        if (uid + F.G < NUID) { const int tid_i = tid; M1_HALO_ISSUE(uid + F.G); }
        REP(18)
#pragma unroll 2
        for (int n = 0; n < 8; ++n) {
            bf16x8 cvf[4], xmf[4];
#pragma unroll
            for (int ks = 0; ks < 4; ++ks) { cvf[ks] = lds_frag(CV + (16 * n + li) * RS + (32 * ks + 8 * g) * 2); xmf[ks] = lds_frag(XM + (16 * n + li) * RS + (32 * ks + 8 * g) * 2); }
            f32x4 aq = {0.f, 0.f, 0.f, 0.f}, ak = aq, akt = aq, avt = aq;
#pragma unroll
            for (int ks = 0; ks < 4; ++ks) { aq = mfma16(wq[ks], cvf[ks], aq); ak = mfma16(wk[ks], cvf[ks], ak); akt = mfma16(cvf[ks], wk[ks], akt); avt = mfma16(xmf[ks], wvv[ks], avt); }
            DBG_CHK(aq[0] + aq[1] + aq[2] + aq[3] + ak[0] + ak[1] + ak[2] + ak[3] + akt[0] + akt[1] + akt[2] + akt[3] + avt[0] + avt[1] + avt[2] + avt[3], 2);
            st4bf(Qg + (size_t)(r0 + 16 * n + li) * 512 + h * 128 + 16 * wv + 4 * g, aq);
            st4bf(Kg + (size_t)(r0 + 16 * n + li) * 512 + h * 128 + 16 * wv + 4 * g, ak);
            st4bf_lds(KT_ROW(16 * wv + li) + (16 * n + 4 * g) * 2, akt);
            st4bf_lds(VT + (16 * wv + li) * RS + (16 * n + 4 * g) * 2, avt);
            st4bf(VTg + (size_t)uid * 16384 + (16 * wv + li) * 128 + 16 * n + 4 * g, avt);
        }
        lds_barrier();
        REP(19) {
            bf16x8 vf[4], vb[4];
#pragma unroll
            for (int ks = 0; ks < 4; ++ks) { const bf16x8 v = lds_frag(VT + (16 * wv + li) * RS + (32 * ks + 8 * g) * 2);
                float x[8];
#pragma unroll
                for (int e = 0; e < 8; ++e) x[e] = bf2f((unsigned short)v[e]);
                v4u a, b; const LAS float* wf = FL + 32 * ks + 8 * g; const LAS float* wb = FL + 128 + 32 * ks + 8 * g;
                a.x = pk2(x[0] * wf[0], x[1] * wf[1]); a.y = pk2(x[2] * wf[2], x[3] * wf[3]); a.z = pk2(x[4] * wf[4], x[5] * wf[5]); a.w = pk2(x[6] * wf[6], x[7] * wf[7]);
                b.x = pk2(x[0] * wb[0], x[1] * wb[1]); b.y = pk2(x[2] * wb[2], x[3] * wb[3]); b.z = pk2(x[4] * wb[4], x[5] * wb[5]); b.w = pk2(x[6] * wb[6], x[7] * wb[7]);
                vf[ks] = __builtin_bit_cast(bf16x8, a); vb[ks] = __builtin_bit_cast(bf16x8, b); }
#pragma unroll 2
            for (int n = 0; n < 8; ++n) {
                f32x4 af = {0.f, 0.f, 0.f, 0.f}, ab = af;
#pragma unroll
                for (int ks = 0; ks < 4; ++ks) { const bf16x8 kt = lds_frag(KT_ROW(16 * n + li) + (32 * ks + 8 * g) * 2); af = mfma16(kt, vf[ks], af); ab = mfma16(kt, vb[ks], ab); }
                DBG_CHK(af[0] + af[1] + af[2] + af[3] + ab[0] + ab[1] + ab[2] + ab[3], 3);
                st4bf(CLg + ((size_t)0 * NUID + uid) * 16384 + (16 * wv + li) * 128 + 16 * n + 4 * g, af);
                st4bf(CLg + ((size_t)1 * NUID + uid) * 16384 + (16 * wv + li) * 128 + 16 * n + 4 * g, ab);
            }
            if (tid < 256) { const int dir = tid >> 7, dk = tid & 127; float sacc = 0.f; const LAS float* w = FL + 128 * dir;
#pragma unroll 4
                for (int t8 = 0; t8 < 16; ++t8) { const bf16x8 kk = lds_frag(KT_ROW(dk) + 16 * t8);
#pragma unroll
                    for (int e = 0; e < 8; ++e) sacc += w[8 * t8 + e] * bf2f((unsigned short)kk[e]); }
                NL[((size_t)dir * NUID + uid) * 128 + dk] = sacc; }
        }
        lds_barrier();
    }
}

#undef KT_ROW
#undef M1_HALO_ISSUE
__device__ __forceinline__ int m2_cg(int step, int b, int dir) { return (step < 2) ? (256 + 2 * b + (dir ? 1 - step : step)) : (64 * b + (dir ? 63 - (step - 2) : (step - 2))); }
__device__ __forceinline__ void m2_phase(Frame& F, bool dry = false) {
    bf16* CLg = WSP(bf16, WS_CL); float* NL = WSP(float, WS_NL); float* SC = WSP(float, WS_SC);
    const int gid = F.vcu * NTHR + F.tid;
    const int nthreads = F.G * NTHR;
    constexpr int PF = 11, NSTEP = 66;
    for (int item = gid; item < 32 * 4096; item += nthreads) {
        const int chain = item >> 12, e4 = item & 4095;
        const int dir = chain & 1, h = (chain >> 1) & 3, b = chain >> 3;
        float zero_ = 0.f; asm volatile("" : "+v"(zero_));
        float C0 = zero_, C1 = zero_, C2 = zero_, C3 = zero_, m = zero_;
        f32x4 nvec = {zero_, zero_, zero_, zero_};
        const bool do_n = e4 < 32; const int en = do_n ? e4 : 0;
        v2u w[PF]; float ml[PF], bt[PF]; f32x4 nl[PF];
#pragma unroll
        for (int p = 0; p < PF; ++p) { const int uid = m2_cg(p, b, dir) * 4 + h;
            w[p] = *(const v2u*)(CLg + ((size_t)dir * NUID + uid) * 16384 + 4 * e4); ml[p] = SC[(0 * 2 + dir) * NUID + uid]; bt[p] = SC[(1 * 2 + dir) * NUID + uid];
            nl[p] = *(const f32x4*)(NL + ((size_t)dir * NUID + uid) * 128 + 4 * en); }
#pragma unroll
        for (int s0 = 0; s0 < NSTEP; s0 += PF) {
#pragma unroll
            for (int p = 0; p < PF; ++p) { const int step = s0 + p; const int uid = m2_cg(step, b, dir) * 4 + h;
                bf16* cp = CLg + ((size_t)dir * NUID + uid) * 16384 + 4 * e4;
                const v2u wc = w[p]; const float mlc = ml[p], btc = bt[p]; const f32x4 nlc = nl[p];
                if (!dry) { v2u o; o.x = pk2(C0, C1); o.y = pk2(C2, C3); *(v2u*)cp = o; } else asm volatile("" :: "v"(C0), "v"(C1), "v"(C2), "v"(C3), "v"(m), "v"(nvec[0]));
                if (do_n && !dry) *(f32x4*)(NL + ((size_t)dir * NUID + uid) * 128 + 4 * e4) = nvec;
                if (e4 == 0 && !dry) SC[(2 * 2 + dir) * NUID + uid] = m;
                { const int uid2 = m2_cg((step + PF < NSTEP) ? step + PF : NSTEP - 1, b, dir) * 4 + h;
                    w[p] = *(const v2u*)(CLg + ((size_t)dir * NUID + uid2) * 16384 + 4 * e4); ml[p] = SC[(0 * 2 + dir) * NUID + uid2]; bt[p] = SC[(1 * 2 + dir) * NUID + uid2];
                    nl[p] = *(const f32x4*)(NL + ((size_t)dir * NUID + uid2) * 128 + 4 * en); }
                const float mn = fmaxf(btc + m, mlc), dec = __expf(btc + m - mn), inj = __expf(mlc - mn);
                C0 = dec * C0 + inj * bf2f(wc.x & 0xffffu); C1 = dec * C1 + inj * bf2f(wc.x >> 16); C2 = dec * C2 + inj * bf2f(wc.y & 0xffffu); C3 = dec * C3 + inj * bf2f(wc.y >> 16);
                nvec = nvec * dec + nlc * inj; m = mn; DBG_CHK(C0 + C1 + C2 + C3 + m + nvec[0] + nvec[1] + nvec[2] + nvec[3], 5);
            }
        }
    }
}

__device__ __forceinline__ void m3_phase(Frame& F, int l, int ncg, bool dry = false) {
    LAS unsigned char* KS = F.lds;
    LAS unsigned char* VT = F.lds + TILE_B;
    LAS unsigned char* CF = F.lds + 2 * TILE_B;
    LAS unsigned char* CB = F.lds + 3 * TILE_B;
    LAS float* FL = (LAS float*)(F.lds + 4 * TILE_B);
    const bf16* Qg = WSP(bf16, WS_Q); const bf16* Kg = WSP(bf16, WS_K); const bf16* VTg = WSP(bf16, WS_VT); const bf16* CLg = WSP(bf16, WS_CL);
    const float* GA = WSP(float, WS_GA); const float* NL = WSP(float, WS_NL); const float* SC = WSP(float, WS_SC);
    bf16* A4 = WSP(bf16, WS_A4);
    const int wv = F.wave;
    v4u pk_[4], pv_[4], pf_[4], pb_[4];
#define M3_LOAD(uid_) do { const int u_ = (uid_), cg_ = u_ >> 2, h_ = u_ & 3, rr_ = cg_ * 128; _Pragma("unroll") for (int it = 0; it < 4; ++it) { const int ch = tid0 + NTHR * it, row = ch >> 4, c16 = ch & 15; \
        pk_[it] = *(const v4u*)(Kg + (size_t)(rr_ + row) * 512 + h_ * 128 + 8 * c16); \
        pf_[it] = *(const v4u*)(CLg + ((size_t)0 * NUID + u_) * 16384 + row * 128 + 8 * c16); } } while (0)
#define M3_STORE() do { _Pragma("unroll") for (int it = 0; it < 4; ++it) { const int ch = tid0 + NTHR * it, row = ch >> 4, c16 = ch & 15; \
        *(LAS v4u*)(KS + row * RS + 16 * c16) = pk_[it]; *(LAS v4u*)(CF + row * RS + 16 * c16) = pf_[it]; } } while (0)
    { const int tid0 = F.tid; if (F.vcu < ncg * 4) { M3_LOAD(F.vcu); M3_STORE(); } }
    for (int uid = F.vcu; uid < ncg * 4; uid += F.G) {
        int tid = F.tid; asm volatile("" : "+v"(tid));
        const int lane = tid & 63, li = lane & 15, g = lane >> 4; const int tid0 = tid;
        const int cg = uid >> 2, h = uid & 3, r0 = cg * 128;
        const bool more = uid + F.G < ncg * 4;
        const int t = 16 * wv + li;
        f32x4 sm4; float sm1;
        { const float* p4 = (tid < 128) ? GA + ((size_t)(r0 + tid) * 4 + h) * 4 : FIN(I_HNW) + l * 512 + h * 128 + 4 * ((tid - 128) & 31);
          const int e1 = tid - 160; const float* p1 = ((unsigned)e1 < 256u) ? NL + ((size_t)(e1 >> 7) * NUID + uid) * 128 + (e1 & 127) : SC + (2 * 2 + (tid & 1)) * NUID + uid;
          sm4 = *(const f32x4*)p4; sm1 = *p1; }
        bf16x8 qf[4];
#pragma unroll
        for (int ks = 0; ks < 4; ++ks) qf[ks] = glb_frag(Qg + (size_t)(r0 + t) * 512 + h * 128 + 32 * ks + 8 * g);
#pragma unroll
        for (int it = 0; it < 4; ++it) { const int ch = tid + NTHR * it; pv_[it] = *(const v4u*)(VTg + (size_t)uid * 16384 + (ch >> 4) * 128 + 8 * (ch & 15)); pb_[it] = *(const v4u*)(CLg + ((size_t)1 * NUID + uid) * 16384 + (ch >> 4) * 128 + 8 * (ch & 15)); }
        if (tid < 128) *(LAS f32x4*)(FL + 4 * tid) = sm4; else if (tid < 160) *(LAS f32x4*)(FL + 1040 + 4 * (tid - 128)) = sm4;
        if ((unsigned)(tid - 160) < 256u) FL[512 + (tid - 160)] = sm1; else if ((unsigned)(tid - 416) < 2u) FL[1024 + (tid - 416)] = sm1;
        lds_barrier();
        if (wv == 0) { const float u0 = FL[4 * (2 * lane) + 1], u1 = FL[4 * (2 * lane + 1) + 1];
            const float pm = dscan_max(fmaxf(u0, u1)), excl = dpp_f<0x138, 0xf>(-3.0e38f, pm), mp = FL[1024];
            FL[768 + 2 * lane] = fmaxf(mp, fmaxf(excl, u0)); FL[768 + 2 * lane + 1] = fmaxf(mp, pm); }
        else if (wv == 1) { const float u0 = FL[4 * (2 * lane) + 3], u1 = FL[4 * (2 * lane + 1) + 3];
            const float rv = __shfl(fmaxf(u0, u1), 63 - lane), rs = dscan_max(rv), rx = dpp_f<0x138, 0xf>(-3.0e38f, rs);
            const float sm = __shfl(rs, 63 - lane), excl = __shfl(rx, 63 - lane), mp = FL[1025];
            FL[896 + 2 * lane + 1] = fmaxf(mp, fmaxf(excl, u1)); FL[896 + 2 * lane] = fmaxf(mp, sm); }
        lds_barrier();
        M3_LOAD(more ? uid + F.G : uid);
        REP(21) {
            const bool dry_ = dry || (rep_ == 0 && ((DUPMASK >> 21) & 1));
            bf16x8 sfr[4], sbr[4];
            const float Mf = FL[768 + t], Mb = FL[896 + t], mpf = FL[1024], mpb = FL[1025];
            float rsf = 0.f, rsb = 0.f; const int d = wv >> 1;
#pragma unroll
            for (int kp = 0; kp < 4; ++kp) { f32x4 a0 = {0.f, 0.f, 0.f, 0.f}, a1 = a0;
#pragma unroll
                for (int ks = 0; ks < 4; ++ks) { a0 = mfma16(lds_frag(KS + (32 * kp + li) * RS + (32 * ks + 8 * g) * 2), qf[ks], a0); a1 = mfma16(lds_frag(KS + (32 * kp + 16 + li) * RS + (32 * ks + 8 * g) * 2), qf[ks], a1); }
                DBG_CHK(a0[0] + a0[1] + a0[2] + a0[3] + a1[0] + a1[1] + a1[2] + a1[3], 7);
                __builtin_amdgcn_sched_barrier(0);
                float pf_[8], pb_[8];
                if (kp < d) {
#pragma unroll
                    for (int e = 0; e < 8; ++e) { const int s = 32 * kp + 16 * (e >> 2) + 4 * g + (e & 3); const float a = (e < 4) ? a0[e & 3] : a1[e & 3];
                        pf_[e] = a * __expf(FL[4 * s + 1] - Mf); pb_[e] = 0.f; rsf += pf_[e]; }
                } else if (kp > d) {
#pragma unroll
                    for (int e = 0; e < 8; ++e) { const int s = 32 * kp + 16 * (e >> 2) + 4 * g + (e & 3); const float a = (e < 4) ? a0[e & 3] : a1[e & 3];
                        pb_[e] = a * __expf(FL[4 * s + 3] - Mb); pf_[e] = 0.f; rsb += pb_[e]; }
                } else {
#pragma unroll
                    for (int e = 0; e < 8; ++e) { const int s = 32 * kp + 16 * (e >> 2) + 4 * g + (e & 3); const float a = (e < 4) ? a0[e & 3] : a1[e & 3]; const float uf = FL[4 * s + 1], ub = FL[4 * s + 3];
                        const int dts = t - s; const float pen_f = (float)min(dts, 0) * 1.0e30f, pen_b = (float)min(-dts, 0) * 1.0e30f;
                        const float wf = __expf(uf - Mf + pen_f), wb = __expf(ub - Mb + pen_b);
                        pf_[e] = a * wf; pb_[e] = a * wb; rsf += pf_[e]; rsb += pb_[e]; }
                }
                v4u wa, wb4; wa.x = pk2(pf_[0], pf_[1]); wa.y = pk2(pf_[2], pf_[3]); wa.z = pk2(pf_[4], pf_[5]); wa.w = pk2(pf_[6], pf_[7]);
                wb4.x = pk2(pb_[0], pb_[1]); wb4.y = pk2(pb_[2], pb_[3]); wb4.z = pk2(pb_[4], pb_[5]); wb4.w = pk2(pb_[6], pb_[7]);
                sfr[kp] = __builtin_bit_cast(bf16x8, wa); sbr[kp] = __builtin_bit_cast(bf16x8, wb4);
                __builtin_amdgcn_sched_barrier(0); }
            rsf += __shfl_xor(rsf, 16); rsf += __shfl_xor(rsf, 32); rsb += __shfl_xor(rsb, 16); rsb += __shfl_xor(rsb, 32);
            float qnf = 0.f, qnb = 0.f;
#pragma unroll
            for (int ks = 0; ks < 4; ++ks)
#pragma unroll
                for (int e = 0; e < 8; ++e) { const float qv = bf2f((unsigned short)qf[ks][e]); const int d = 32 * ks + 8 * g + e; qnf += qv * FL[512 + d]; qnb += qv * FL[640 + d]; }
            qnf += __shfl_xor(qnf, 16); qnf += __shfl_xor(qnf, 32); qnb += __shfl_xor(qnb, 16); qnb += __shfl_xor(qnb, 32);
            const f32x4 gat = *(const LAS f32x4*)(FL + 4 * t);
            const float wif = __expf(mpf - Mf), wib = __expf(mpb - Mb);
            const float denf = rsf + wif * qnf, denb = rsb + wib * qnb;
            const float rf = 1.0f / fmaxf(fabsf(denf), __expf(-(gat[0] + Mf))), rb = 1.0f / fmaxf(fabsf(denb), __expf(-(gat[2] + Mb)));
            const float alf = rf * wif, alb = rb * wib; DBG_CHK(rf + rb + alf + alb, 8);
            if (rep_ == 0) {
#pragma unroll
                for (int it = 0; it < 4; ++it) { const int ch = tid + NTHR * it; *(LAS v4u*)(VT + (ch >> 4) * RS + 16 * (ch & 15)) = pv_[it]; *(LAS v4u*)(CB + (ch >> 4) * RS + 16 * (ch & 15)) = pb_[it]; } }
            lds_barrier();
            f32x4 o[8]; float sum = 0.f;
#pragma unroll
            for (int n = 0; n < 8; ++n) { f32x4 apf = {0.f, 0.f, 0.f, 0.f}, apb = apf, acf = apf, acb = apf;
#pragma unroll
                for (int kp = 0; kp < 4; ++kp) { const v2u lo = *(const LAS v2u*)(VT + (16 * n + li) * RS + (32 * kp + 4 * g) * 2), hi = *(const LAS v2u*)(VT + (16 * n + li) * RS + (32 * kp + 16 + 4 * g) * 2);
                    const v4u vv = {lo.x, lo.y, hi.x, hi.y}; const bf16x8 vfr = __builtin_bit_cast(bf16x8, vv); if (kp <= d) apf = mfma16(vfr, sfr[kp], apf); if (kp >= d) apb = mfma16(vfr, sbr[kp], apb); }
#pragma unroll
                for (int ks = 0; ks < 4; ++ks) { acf = mfma16(lds_frag(CF + (16 * n + li) * RS + (32 * ks + 8 * g) * 2), qf[ks], acf); acb = mfma16(lds_frag(CB + (16 * n + li) * RS + (32 * ks + 8 * g) * 2), qf[ks], acb); }
                const f32x4 a = apf * rf + apb * rb + acf * alf + acb * alb;
                o[n] = a; sum += (a[0] + a[1]) + (a[2] + a[3]);
                __builtin_amdgcn_sched_barrier(0); }
            DBG_CHK(sum, 9);
            bf16* zrow = A4 + (size_t)(r0 + t) * 1024 + 512 + h * 128;
            v2u zz[8];
#pragma unroll
            for (int n = 0; n < 8; ++n) zz[n] = *(const v2u*)(zrow + 16 * n + 4 * g);
            sum += __shfl_xor(sum, 16); sum += __shfl_xor(sum, 32);
            const float mu = sum * (1.f / 128.f); float var = 0.f;
#pragma unroll
            for (int n = 0; n < 8; ++n) { o[n] = o[n] - mu; var += (o[n][0] * o[n][0] + o[n][1] * o[n][1]) + (o[n][2] * o[n][2] + o[n][3] * o[n][3]); }
            var += __shfl_xor(var, 16); var += __shfl_xor(var, 32);
            const float rstd = 1.0f / sqrtf(var * (1.f / 128.f) + EPSN);
#pragma unroll
            for (int n = 0; n < 8; ++n) { const int dv = 16 * n + 4 * g; const f32x4 w4 = *(const LAS f32x4*)(FL + 1040 + dv);
                f32x4 y; y[0] = o[n][0] * rstd * w4[0] * pg8::fast_sigmoid(bf2f(zz[n].x & 0xffffu)); y[1] = o[n][1] * rstd * w4[1] * pg8::fast_sigmoid(bf2f(zz[n].x >> 16));
                y[2] = o[n][2] * rstd * w4[2] * pg8::fast_sigmoid(bf2f(zz[n].y & 0xffffu)); y[3] = o[n][3] * rstd * w4[3] * pg8::fast_sigmoid(bf2f(zz[n].y >> 16));
                DBG_CHK(y[0] + y[1] + y[2] + y[3], 10); if (!dry_) st4bf(zrow + dv, y); else asm volatile("" :: "v"(y[0]), "v"(y[1]), "v"(y[2]), "v"(y[3])); }
        }
        lds_barrier();
        M3_STORE();
        lds_barrier();
    }
#undef M3_LOAD
#undef M3_STORE
}
constexpr int FRS = 288;
__device__ __forceinline__ s16x4 tr_read(const LAS unsigned char* p) { typedef short v4i16_t __attribute__((ext_vector_type(4))); return __builtin_bit_cast(s16x4, __builtin_amdgcn_ds_read_tr16_b64_v4i16((LAS v4i16_t*)p)); }
__device__ __forceinline__ bf16x8 dft_frag(const LAS unsigned char* tile, int t, int nt, int lane) {
    const int g = lane >> 4, q = (lane & 15) >> 2, p = lane & 3;
    const LAS unsigned char* a = tile + (32 * t + 16 * (g >> 1) + 4 * (g & 1) + q) * FRS + (16 * nt + 4 * p) * 2;
    const s16x4 lo = tr_read(a), hi = tr_read(a + 8 * FRS);
    bf16x8 r; r[0] = lo[0]; r[1] = lo[1]; r[2] = lo[2]; r[3] = lo[3]; r[4] = hi[0]; r[5] = hi[1]; r[6] = hi[2]; r[7] = hi[3]; return r;
}
__device__ __forceinline__ const bf16* f1_src(const bf16* UXF, int u, int ch) { const int cb = u & 3, s2 = (u >> 2) & 63, b = u >> 8, row = ch >> 4, c16 = ch & 15; return UXF + (size_t)(b * SEQ + 64 * row + s2) * 512 + 128 * cb + 8 * c16; }
__device__ __forceinline__ void f1_phase(Frame& F) {
    const bf16* UXF = WSP(bf16, WS_Y); bf16* HS1 = (bf16*)FOUT;
    const bf16* W1 = (const bf16*)(F.ws + WS_TAB + TAB_W1); const f32x2* TW = (const f32x2*)(F.ws + WS_TAB + TAB_TW);
    const int lane0 = F.lane, wv = F.wave;
    bf16x8 wre[4], wim[4];
#pragma unroll
    for (int t = 0; t < 4; ++t) { wre[t] = glb_frag(W1 + ((((size_t)wv * 2 + 0) * 4 + t) * 64 + lane0) * 8); wim[t] = glb_frag(W1 + ((((size_t)wv * 2 + 1) * 4 + t) * 64 + lane0) * 8); }
    int ub, un, us;
    if (F.G == 256) { us = 1; const int v = F.vcu; if (v < 32) { ub = v; un = 1; } else { const int w = v - 32; if (w < 96) { ub = 32 + 5 * w; un = 5; } else { ub = 32 + 480 + 4 * (w - 96); un = 4; } } }
    else { ub = F.vcu; us = F.G; un = (NB * 64 * 4 - F.vcu + F.G - 1) / F.G; }
    constexpr int TB = 128 * FRS;
    f32x2 twn = {0.f, 0.f};
    if (un > 0) { const int tid = F.tid;
#pragma unroll
        for (int it = 0; it < 4; ++it) { const int ch = tid + NTHR * it; *(LAS v4u*)(F.lds + (ch >> 4) * FRS + 16 * (ch & 15)) = *(const v4u*)f1_src(UXF, ub, ch); }
        twn = TW[(16 * wv + (lane0 & 15)) * 64 + ((ub >> 2) & 63)]; }
    VM_DONE();
    lds_barrier();
    for (int ui = 0; ui < un; ++ui) {
        const int u = ub + ui * us;
        int tid = F.tid; asm volatile("" : "+v"(tid)); const int lane = tid & 63, li = lane & 15, g = lane >> 4;
        const int cb = u & 3, s2 = (u >> 2) & 63, b = u >> 8;
        LAS unsigned char* tile = F.lds + (ui & 1) * TB; LAS unsigned char* ntile = F.lds + ((ui + 1) & 1) * TB;
        v4u pre[4]; const bool more = ui + 1 < un;
        const int k1 = 16 * wv + li; const f32x2 tw = twn;
        if (more) {
#pragma unroll
            for (int it = 0; it < 4; ++it) pre[it] = *(const v4u*)f1_src(UXF, u + us, tid + NTHR * it);
            twn = TW[k1 * 64 + (((u + us) >> 2) & 63)]; }
        bf16* ore = HS1 + (size_t)(b * SEQ + 64 * k1 + s2) * 1024 + 128 * cb;
#pragma unroll
        for (int nt = 0; nt < 8; ++nt) { f32x4 are = {0.f, 0.f, 0.f, 0.f}, aim = are;
#pragma unroll
            for (int t = 0; t < 4; ++t) { const bf16x8 d = dft_frag(tile, t, nt, lane); are = mfma16(d, wre[t], are); aim = mfma16(d, wim[t], aim); }
            DBG_CHK(are[0] + are[1] + are[2] + are[3] + aim[0] + aim[1] + aim[2] + aim[3], 4);
            st4bf(ore + 16 * nt + 4 * g, are * tw.x - aim * tw.y);
            st4bf(ore + 512 + 16 * nt + 4 * g, are * tw.y + aim * tw.x); }
        if (more) {
#pragma unroll
            for (int it = 0; it < 4; ++it) { const int ch = tid + NTHR * it; *(LAS v4u*)(ntile + (ch >> 4) * FRS + 16 * (ch & 15)) = pre[it]; } }
        lds_barrier();
    }
}
__device__ __forceinline__ const bf16* f2_src(const bf16* HS1, int u, int ch) { const int cb = u & 3, k1 = (u >> 2) & 127, b = u >> 9, row = ch >> 4, c16 = ch & 15;
    return HS1 + (size_t)(b * SEQ + 64 * k1 + (row & 63)) * 1024 + (row >> 6) * 512 + 128 * cb + 8 * c16; }
__device__ __forceinline__ void f2_phase(Frame& F, int l) {
    const bf16* HS1 = (const bf16*)FOUT; bf16* A4 = WSP(bf16, WS_A4);
    const bf16* W2 = (const bf16*)(F.ws + WS_TAB + TAB_W2); const bf16* PQF = (const bf16*)(F.ws + WS_TAB + TAB_PQF) + (size_t)l * 8 * 8192;
    const int lane0 = F.lane, wv = F.wave, kq = wv & 3, grp = wv >> 2;
    bf16x8 w2r[4], w2i[4];
#pragma unroll
    for (int t = 0; t < 4; ++t) { w2r[t] = glb_frag(W2 + (((size_t)kq * 4 + t) * 64 + lane0) * 8); w2i[t] = glb_frag(W2 + (((size_t)(kq + 4) * 4 + t) * 64 + lane0) * 8); }
    constexpr int TB = 128 * FRS;
    constexpr int NQP = NB * 63 * 4, NU = NQP + NB * 2 * 4;
#define F2_OLD(q_) (((q_) < NQP) ? ((((q_) >> 2) / 63 * 128 + 1 + ((q_) >> 2) % 63) << 2) | ((q_) & 3) : ((((((q_) - NQP) >> 3) * 128 + ((((q_) - NQP) >> 2) & 1) * 64)) << 2) | ((q_) & 3))
    bf16x8 pqr[16]; int cur_gi = 2 * (F.vcu & 3) + grp;
    { const bf16* pq = PQF + (size_t)cur_gi * 8192 + lane0 * 8;
#pragma unroll
      for (int q = 0; q < 16; ++q) pqr[q] = glb_frag(pq + q * 512); }
    if (F.vcu < NU) { const int tid = F.tid;
#pragma unroll
        for (int it = 0; it < 4; ++it) { const int ch = tid + NTHR * it; *(LAS v4u*)(F.lds + (ch >> 4) * FRS + 16 * (ch & 15)) = *(const v4u*)f2_src(HS1, F2_OLD(F.vcu), ch); } }
    VM_DONE();
    v4u preA[4], preB[4];
#define PF_LOAD(dst_, ptr_) asm volatile("global_load_dwordx4 %0, %1, off" : "=v"(dst_) : "v"(ptr_) : "memory")
#define PF_WAIT(P_, younger4_) do { if (younger4_) asm volatile("s_waitcnt vmcnt(4)" :: "v"(P_[0]), "v"(P_[1]), "v"(P_[2]), "v"(P_[3]) : "memory"); \
        else asm volatile("s_waitcnt vmcnt(0)" :: "v"(P_[0]), "v"(P_[1]), "v"(P_[2]), "v"(P_[3]) : "memory"); } while (0)
    if (F.vcu + F.G < NU) { const int tid = F.tid;
#pragma unroll
        for (int it = 0; it < 4; ++it) PF_LOAD(preA[it], f2_src(HS1, F2_OLD(F.vcu + F.G), tid + NTHR * it)); }
    lds_barrier();
#define F2_BODY(TILE_, NTILE_, PL_, PW_) do { \
        int tid = F.tid; asm volatile("" : "+v"(tid)); const int lane = tid & 63, li = lane & 15, g = lane >> 4; \
        const int u = F2_OLD(q); const bool pair = q < NQP; \
        const int cb = u & 3, k1 = (u >> 2) & 127, b = u >> 9, gi = 2 * cb + grp; \
        LAS unsigned char* tile = (TILE_); LAS unsigned char* ntile = (NTILE_); \
        const bool more1 = q + F.G < NU, more2 = q + 2 * F.G < NU; \
        if (more2) { _Pragma("unroll") for (int it = 0; it < 4; ++it) PF_LOAD(PL_[it], f2_src(HS1, F2_OLD(q + 2 * F.G), tid + NTHR * it)); } \
        bf16x8 uf[4]; \
        _Pragma("unroll") for (int hp = 0; hp < 2; ++hp) { f32x4 r0 = {0.f, 0.f, 0.f, 0.f}, r1 = r0, i0 = r0, i1 = r0; \
            _Pragma("unroll") for (int t = 0; t < 4; ++t) { const bf16x8 d0 = dft_frag(tile, t, 4 * grp + 2 * hp, lane), d1 = dft_frag(tile, t, 4 * grp + 2 * hp + 1, lane); \
                r0 = mfma16(d0, w2r[t], r0); r1 = mfma16(d1, w2r[t], r1); i0 = mfma16(d0, w2i[t], i0); i1 = mfma16(d1, w2i[t], i1); } \
            DBG_CHK(r0[0] + r1[1] + i0[2] + i1[3], 6); \
            v4u wr_, wi_; wr_.x = pk2(r0[0], r0[1]); wr_.y = pk2(r0[2], r0[3]); wr_.z = pk2(r1[0], r1[1]); wr_.w = pk2(r1[2], r1[3]); \
            wi_.x = pk2(i0[0], i0[1]); wi_.y = pk2(i0[2], i0[3]); wi_.z = pk2(i1[0], i1[1]); wi_.w = pk2(i1[2], i1[3]); \
            uf[hp] = __builtin_bit_cast(bf16x8, wr_); uf[2 + hp] = __builtin_bit_cast(bf16x8, wi_); } \
        if (more1) { PF_WAIT(PW_, more2); \
            _Pragma("unroll") for (int it = 0; it < 4; ++it) { const int ch = tid + NTHR * it; *(LAS v4u*)(ntile + (ch >> 4) * FRS + 16 * (ch & 15)) = PW_[it]; } } \
        bf16* orow = A4 + (size_t)(b * SEQ + k1 + 128 * (16 * kq + li)) * 1024 + 64 * gi; \
        bf16* orow2 = A4 + (size_t)(b * SEQ + (128 - k1) + 128 * (63 - (16 * kq + li))) * 1024 + 64 * gi; \
        if (gi != cur_gi) { cur_gi = gi; const bf16* pq = PQF + (size_t)gi * 8192 + lane * 8; \
            _Pragma("unroll") for (int q = 0; q < 16; ++q) pqr[q] = glb_frag(pq + q * 512); \
            VM_DONE(); } \
        _Pragma("unroll") for (int nd = 0; nd < 4; ++nd) { f32x4 pa = {0.f, 0.f, 0.f, 0.f}, pb = pa;        \
            pa = mfma16(pqr[nd * 4 + 0], uf[0], pa); pb = mfma16(pqr[nd * 4 + 2], uf[2], pb); pa = mfma16(pqr[nd * 4 + 1], uf[1], pa); pb = mfma16(pqr[nd * 4 + 3], uf[3], pb); \
            st4bf(orow + 16 * nd + 4 * g, pa + pb); if (pair) st4bf(orow2 + 16 * nd + 4 * g, pa - pb); } \
        lds_barrier(); } while (0)
    for (int q = F.vcu; q < NU; q += F.G) {
        F2_BODY(F.lds, F.lds + TB, preB, preA);
        q += F.G; if (q >= NU) break;
        F2_BODY(F.lds + TB, F.lds, preA, preB);
    }
#undef F2_BODY
#undef F2_OLD
#undef PF_LOAD
#undef PF_WAIT
}
__device__ __forceinline__ void ctx_fourier(Frame& F, int l) {
    const bf16* UXF = WSP(bf16, WS_Y); bf16* A4 = WSP(bf16, WS_A4);
    const bf16* WC = (const bf16*)(F.ws + WS_WC); const bf16* PQF = (const bf16*)(F.ws + WS_TAB + TAB_PQF) + (size_t)l * 8 * 8192;
    const int wv = F.wave, kq = wv & 3, grp = wv >> 2;
    for (int it = (F.G == 256) ? F.vcu - 128 : F.vcu; it < NB * 4 * 4; it += F.G) {
        if (it < 0) continue;
        int tid = F.tid; asm volatile("" : "+v"(tid)); const int lane = tid & 63, li = lane & 15, g = lane >> 4;
        const int kt = it & 3, cb = (it >> 2) & 3, b = it >> 4, gi = 2 * cb + grp;
#pragma unroll
        for (int i8 = 0; i8 < 8; ++i8) { const int ch = tid + NTHR * i8, row = ch >> 4, c16 = ch & 15;
            *(LAS v4u*)(F.lds + row * FRS + 16 * c16) = *(const v4u*)(UXF + (size_t)(TL + b * CTXL + row) * 512 + 128 * cb + 8 * c16); }
        bf16x8 wr[8], wi[8], pqr[16];
#pragma unroll
        for (int t = 0; t < 8; ++t) { wr[t] = glb_frag(WC + ((((size_t)(kt * 4 + kq) * 2 + 0) * 8 + t) * 64 + lane) * 8); wi[t] = glb_frag(WC + ((((size_t)(kt * 4 + kq) * 2 + 1) * 8 + t) * 64 + lane) * 8); }
#pragma unroll
        for (int q = 0; q < 16; ++q) pqr[q] = glb_frag(PQF + (size_t)gi * 8192 + lane * 8 + q * 512);
        lds_barrier();
        bf16x8 uf[4];
#pragma unroll
        for (int hp = 0; hp < 2; ++hp) { f32x4 r0 = {0.f, 0.f, 0.f, 0.f}, r1 = r0, i0 = r0, i1 = r0;
#pragma unroll
            for (int t = 0; t < 8; ++t) { const bf16x8 d0 = dft_frag(F.lds, t, 4 * grp + 2 * hp, lane), d1 = dft_frag(F.lds, t, 4 * grp + 2 * hp + 1, lane);
                r0 = mfma16(d0, wr[t], r0); r1 = mfma16(d1, wr[t], r1); i0 = mfma16(d0, wi[t], i0); i1 = mfma16(d1, wi[t], i1); }
            v4u wr_, wi_; wr_.x = pk2(r0[0], r0[1]); wr_.y = pk2(r0[2], r0[3]); wr_.z = pk2(r1[0], r1[1]); wr_.w = pk2(r1[2], r1[3]);
            wi_.x = pk2(i0[0], i0[1]); wi_.y = pk2(i0[2], i0[3]); wi_.z = pk2(i1[0], i1[1]); wi_.w = pk2(i1[2], i1[3]);
            uf[hp] = __builtin_bit_cast(bf16x8, wr_); uf[2 + hp] = __builtin_bit_cast(bf16x8, wi_); }
        bf16* orow = A4 + (size_t)(TL + b * CTXL + 64 * kt + 16 * kq + li) * 1024 + 64 * gi;
#pragma unroll
        for (int nd = 0; nd < 4; ++nd) { f32x4 a = {0.f, 0.f, 0.f, 0.f};
#pragma unroll
            for (int ks = 0; ks < 4; ++ks) a = mfma16(pqr[nd * 4 + ks], uf[ks], a);
            DBG_CHK(a[0] + a[1] + a[2] + a[3], 11); st4bf(orow + 16 * nd + 4 * g, a); }
        lds_barrier();
    }
    lds_barrier();
}

struct Args { const float* in[17]; float* out; unsigned char* ws; int ph_lo, ph_hi; };
constexpr int NPHASES = 2 + DEPTH * 12;
__global__ void __launch_bounds__(NTHR, 2) mega_fwd(Args args) {
    extern __shared__ __attribute__((aligned(16))) unsigned char lds[];
    Frame F;
    F.lds = (LAS unsigned char*)lds;
    F.MISC = (volatile LAS unsigned*)(F.lds + MISC_OFF);
    F.tid = threadIdx.x; F.lane = F.tid & 63; F.wave = __builtin_amdgcn_readfirstlane(F.tid >> 6);
    F.G = gridDim.x; { const int bx = blockIdx.x; F.vcu = (F.G % 8 == 0) ? (bx % 8) * (F.G / 8) + bx / 8 : bx; }
    F.ws = args.ws; F.ctl = (gu32*)(args.ws + WS_CTL);
    if (F.tid < 16) ((LAS unsigned*)(F.lds + MISC_OFF))[F.tid] = 0u;
    if (F.tid == 64) { LAS unsigned long long* pt = (LAS unsigned long long*)(F.lds + PTAB_OFF);
#pragma unroll
        for (int i = 0; i < 17; ++i) pt[i] = (unsigned long long)args.in[i];
        pt[17] = (unsigned long long)args.out; pt[18] = (unsigned long long)args.ws; }
    __syncthreads();
    XcdBarrier bar = xcd_barrier_post((unsigned*)(F.ctl + CW_BAR), F.MISC + 8);
    const int lo = args.ph_lo, hi = args.ph_hi;
    const int vcu_s = F.vcu; const int wave_s = F.wave;
    int pid = 0;
#ifdef SEC_PROBE
#define SEC_T(v_) const unsigned long long v_ = __builtin_amdgcn_s_memrealtime();
#define SEC_SLEEP(a_, b_) { const unsigned long long t_ = __builtin_amdgcn_s_memrealtime(), d_ = ((b_) - (a_)) * SEC_K; while (__builtin_amdgcn_s_memrealtime() - t_ < d_) __builtin_amdgcn_s_sleep(32); }
#else
#define SEC_T(v_)
#define SEC_SLEEP(a_, b_)
#endif
#define PH_BEGIN if (lo <= pid && pid < hi) { { int t_; asm volatile("v_mbcnt_lo_u32_b32 %0, -1, 0\n\tv_mbcnt_hi_u32_b32 %0, -1, %0" : "=v"(t_)); t_ += wave_s * 64; { int g_ = (int)gridDim.x, v_ = vcu_s, b_ = (int)blockIdx.x; asm volatile("" : "+s"(g_), "+s"(v_), "+s"(b_)); F.G = g_; F.vcu = v_; F.bid = b_; } F.tid = t_; F.lane = t_ & 63; F.wave = __builtin_amdgcn_readfirstlane(t_ >> 6); { LAS unsigned char* lp_ = (LAS unsigned char*)lds; asm volatile("" : "+s"(lp_)); F.lds = lp_; } F.ws = (unsigned char*)(GAS unsigned char*)ptab(F, 18); F.ctl = (gu32*)(F.ws + WS_CTL); }
#define PH_END   if (pid + 1 < hi) { int tb_; asm volatile("v_mbcnt_lo_u32_b32 %0, -1, 0\n\tv_mbcnt_hi_u32_b32 %0, -1, %0" : "=v"(tb_)); xcd_barrier(bar.bar, bar.x, bar.st, tb_ + wave_s * 64, gridDim.x); } } ++pid;
#define XC WSP(float, WS_XC)
#define Hb ((bf16*)FOUT)
#define XB WSP(bf16, WS_XB)
#define Yb WSP(bf16, WS_Y)
#define ACT WSP(bf16, WS_ACT)
#define A4 WSP(bf16, WS_A4)
#define MOD WSP(float, WS_MOD)

    PH_BEGIN mod_first(F); PH_END
    PH_BEGIN { SEC_T(ta_) REP(0) p0_prologue(F, 3, F.vcu, F.G); SEC_T(tb_s)
#if defined(SEC_PROBE) && SEC_PROBE == 5
      SEC_SLEEP(ta_, tb_s)
#endif

      if (F.G != 256) { int tb_; asm volatile("v_mbcnt_lo_u32_b32 %0, -1, 0\n\tv_mbcnt_hi_u32_b32 %0, -1, %0" : "=v"(tb_)); xcd_barrier(bar.bar, bar.x, bar.st, tb_ + wave_s * 64, gridDim.x); }
      REP(1) { const Thin P{FIN(I_X), FIN(I_CTX), XB, XC, nullptr, nullptr, nullptr, nullptr, Hb, FIN(I_NORMW) + 0 * DM, MOD + 1 * DM, MOD + 0 * DM, 0.f, 0, TT, 0, 1}; thin_phase(F, P, 0); } } PH_END

#pragma unroll 1
    for (int hl = 0; hl < 2 * DEPTH; ++hl) {
        const int l = hl >> 1, f = hl & 1; const bool last = (l == DEPTH - 1);

        const int Mrows = (last && f == 1) ? TL : TT;
        PH_BEGIN REP(2) { pg8::Gemm gm{Hb, WSP(bf16, WS_WFFIN) + (size_t)(l * 2 + f) * 2 * DFF * DM, Mrows, 2 * DFF, DM, DM, 0, 0}; pg8::StaticOrder S; S.init(Mrows, 2 * DFF, F.G, F.bid);
            pg8::EpiSwiGLU E{ACT, DFF}; pg8::gemm_phase<pg8::EpiSwiGLU, pg8::StaticOrder, true, true>(F.lds, gm, S, E, F.tid);
            if (false && l == 0) { const int nfull = (Mrows / 256) * (2 * DFF / 256) % F.G; if (nfull > 0 && F.bid >= nfull) p0_prologue(F, 1 + f, F.bid - nfull, F.G - nfull); } } PH_END
        PH_BEGIN REP(3) { { pg8::Gemm gm{ACT, WSP(bf16, WS_WFFOUT) + (size_t)(l * 2 + f) * DM * DFF, TL, DM, DFF, DFF, 1, 1}; pg8::StaticOrder S; S.init(TL, DM, F.G, F.bid, 1);
            pg8::EpiPlain E{Yb, DM}; pg8::gemm_phase<pg8::EpiPlain, pg8::StaticOrder, false, true>(F.lds, gm, S, E, F.tid); }
            if (Mrows > TL) {
                pg8::Gemm gm{ACT, WSP(bf16, WS_WFFOUT) + (size_t)(l * 2 + f) * DM * DFF, TT, DM, DFF, 256, 1, 1}; pg8::SplitKOrder S; S.init(TL / 256, 4, 4, 11, F.G, F.bid);
                pg8::EpiSlab E{WSP(float, WS_SLAB2), DM, TL / 256, (size_t)TC * DM}; pg8::gemm_phase<pg8::EpiSlab, pg8::SplitKOrder, false, true>(F.lds, gm, S, E, F.tid); } } PH_END
        PH_BEGIN { const int j = f ? 2 : 0;
            const float* nw = FIN(I_NORMW) + (size_t)l * 6 * DM; const float* modl = MOD + (size_t)l * 5 * NMOD * DM; const bool fin = last && f == 1;
            bf16* const Hp = (f == 0 || !last) ? Hb : nullptr;
            const float* const nwp = (f == 0) ? nw + 2 * DM : nw + 6 * DM;
            const float* const scp = (f == 0) ? modl + 4 * DM : modl + (size_t)5 * NMOD * DM + 1 * DM;
            const float* const shp = (f == 0) ? modl + 3 * DM : modl + (size_t)5 * NMOD * DM;
            const Thin P{XB, XC, fin ? (void*)FOUT : (void*)XB, XC, Yb, WSP(float, WS_SLAB2), nw + (f ? 5 : 1) * DM, modl + (3 * j + 2) * DM, Hp, nwp, scp, shp, 0.5f, (Mrows > TL) ? 11 : 0, Mrows, 1, fin ? 0 : 1};
            REP(4) thin_phase(F, P, l == 0 ? (f ? 3 : 1) : (f ? 6 : 4), rep_ == 0 && ((DUPMASK >> 4) & 1));
#ifdef DBG_FLAGS
            if (last && f == 1) { __syncthreads(); if (blockIdx.x == 0 && F.tid == 0) { const unsigned m = __hip_atomic_load((unsigned*)(F.ctl + 64), __ATOMIC_RELAXED, __HIP_MEMORY_SCOPE_AGENT); if (m) FOUT[0] = 1.0e6f * (float)(__builtin_ctz(m) + 1); } }
#endif
            } PH_END
        if (f == 0) {
            PH_BEGIN REP(5) { pg8::Gemm gm{Hb, WSP(bf16, WS_WIN) + (size_t)l * DIN_PAD * DM, TT, DIN_PAD, DM, DM, 0, 0}; pg8::StaticOrder S; S.init(TT, DIN_PAD, F.G, F.bid);
                pg8::EpiInProj E{Yb, Yb + (size_t)TT * 512, A4, WSP(float, WS_GT)}; pg8::gemm_phase<pg8::EpiInProj, pg8::StaticOrder, false, true>(F.lds, gm, S, E, F.tid); } PH_END
            PH_BEGIN { REP(6) m1_phase(F, l); REP(12) f1_phase(F); } PH_END
            PH_BEGIN { REP(7) m2_phase(F, rep_ == 0 && ((DUPMASK >> 7) & 1)); REP(13) f2_phase(F, l); } PH_END
            PH_BEGIN { REP(8) m3_phase(F, l, last ? 256 : NCG, rep_ == 0 && ((DUPMASK >> 8) & 1)); if (!last) ctx_fourier(F, l); } PH_END
            { const int M4 = last ? TL : TT;
            PH_BEGIN REP(9) { { pg8::Gemm gm{A4, WSP(bf16, WS_WOUT) + (size_t)l * DM * DM, TL, DM, DM, DM, 0, 0}; pg8::StaticOrder S; S.init(TL, DM, F.G, F.bid);
                pg8::EpiPlain E{Yb, DM}; pg8::gemm_phase<pg8::EpiPlain, pg8::StaticOrder, false, true>(F.lds, gm, S, E, F.tid); }
                if (M4 > TL) { pg8::Gemm gm{A4, WSP(bf16, WS_WOUT) + (size_t)l * DM * DM, TT, DM, DM, 256, 0, 0}; pg8::SplitKOrder S; S.init(TL / 256, 4, 4, 4, F.G, F.bid);
                    pg8::EpiSlab E{WSP(float, WS_SLAB4), DM, TL / 256, (size_t)TC * DM}; pg8::gemm_phase<pg8::EpiSlab, pg8::SplitKOrder, false, true>(F.lds, gm, S, E, F.tid); } } PH_END
            PH_BEGIN { const float* nw = FIN(I_NORMW) + (size_t)l * 6 * DM; const float* modl = MOD + (size_t)l * 5 * NMOD * DM;
                const Thin P{XB, XC, XB, XC, Yb, WSP(float, WS_SLAB4), nw + 3 * DM, modl + 5 * DM, Hb, nw + 4 * DM, modl + 7 * DM, modl + 6 * DM, 1.0f, (M4 > TL) ? 4 : 0, M4, 1, 1}; REP(10) thin_phase(F, P, l == 0 ? 2 : 5, rep_ == 0 && ((DUPMASK >> 10) & 1)); } PH_END
            }
        }
    }
#undef XC
#undef Hb
#undef XB
#undef Yb
#undef ACT
#undef A4
#undef MOD
#undef PH_BEGIN
#undef PH_END
}

#ifndef MK_PER_PHASE
#define MK_PER_PHASE 0
#endif
extern "C" void kernel_launch(void* const* d_in, const int* in_sizes, int n_in, void* d_out, int out_size, void* d_ws, size_t ws_size, hipStream_t stream) {
    static int grid = 0;
    if (grid == 0) {
        if (n_in != 17 || out_size != TL * DM || ws_size < WS_END) { fprintf(stderr, "kernel_launch: unexpected problem (n_in %d, out %d, ws %zu); nothing launched\n", n_in, out_size, ws_size); grid = -1; return; }
        int dev = 0, cus = 0, per_cu = 0;
        if (hipGetDevice(&dev) != hipSuccess || hipDeviceGetAttribute(&cus, hipDeviceAttributeMultiprocessorCount, dev) != hipSuccess) { grid = -1; return; }
        if (hipFuncSetAttribute((const void*)mega_fwd, hipFuncAttributeMaxDynamicSharedMemorySize, LDS_BYTES) != hipSuccess) { fprintf(stderr, "kernel_launch: hipFuncSetAttribute failed\n"); grid = -1; return; }
        if (hipOccupancyMaxActiveBlocksPerMultiprocessor(&per_cu, (const void*)mega_fwd, NTHR, LDS_BYTES) != hipSuccess || per_cu < 1) fprintf(stderr, "kernel_launch: occupancy query reports %d\n", per_cu);
        (void)hipGetLastError();
        grid = cus;
    }
    if (grid < 0) return;
    if (hipMemsetAsync((char*)d_ws + WS_CTL, 0, CTL_ZERO_BYTES, stream) != hipSuccess) return;
    Args a{};
    for (int i = 0; i < 17; ++i) a.in[i] = (const float*)d_in[i];
    a.out = (float*)d_out; a.ws = (unsigned char*)d_ws;
#if MK_PER_PHASE
    for (int p = 0; p < NPHASES; ++p) { a.ph_lo = p; a.ph_hi = p + 1; hipLaunchKernelGGL(mega_fwd, dim3(grid), dim3(NTHR), LDS_BYTES, stream, a); }
#else
    a.ph_lo = 0; a.ph_hi = NPHASES;
    hipLaunchKernelGGL(mega_fwd, dim3(grid), dim3(NTHR), LDS_BYTES, stream, a);
#endif
}
```

```cpp
#include <hip/hip_runtime.h>
#include <cstdio>
#include <cstdint>
namespace pg8 {
#define PG8_LAS __attribute__((address_space(3)))
typedef unsigned short bf16_t;
typedef short bf16x8 __attribute__((ext_vector_type(8)));
typedef float f32x4 __attribute__((ext_vector_type(4)));
typedef unsigned u32x4 __attribute__((ext_vector_type(4)));
constexpr int BM = 256, BK = 64, HALF = 128, HTB = HALF * BK * 2  , STAGE_BYTES = 8 * HTB, NXCD = 8, WGM = 8;

__host__ __device__ __forceinline__ int lds_byte(int r, int c) { const int st = (r >> 4) * 2 + (c >> 5), rr = r & 15, cc = c & 31, ob = rr * 64 + cc * 2; return st * 1024 + (ob ^ (((ob >> 9) & 1) << 5)); }
__host__ __device__ __forceinline__ void stage_rc(int b, int& R, int& C) { const int st = b / 1024, sb = b % 1024, swz = sb ^ (((sb >> 9) & 1) << 5); R = (st >> 1) * 16 + swz / 64; C = (st & 1) * 32 + (swz % 64) / 2; }
__host__ __device__ __forceinline__ int perm32(int rho) { const int n = rho >> 4, i = rho & 15; return 8 * (i >> 2) + 4 * n + (i & 3); }

struct Unit { int pm, pn, ks; };
struct Gemm { const bf16_t* A; const bf16_t* Bt; int M, N, K, Klen; int atm, btm; };

struct StaticOrder {
    int nM, nN, nwg, G, c, rev;
    __host__ __device__ void init(int M, int N, int G_, int c_, int rev_ = 0) { nM = M / BM; nN = N / BM; nwg = nM * nN; G = G_; c = c_; rev = rev_; }
    __host__ __device__ bool next(int i, Unit& u) const {
        const long L = (long)i * G + c; if (L >= nwg) return false;
        int wgid = (int)L; { const int q = nwg / NXCD, r = nwg % NXCD, xcd = wgid % NXCD, off = wgid / NXCD; wgid = (xcd < r ? xcd * (q + 1) : r * (q + 1) + (xcd - r) * q) + off; }
        const int nig = WGM * nN, gid = wgid / nig, fm = gid * WGM, gsz = (nM - fm) < WGM ? (nM - fm) : WGM;
        u.pm = fm + ((wgid % nig) % gsz); u.pn = (wgid % nig) / gsz; u.ks = 0; if (rev) u.pm = nM - 1 - u.pm; return true;
    }
    __device__ __forceinline__ void a_ready(const Unit&) const {}
    __device__ __forceinline__ void done(const Unit&) const {}
};

struct SplitKOrder {
    int pm0, nN, nS, nU, G, c;
    __host__ __device__ void init(int pm0_, int nP, int nN_, int nS_, int G_, int c_) { pm0 = pm0_; nN = nN_; nS = nS_; nU = nP * nN_ * nS_; G = G_; c = c_; }
    __host__ __device__ bool next(int i, Unit& u) const { const int L = i * G + c; if (L >= nU) return false; u.ks = L % nS; u.pn = (L / nS) % nN; u.pm = pm0 + L / (nS * nN); return true; }
    __device__ __forceinline__ void a_ready(const Unit&) const {}
    __device__ __forceinline__ void done(const Unit&) const {}
};

__device__ __forceinline__ unsigned cvt_pk_bf16(float lo, float hi) { unsigned r; asm volatile("v_cvt_pk_bf16_f32 %0, %1, %2" : "=v"(r) : "v"(lo), "v"(hi)); return r; }
typedef float f32x2 __attribute__((ext_vector_type(2)));
__device__ __forceinline__ float fast_sigmoid(float x) { return __builtin_amdgcn_rcpf(1.0f + __expf(-x)); }
struct EpiPlain {
    static constexpr bool PERM = true, AFTER_DRAIN = false;
    bf16_t* O; int ldo;
    __device__ __forceinline__ void operator()(const f32x4 (&acc)[2][2][4][2], const Unit& u, int wr, int wc, int fr, int fq) const {
        const int row0 = u.pm * BM + wr * 64 + fr, col0 = u.pn * BM + wc * 32 + 8 * fq;
#pragma unroll
        for (int ai = 0; ai < 2; ++ai)
#pragma unroll
            for (int m = 0; m < 4; ++m) { bf16_t* rowp = O + (size_t)(row0 + ai * HALF + m * 16) * ldo + col0;
#pragma unroll
                for (int bj = 0; bj < 2; ++bj) { const f32x4 v0 = acc[ai][bj][m][0], v1 = acc[ai][bj][m][1];
                    u32x4 w; w.x = cvt_pk_bf16(v0[0], v0[1]); w.y = cvt_pk_bf16(v0[2], v0[3]); w.z = cvt_pk_bf16(v1[0], v1[1]); w.w = cvt_pk_bf16(v1[2], v1[3]);
                    *(u32x4*)(rowp + bj * HALF) = w; } }
    }
};
struct EpiSwiGLU {
    static constexpr bool PERM = true, AFTER_DRAIN = false;
    bf16_t* O; int ldo;
    __device__ __forceinline__ void operator()(const f32x4 (&acc)[2][2][4][2], const Unit& u, int wr, int wc, int fr, int fq) const {
        const int nkt = ldo / BK, kt = u.pn * 2 + (wc >> 1), c64 = (wc & 1) * 32 + 8 * fq;
        bf16_t* base = O + ((size_t)(u.pm * nkt + kt) * BM) * BK + c64;
#pragma unroll
        for (int ai = 0; ai < 2; ++ai)
#pragma unroll
            for (int m = 0; m < 4; ++m) { bf16_t* rowp = base + (size_t)(wr * 64 + fr + ai * HALF + m * 16) * BK;
                f32x4 a0, a1;
#pragma unroll
                for (int j = 0; j < 4; ++j) { const float g0 = acc[ai][0][m][0][j], g1 = acc[ai][0][m][1][j];
                    a0[j] = g0 * fast_sigmoid(g0) * acc[ai][1][m][0][j]; a1[j] = g1 * fast_sigmoid(g1) * acc[ai][1][m][1][j]; }
                u32x4 w; w.x = cvt_pk_bf16(a0[0], a0[1]); w.y = cvt_pk_bf16(a0[2], a0[3]); w.z = cvt_pk_bf16(a1[0], a1[1]); w.w = cvt_pk_bf16(a1[2], a1[3]);
                *(u32x4*)rowp = w; }
    }
};
struct EpiInProj {
    static constexpr bool PERM = true, AFTER_DRAIN = false;
    bf16_t* XF; bf16_t* XM; bf16_t* A4; float* GT;
    __device__ __forceinline__ void operator()(const f32x4 (&acc)[2][2][4][2], const Unit& u, int wr, int wc, int fr, int fq) const {
        const int row0 = u.pm * BM + wr * 64 + fr;
        if (u.pn < 6) {
            bf16_t* base; int ldo;
            if (u.pn < 2) { base = XF + u.pn * BM; ldo = 512; } else if (u.pn < 4) { base = XM + (u.pn - 2) * BM; ldo = 512; } else { base = A4 + 512 + (u.pn - 4) * BM; ldo = 1024; }
            const int col0 = wc * 32 + 8 * fq;
#pragma unroll
            for (int ai = 0; ai < 2; ++ai)
#pragma unroll
                for (int m = 0; m < 4; ++m) { bf16_t* rowp = base + (size_t)(row0 + ai * HALF + m * 16) * ldo + col0;
#pragma unroll
                    for (int bj = 0; bj < 2; ++bj) { const f32x4 v0 = acc[ai][bj][m][0], v1 = acc[ai][bj][m][1];
                        u32x4 w; w.x = cvt_pk_bf16(v0[0], v0[1]); w.y = cvt_pk_bf16(v0[2], v0[3]); w.z = cvt_pk_bf16(v1[0], v1[1]); w.w = cvt_pk_bf16(v1[2], v1[3]);
                        *(u32x4*)(rowp + bj * HALF) = w; } }
        } else if (wc == 0 && fq < 2) {
#pragma unroll
            for (int ai = 0; ai < 2; ++ai)
#pragma unroll
                for (int m = 0; m < 4; ++m) { float* rowp = GT + (size_t)(row0 + ai * HALF + m * 16) * 16 + 8 * fq;
                    *(f32x4*)rowp = acc[ai][0][m][0]; *(f32x4*)(rowp + 4) = acc[ai][0][m][1]; }
        }
    }
};
struct EpiSlab {
    static constexpr bool PERM = false, AFTER_DRAIN = false;
    float* S; int ldo; int pm0; size_t slab_stride;
    __device__ __forceinline__ void operator()(const f32x4 (&acc)[2][2][4][2], const Unit& u, int wr, int wc, int fr, int fq) const {
        float* base = S + (size_t)u.ks * slab_stride + (size_t)((u.pm - pm0) * BM) * ldo + u.pn * BM;
        unsigned off = (unsigned)((wr * 64 + fr) * ldo + wc * 32 + 4 * fq);
#pragma unroll
        for (int ai = 0; ai < 2; ++ai)
#pragma unroll
            for (int m = 0; m < 4; ++m) { float* rowp = base + off + (unsigned)((ai * HALF + m * 16) * ldo);
#pragma unroll
                for (int bj = 0; bj < 2; ++bj)
#pragma unroll
                    for (int n = 0; n < 2; ++n) *(f32x4*)(rowp + bj * HALF + n * 16) = acc[ai][bj][m][n];
                asm volatile("" ::: "memory"); }
    }
};
template <class Epi, class Sched, bool ALIGN_EPI = false, bool SP2 = false>
__device__ __forceinline__ void gemm_phase(PG8_LAS unsigned char* lds, const Gemm g, const Sched& S, const Epi& E, int tid_in) {
    int tid_ = tid_in; asm volatile("" : "+v"(tid_)); const int tid = tid_, wid = __builtin_amdgcn_readfirstlane(tid >> 6), lane = tid & 63, wr = wid >> 2, wc = wid & 3, fr = lane & 15, fq = lane >> 4;
    const int K = g.K, nt = g.Klen / BK;
    unsigned voffA[2], voffB[2];
#pragma unroll
    for (int i = 0; i < 2; ++i) { int R, C; stage_rc(tid * 16 + i * 8192, R, C); const int Rb = Epi::PERM ? ((R & ~31) + perm32(R & 31)) : R;
        voffA[i] = (unsigned)(R * (g.atm ? BK : K) + C) * 2u; voffB[i] = (unsigned)(Rb * (g.btm ? BK : K) + C) * 2u; }
    const size_t kstepA = g.atm ? (size_t)BM * BK * 2 : (size_t)(BK * 2), hstepA = g.atm ? (size_t)HALF * BK * 2 : (size_t)HALF * K * 2, tstepA = (size_t)BM * K * 2;
    const size_t kstepB = g.btm ? (size_t)BM * BK * 2 : (size_t)(BK * 2), hstepB = g.btm ? (size_t)HALF * BK * 2 : (size_t)HALF * K * 2, tstepB = (size_t)BM * K * 2;
    const unsigned ldsw = (unsigned)wid * 1024u;
    const int aoff = lds_byte(wr * 64 + fr, fq * 8), boff = lds_byte(wc * 32 + fr, fq * 8);
#define PG8_SA(b, h) (((b) * 2 + (h)) * HTB)
#define PG8_SB(b, h) ((4 + (b) * 2 + (h)) * HTB)
#define PG8_STAGE(bufoff, gbase, voff) do { _Pragma("unroll") for (int _i = 0; _i < 2; ++_i) \
        __builtin_amdgcn_global_load_lds((const unsigned*)((const char*)(gbase) + (voff)[_i]), (PG8_LAS unsigned*)(lds + (bufoff) + ldsw + _i * 8192), 16, 0, 0); } while (0)
#define PG8_LDA(dst, b, h) do { _Pragma("unroll") for (int m = 0; m < 4; ++m) _Pragma("unroll") for (int k = 0; k < 2; ++k) dst[m][k] = *(const PG8_LAS bf16x8*)(lds + PG8_SA(b, h) + aoff + m * 2048 + k * 1024); } while (0)
#define PG8_LDB(dst, b, h) do { _Pragma("unroll") for (int n = 0; n < 2; ++n) _Pragma("unroll") for (int k = 0; k < 2; ++k) dst[n][k] = *(const PG8_LAS bf16x8*)(lds + PG8_SB(b, h) + boff + n * 2048 + k * 1024); } while (0)
#define PG8_MMA(ai, bj, At, Bt) do { __builtin_amdgcn_s_setprio(1); _Pragma("unroll") for (int m = 0; m < 4; ++m) _Pragma("unroll") for (int n = 0; n < 2; ++n) _Pragma("unroll") for (int k = 0; k < 2; ++k) \
        acc[ai][bj][m][n] = __builtin_amdgcn_mfma_f32_16x16x32_bf16(Bt[n][k], At[m][k], acc[ai][bj][m][n], 0, 0, 0); __builtin_amdgcn_s_setprio(0); } while (0)
#define PG8_WAIT_V(n) asm volatile("s_waitcnt vmcnt(" #n ")" ::: "memory")
#define PG8_WAIT_L(n) asm volatile("s_waitcnt lgkmcnt(" #n ")" ::: "memory")
#define PG8_BAR __builtin_amdgcn_s_barrier()
#define PG8_SCHED __builtin_amdgcn_sched_barrier(0)
    Unit cur, nxt; int ui = 0;
    if (!S.next(0, cur)) return;
    f32x4 acc[2][2][4][2];
#pragma unroll
    for (int a = 0; a < 2; ++a)
#pragma unroll
        for (int b = 0; b < 2; ++b)
#pragma unroll
            for (int m = 0; m < 4; ++m)
#pragma unroll
                for (int n = 0; n < 2; ++n) acc[a][b][m][n] = (f32x4){0.f, 0.f, 0.f, 0.f};
    bf16x8 At[4][2], B0[2][2], B1[2][2];
    const size_t sstepA = (size_t)(g.Klen / BK) * kstepA, sstepB = (size_t)(g.Klen / BK) * kstepB;
    const char* cA = (const char*)g.A + (size_t)cur.pm * tstepA + (size_t)cur.ks * sstepA; const char* cB = (const char*)g.Bt + (size_t)cur.pn * tstepB + (size_t)cur.ks * sstepB;
    S.a_ready(cur);
    if constexpr (SP2) {
        PG8_STAGE(PG8_SB(0, 0), cB, voffB); PG8_STAGE(PG8_SB(0, 1), cB + hstepB, voffB); PG8_STAGE(PG8_SA(0, 0), cA, voffA); PG8_STAGE(PG8_SA(0, 1), cA + hstepA, voffA);
        if (wr == 1) PG8_BAR;
        PG8_WAIT_V(2); PG8_BAR;
        PG8_STAGE(PG8_SB(1, 0), cB + kstepB, voffB); PG8_STAGE(PG8_SA(1, 0), cA + kstepA, voffA); PG8_STAGE(PG8_SB(1, 1), cB + hstepB + kstepB, voffB);
        PG8_WAIT_V(6); PG8_BAR;
    } else {
        PG8_STAGE(PG8_SB(0, 0), cB, voffB); PG8_STAGE(PG8_SA(0, 0), cA, voffA); PG8_STAGE(PG8_SB(0, 1), cB + hstepB, voffB); PG8_STAGE(PG8_SA(0, 1), cA + hstepA, voffA);
        if (wr == 1) PG8_BAR;
        PG8_WAIT_V(4); PG8_BAR;
        PG8_STAGE(PG8_SB(1, 0), cB + kstepB, voffB); PG8_STAGE(PG8_SA(1, 0), cA + kstepA, voffA); PG8_STAGE(PG8_SB(1, 1), cB + hstepB + kstepB, voffB);
        PG8_WAIT_V(6); PG8_BAR;
    }
    for (;;) {
        const bool has_next = S.next(ui + 1, nxt);
        const char* nA = has_next ? (const char*)g.A + (size_t)nxt.pm * tstepA + (size_t)nxt.ks * sstepA : cA; const char* nB = has_next ? (const char*)g.Bt + (size_t)nxt.pn * tstepB + (size_t)nxt.ks * sstepB : cB;
        for (int t = 0; t < nt; t += 2) {
            const bool last = (t == nt - 2);
            const char* a1 = cA + (size_t)(t + 1) * kstepA;
            const char* a2 = last ? nA : cA + (size_t)(t + 2) * kstepA; const char* b2 = last ? nB : cB + (size_t)(t + 2) * kstepB;
            const char* a3 = a2 + kstepA; const char* b3 = b2 + kstepB;
            if (last && has_next) S.a_ready(nxt);
            if constexpr (SP2) {
            PG8_LDB(B0, 0, 0); PG8_LDB(B1, 0, 1); PG8_SCHED; PG8_LDA(At, 0, 0); PG8_STAGE(PG8_SA(1, 1), a1 + hstepA, voffA);
            PG8_WAIT_V(8); PG8_WAIT_L(0); PG8_BAR; PG8_MMA(0, 0, At, B0); PG8_MMA(0, 1, At, B1); PG8_BAR; PG8_SCHED;
            PG8_LDA(At, 0, 1); PG8_STAGE(PG8_SB(0, 0), b2, voffB); PG8_STAGE(PG8_SB(0, 1), b2 + hstepB, voffB); PG8_STAGE(PG8_SA(0, 0), a2, voffA);
            PG8_WAIT_V(8); PG8_WAIT_L(0); PG8_BAR; PG8_MMA(1, 0, At, B0); PG8_MMA(1, 1, At, B1); PG8_BAR; PG8_SCHED;
            PG8_LDB(B0, 1, 0); PG8_LDB(B1, 1, 1); PG8_SCHED; PG8_LDA(At, 1, 0); PG8_STAGE(PG8_SA(0, 1), a2 + hstepA, voffA);
            PG8_WAIT_V(8); PG8_WAIT_L(0); PG8_BAR; PG8_MMA(0, 0, At, B0); PG8_MMA(0, 1, At, B1); PG8_BAR; PG8_SCHED;
            PG8_LDA(At, 1, 1); PG8_STAGE(PG8_SB(1, 0), b3, voffB); PG8_STAGE(PG8_SB(1, 1), b3 + hstepB, voffB); PG8_STAGE(PG8_SA(1, 0), a3, voffA);
            PG8_WAIT_V(8); PG8_WAIT_L(0); PG8_BAR; PG8_MMA(1, 0, At, B0); PG8_MMA(1, 1, At, B1); PG8_BAR; PG8_SCHED;
            } else {
            PG8_LDB(B0, 0, 0); PG8_SCHED; PG8_LDA(At, 0, 0); PG8_STAGE(PG8_SA(1, 1), a1 + hstepA, voffA);
            PG8_WAIT_L(8); PG8_BAR; PG8_WAIT_L(0); PG8_MMA(0, 0, At, B0); PG8_BAR; PG8_SCHED;
            PG8_LDB(B1, 0, 1); PG8_STAGE(PG8_SB(0, 0), b2, voffB);
            PG8_BAR; PG8_WAIT_L(0); PG8_MMA(0, 1, At, B1); PG8_BAR;
            PG8_LDA(At, 0, 1); PG8_STAGE(PG8_SA(0, 0), a2, voffA);
            PG8_BAR; PG8_WAIT_L(0); PG8_MMA(1, 0, At, B0); PG8_BAR; PG8_SCHED;
            PG8_STAGE(PG8_SB(0, 1), b2 + hstepB, voffB);
            PG8_WAIT_V(6); PG8_BAR; PG8_MMA(1, 1, At, B1); PG8_BAR;
            PG8_LDB(B0, 1, 0); PG8_SCHED; PG8_LDA(At, 1, 0); PG8_STAGE(PG8_SA(0, 1), a2 + hstepA, voffA);
            PG8_WAIT_L(8); PG8_BAR; PG8_WAIT_L(0); PG8_MMA(0, 0, At, B0); PG8_BAR; PG8_SCHED;
            PG8_LDB(B1, 1, 1); PG8_STAGE(PG8_SB(1, 0), b3, voffB);
            PG8_BAR; PG8_WAIT_L(0); PG8_MMA(0, 1, At, B1); PG8_BAR;
            PG8_LDA(At, 1, 1); PG8_STAGE(PG8_SA(1, 0), a3, voffA);
            PG8_BAR; PG8_WAIT_L(0); PG8_MMA(1, 0, At, B0); PG8_BAR; PG8_SCHED;
            PG8_STAGE(PG8_SB(1, 1), b3 + hstepB, voffB);
            PG8_WAIT_V(6); PG8_BAR; PG8_MMA(1, 1, At, B1); PG8_BAR;
            }
        }
        if constexpr (ALIGN_EPI) { if (wr == 0) PG8_BAR; }
        if constexpr (!Epi::AFTER_DRAIN) { E(acc, cur, wr, wc, fr, fq); S.done(cur); }
        if (!has_next) break;
#pragma unroll
        for (int a = 0; a < 2; ++a)
#pragma unroll
            for (int b = 0; b < 2; ++b)
#pragma unroll
                for (int m = 0; m < 4; ++m)
#pragma unroll
                    for (int n = 0; n < 2; ++n) acc[a][b][m][n] = (f32x4){0.f, 0.f, 0.f, 0.f};
        cur = nxt; cA = nA; cB = nB; ++ui;
        if constexpr (ALIGN_EPI) { if (wr == 1) PG8_BAR; }
    }
    PG8_WAIT_V(0);
    if constexpr (!ALIGN_EPI) { if (wr == 0) PG8_BAR; }
    PG8_BAR;
    if constexpr (Epi::AFTER_DRAIN) { E.fused(acc, cur, wr, wc, fr, fq, lds, wid, lane); S.done(cur); }
#undef PG8_SA
#undef PG8_SB
#undef PG8_STAGE
#undef PG8_LDA
#undef PG8_LDB
#undef PG8_MMA
#undef PG8_WAIT_V
#undef PG8_WAIT_L
#undef PG8_BAR
#undef PG8_SCHED
}
}
constexpr int NWAVES = 8, NTHR = 512;
constexpr int DM = 1024, NB = 4, SEQ = 8192, DEPTH = 2, CTXL = 256, DFF = 2816, DINP = 1552, DIN_PAD = 1792;
constexpr int TL = NB * SEQ, TC = NB * CTXL, TT = TL + TC;
constexpr int NH = 4, HD = 128, NMOD = 9;
constexpr int NCG = TT / 128;
constexpr int NUID = NCG * NH;
constexpr float EPSN = 1e-6f;

constexpr size_t MiB = 1u << 20;
constexpr size_t WS_CTL = 0, CTL_ZERO_BYTES = 32 * 1024;
constexpr size_t WS_MOD = 1 * MiB;
constexpr size_t WS_TAB = 2 * MiB;
constexpr size_t WS_WQKV = 3 * MiB;
constexpr size_t WS_XC = 4 * MiB;
constexpr size_t WS_WFFIN = 8 * MiB;
constexpr size_t WS_WFFOUT = 52 * MiB;
constexpr size_t WS_WIN = 74 * MiB;
constexpr size_t WS_WOUT = 81 * MiB;
constexpr size_t WS_XB = 88 * MiB;
constexpr size_t WS_Y = 154 * MiB;
constexpr size_t WS_R = 220 * MiB;
constexpr size_t WS_ACT = WS_R;
constexpr size_t WS_Q = WS_R;
constexpr size_t WS_K = WS_R + 33 * MiB;
constexpr size_t WS_VT = WS_R + 66 * MiB;
constexpr size_t WS_CL = WS_R + 99 * MiB;
constexpr size_t WS_A4 = WS_R + 165 * MiB;
constexpr size_t WS_GT = WS_R + 264 * MiB;
constexpr size_t WS_GA = WS_R + 267 * MiB;
constexpr size_t WS_NL = WS_R + 270 * MiB;
constexpr size_t WS_SC = WS_R + 272 * MiB;
constexpr size_t WS_WC = WS_R + 273 * MiB;
constexpr size_t WS_END = WS_R + 274 * MiB;
constexpr size_t WS_SLAB2 = WS_R + 184 * MiB;
constexpr size_t WS_SLAB4 = WS_R;
static_assert(WS_ACT + (size_t)TT * DFF * 2 <= 512 * MiB && WS_END <= 512 * MiB, "d_ws map");
static_assert((size_t)TT * 1024 * 2 <= 99 * MiB && (size_t)2 * NUID * 32768 <= 66 * MiB && (size_t)TT * 512 * 2 <= 33 * MiB, "d_ws map 2");
constexpr int CW_BAR = 4096;
constexpr int CW_MODCNT = 1024;
constexpr size_t TAB_W1 = 0;
constexpr size_t TAB_W2 = 65536;
constexpr size_t TAB_TW = 131072;
constexpr size_t TAB_PQF = 196608;
constexpr size_t TAB_PQ32 = 458752;

constexpr int LDS_BYTES = 163840;
constexpr int MISC_OFF = LDS_BYTES - 256;
constexpr int SCR_BYTES = MISC_OFF;

#define GAS __attribute__((address_space(1)))
#define LAS __attribute__((address_space(3)))
typedef unsigned short bf16;
typedef unsigned v4u __attribute__((ext_vector_type(4)));
typedef unsigned v2u __attribute__((ext_vector_type(2)));
typedef float f32x4 __attribute__((ext_vector_type(4)));
typedef float f32x2 __attribute__((ext_vector_type(2)));
typedef short bf16x8 __attribute__((ext_vector_type(8)));
typedef short s16x4 __attribute__((ext_vector_type(4)));
typedef GAS unsigned gu32;
#define RLX_AGENT __ATOMIC_RELAXED, __HIP_MEMORY_SCOPE_AGENT
#define LDS_WAIT() asm volatile("s_waitcnt lgkmcnt(0)" ::: "memory")
#define VM_WAIT() asm volatile("s_waitcnt vmcnt(0)" ::: "memory")
#define VM_DONE() __builtin_amdgcn_s_waitcnt(0x0F70)
__device__ __forceinline__ float bf2f(unsigned b) { return __builtin_bit_cast(float, b << 16); }
typedef __bf16 bf16x2_t __attribute__((ext_vector_type(2)));
__device__ __forceinline__ unsigned pk2(float lo, float hi) { const f32x2 v = {lo, hi}; const bf16x2_t b = __builtin_convertvector(v, bf16x2_t); return __builtin_bit_cast(unsigned, b); }
__device__ __forceinline__ float wave_sum(float v) {
#pragma unroll
    for (int o = 1; o < 64; o <<= 1) v += __shfl_xor(v, o);
    return v;
}
__device__ __forceinline__ f32x4 mfma16(bf16x8 a, bf16x8 b, f32x4 c) { return __builtin_amdgcn_mfma_f32_16x16x32_bf16(a, b, c, 0, 0, 0); }
__device__ __forceinline__ float logsigf(float x) { return fminf(x, 0.f) - log1pf(__expf(-fabsf(x))); }

#ifndef DUPMASK
#define DUPMASK 0
#endif
#define REP(bit) _Pragma("unroll 1") for (int rep_ = 0; rep_ < 1 + ((DUPMASK >> (bit)) & 1); ++rep_)
__device__ __forceinline__ void lds_barrier() { asm volatile("s_waitcnt lgkmcnt(0)" ::: "memory"); __builtin_amdgcn_s_barrier(); asm volatile("" ::: "memory"); }
#define XB_TMO      128
#define XB_XCNT(j)  (256  + 64 * (j))
#define XB_XSUB(j)  (1280 + 64 * (j))
#define XB_XGEN(j)  (2304 + 64 * (j))
#define XB_TOP      3328
#define XB_TOPGEN   3392
#define XCD_BAR_WORDS 3456
#define XB_SPIN_CAP (1u << 18)

__device__ __forceinline__ unsigned xb_ld(unsigned* p)              { return __hip_atomic_load(p, __ATOMIC_RELAXED, __HIP_MEMORY_SCOPE_AGENT); }
__device__ __forceinline__ unsigned xb_add(unsigned* p, unsigned v) { return __hip_atomic_fetch_add(p, v, __ATOMIC_RELAXED, __HIP_MEMORY_SCOPE_AGENT); }
__device__ __forceinline__ unsigned xb_xcc_id() { return (unsigned)__builtin_amdgcn_s_getreg((3 << 11) | 20) & 0xFu; }
#define XB_SPIN(cond, bar) do { unsigned _sp = 0; while (cond) { __builtin_amdgcn_s_sleep(1); \
    if ((++_sp & 255u) == 0u) { if (xb_ld(&(bar)[XB_TMO])) break; if (_sp > XB_SPIN_CAP) { atomicAdd(&(bar)[XB_TMO], 1u); break; } } } } while (0)

struct XcdBarrier {
    unsigned* bar; unsigned x;
    volatile LAS unsigned* st;
};

__device__ __forceinline__ XcdBarrier xcd_barrier_post(unsigned* bar, volatile LAS unsigned* st) {
    XcdBarrier b; b.bar = bar; b.x = xb_xcc_id(); b.st = st;
    if (threadIdx.x == 0) (void)xb_add(&bar[XB_XCNT(b.x)], 1u);
    return b;
}
__device__ __forceinline__ void xcd_barrier_complete(unsigned* bar, unsigned x, unsigned& nloc, unsigned& nx, const unsigned G) {
    unsigned sum, cnt, mine, sp = 0u;
    for (;;) {
        sum = 0u; cnt = 0u; mine = 0u;
#pragma unroll
        for (unsigned j = 0; j < 16; ++j) { const unsigned c = xb_ld(&bar[XB_XCNT(j)]); sum += c; cnt += (c > 0u) ? 1u : 0u; mine = (j == x) ? c : mine; }
        if (sum == G) break;
        __builtin_amdgcn_s_sleep(1);
        if ((++sp & 255u) == 0u) { if (xb_ld(&bar[XB_TMO])) break; if (sp > XB_SPIN_CAP) { atomicAdd(&bar[XB_TMO], 1u); break; } }
    }
    nloc = mine > 0u ? mine : 1u; nx = cnt > 0u ? cnt : 1u;
}

__device__ __attribute__((noinline)) void xcd_barrier(unsigned* bar_, unsigned x_, volatile LAS unsigned* st_, int tid_, unsigned G_) { XcdBarrier b; b.bar = bar_; b.x = x_; b.st = st_;
    asm volatile("s_waitcnt vmcnt(0)" ::: "memory");
    __syncthreads();
    if (tid_ == 0) {
        unsigned* bar = b.bar;
        __builtin_amdgcn_s_waitcnt(0);
        unsigned nloc = b.st[0], nx = b.st[1];
        if (nloc == 0u) { xcd_barrier_complete(bar, b.x, nloc, nx, G_); b.st[0] = nloc; b.st[1] = nx; }
        const unsigned old = xb_add(&bar[XB_XSUB(b.x)], 1u);
        const unsigned gen = old / nloc;
        if (old + 1u == (gen + 1u) * nloc) {
            __builtin_amdgcn_fence(__ATOMIC_RELEASE, "agent");
            asm volatile("s_waitcnt vmcnt(0)" ::: "memory");
            const unsigned og = xb_add(&bar[XB_TOP], 1u);
            const unsigned tg = og / nx;
            if (og + 1u == (tg + 1u) * nx) xb_add(&bar[XB_TOPGEN], 1u);
            else XB_SPIN(xb_ld(&bar[XB_TOPGEN]) == tg, bar);
            __builtin_amdgcn_fence(__ATOMIC_ACQUIRE, "agent");
            xb_add(&bar[XB_XGEN(b.x)], 1u);
            asm volatile("s_waitcnt vmcnt(0)" ::: "memory");
        } else {
            XB_SPIN(xb_ld(&bar[XB_XGEN(b.x)]) == gen, bar);
            __builtin_amdgcn_fence(__ATOMIC_ACQUIRE, "agent");
            asm volatile("s_waitcnt vmcnt(0)" ::: "memory");
        }
    }
    __syncthreads();
}
struct Frame {
    LAS unsigned char* lds;
    volatile LAS unsigned* MISC;
    gu32* ctl;
    int tid, lane, wave;
    int vcu, G, bid;
    unsigned char* ws;
};
constexpr int PTAB_OFF = MISC_OFF + 64;
__device__ __forceinline__ unsigned long long ptab(const Frame& F, int i) { const LAS unsigned* p = (const LAS unsigned*)(F.lds + PTAB_OFF) + 2 * i;
    const unsigned lo = __builtin_amdgcn_readfirstlane(p[0]), hi = __builtin_amdgcn_readfirstlane(p[1]); return ((unsigned long long)hi << 32) | lo; }
#define FIN(i) ((const float*)(const GAS float*)ptab(F, (i)))
#define FOUT ((float*)(GAS float*)ptab(F, 17))
enum { I_X = 0, I_C, I_CTX, I_CCTX, I_WADA, I_BADA, I_NORMW, I_WFFIN, I_WFFOUT, I_WIN, I_WFMIX, I_CONVW, I_CONVB, I_WQKV, I_GATEB, I_HNW, I_WOUT };
#define WSP(T, off) ((T*)(F.ws + (off)))

__device__ __forceinline__ void p0_transpose_item(const float* W, int ldn, int nvalid, int k0, int n0, bf16* WT, int ldw, int drow, int dcol, float scale, LAS float* scr, int lane, int tm = 0) {
    const int c4 = (lane & 7) * 4; const bool ok = (n0 + c4) < nvalid;
#pragma unroll
    for (int i = 0; i < 8; ++i) { const int kk = 8 * i + (lane >> 3); const f32x4 v = ok ? __builtin_nontemporal_load((const f32x4*)(W + (size_t)(k0 + kk) * ldn + n0 + c4)) * scale : (f32x4){0.f, 0.f, 0.f, 0.f};
        LAS float* d = scr + kk * 33 + c4; d[0] = v[0]; d[1] = v[1]; d[2] = v[2]; d[3] = v[3]; }
    LDS_WAIT(); asm volatile("" ::: "memory");
    const int c = lane & 7;
#pragma unroll
    for (int j = 0; j < 4; ++j) { const int n = (lane >> 3) + 8 * j; const LAS float* s = scr + (8 * c) * 33 + n;
        v4u o; o.x = pk2(s[0 * 33], s[1 * 33]); o.y = pk2(s[2 * 33], s[3 * 33]); o.z = pk2(s[4 * 33], s[5 * 33]); o.w = pk2(s[6 * 33], s[7 * 33]);
        const int rr = drow + n, kk0 = dcol + k0;
        if (tm) *(v4u*)(WT + (((size_t)(rr >> 8) * (ldw >> 6) + (kk0 >> 6)) * 256 + (rr & 255)) * 64 + (kk0 & 63) + 8 * c) = o;
        else *(v4u*)(WT + (size_t)rr * ldw + kk0 + 8 * c) = o; }
    LDS_WAIT(); asm volatile("" ::: "memory");
}

__device__ __forceinline__ void mod_first(Frame& F) {
    const int ncol = 2048 / F.G;
    if (ncol != 8) return;
    const int c0 = 8 * F.vcu, kc = F.tid >> 1, q = F.tid & 1;
    const float* cin = FIN(I_C); const float* cctx = FIN(I_CCTX); const float* wada = FIN(I_WADA);
    f32x4 a[5];
#pragma unroll
    for (int bi = 0; bi < 5; ++bi) a[bi] = (f32x4){0.f, 0.f, 0.f, 0.f};
#pragma unroll
    for (int kk = 0; kk < 4; ++kk) { const int k = 4 * kc + kk; const f32x4 w = *(const f32x4*)(wada + (size_t)k * (NMOD * DM) + c0 + 4 * q);
#pragma unroll
        for (int bi = 0; bi < 5; ++bi) { const float v = (bi < 4) ? cin[bi * DM + k] : cctx[k]; a[bi] += w * (v / (1.f + __expf(-v))); } }
    LAS f32x4* red = (LAS f32x4*)F.lds;
#pragma unroll
    for (int bi = 0; bi < 5; ++bi) red[(kc * 2 + q) * 5 + bi] = a[bi];
    __syncthreads();
    if (F.tid < 40) { const int bi = F.tid >> 3, col = F.tid & 7; float s = FIN(I_BADA)[c0 + col];
        for (int k2 = 0; k2 < 256; ++k2) s += red[(k2 * 2 + (col >> 2)) * 5 + bi][col & 3];
        WSP(float, WS_MOD)[(size_t)bi * (NMOD * DM) + c0 + col] = s; }
    __syncthreads();
}
__device__ __forceinline__ void p0_prologue(Frame& F, const int stage, const int wgi, const int NWG) {
    const int gw = wgi * NWAVES + F.wave, NGW = NWG * NWAVES;
    const float* const p_w_ff_in = FIN(I_WFFIN); const float* const p_w_ff_out = FIN(I_WFFOUT); const float* const p_w_in = FIN(I_WIN); const float* const p_w_out = FIN(I_WOUT); const float* const p_w_qkv = FIN(I_WQKV);
    {
        LAS float* scr = (LAS float*)(F.lds + F.wave * 16384);
        constexpr int I_FI = (DM / 64) * (2 * DFF / 32);
        constexpr int I_FO = (DFF / 64) * (DM / 32);
        constexpr int I_IN = (DM / 64) * 49;
        constexpr int I_WO = (DM / 64) * (DM / 32);
        constexpr int I_QK = 12 * 2 * 4;
        constexpr int I_ZR = 224 / 4;
        constexpr int PER_L = 2 * I_FI + 2 * I_FO + I_IN + I_WO + I_QK + I_ZR;
        const int r_lo = (stage == 1) ? I_FI : 0, r_hi = (stage == 0) ? I_FI : (stage == 3 ? DEPTH * PER_L : PER_L);
        REP(22) for (int it = gw; it < r_hi - r_lo; it += NGW) {
            const int l = (stage == 3) ? (r_lo + it) / PER_L : ((stage == 2) ? 1 : 0); int r = (r_lo + it) % PER_L;
            if (r < 2 * I_FI) { const int f = r / I_FI; r %= I_FI; const int nb = r % 176, kb = r / 176; const int n0 = nb * 32;
                const int drow = (n0 < DFF) ? (256 * (n0 >> 7) + (n0 & 127)) : (256 * ((n0 - DFF) >> 7) + 128 + ((n0 - DFF) & 127));
                p0_transpose_item(p_w_ff_in + (size_t)(l * 2 + f) * DM * 2 * DFF, 2 * DFF, 2 * DFF, kb * 64, n0, WSP(bf16, WS_WFFIN) + (size_t)(l * 2 + f) * 2 * DFF * DM, DM, drow, 0, 1.f, scr, F.lane); continue; }
            r -= 2 * I_FI;
            if (r < 2 * I_FO) { const int f = r / I_FO; r %= I_FO; const int nb = r % 32, kb = r / 32;
                p0_transpose_item(p_w_ff_out + (size_t)(l * 2 + f) * DFF * DM, DM, DM, kb * 64, nb * 32, WSP(bf16, WS_WFFOUT) + (size_t)(l * 2 + f) * DM * DFF, DFF, nb * 32, 0, 1.f, scr, F.lane, 1); continue; }
            r -= 2 * I_FO;
            if (r < I_IN) { const int nb = r % 49, kb = r / 49;
                p0_transpose_item(p_w_in + (size_t)l * DM * DINP, DINP, DINP, kb * 64, nb * 32, WSP(bf16, WS_WIN) + (size_t)l * DIN_PAD * DM, DM, nb * 32, 0, 1.f, scr, F.lane); continue; }
            r -= I_IN;
            if (r < I_WO) { const int nb = r % 32, kb = r / 32;
                p0_transpose_item(p_w_out + (size_t)l * DM * DM, DM, DM, kb * 64, nb * 32, WSP(bf16, WS_WOUT) + (size_t)l * DM * DM, DM, nb * 32, 0, 1.f, scr, F.lane); continue; }
            r -= I_WO;
            if (r < I_QK) { const int mat = r / 8, q = r % 8, nb = q % 4, kb = q / 4;
                p0_transpose_item(p_w_qkv + ((size_t)l * 12 + mat) * HD * HD, HD, HD, kb * 64, nb * 32, WSP(bf16, WS_WQKV) + ((size_t)l * 12 + mat) * HD * HD, HD, nb * 32, 0, (mat / 4 == 1) ? 0.08838834764831845f : 1.f, scr, F.lane); continue; }
            r -= I_QK;
            { bf16* z = WSP(bf16, WS_WIN) + (size_t)l * DIN_PAD * DM + (size_t)(1568 + 4 * r) * DM;
#pragma unroll
              for (int j = 0; j < 8; ++j) *(v4u*)(z + (size_t)(j * 64 + F.lane) * 8) = (v4u){0u, 0u, 0u, 0u}; }
        }
    }
    __syncthreads();
    constexpr int I_MOD = DEPTH * (NMOD * DM / 64);
    constexpr int I_FW = DEPTH * 8;
    constexpr int I_TB = 112 + 256;
    const int b_lo = (stage == 0 || stage == 3) ? 0 : (stage == 1 ? I_MOD : I_MOD + I_FW / 2), b_hi = (stage == 0) ? I_MOD : (stage == 1 ? I_MOD + I_FW / 2 : I_MOD + I_FW);
    REP(23) for (int it0 = wgi; it0 < b_hi - b_lo + ((stage == 1 || stage == 3) ? I_TB : 0); it0 += NWG) {
        int it = (b_lo + it0 < b_hi) ? b_lo + it0 : I_MOD + I_FW + (b_lo + it0 - b_hi);
        if (F.G == 256 && stage == 3) { if (it < I_FW) it = I_MOD + it; else if (it < 32 || (it >= I_MOD && it < I_MOD + I_FW)) continue; }
        if (it < I_MOD) {
            if (it < 32 && F.G == 256) continue;
            const int l = it / 144, j0 = (it % 144) * 64;
            LAS float* sc = (LAS float*)F.lds;
            LAS float* red = (LAS float*)(F.lds + 20480);
            for (int i = F.tid; i < 5 * DM; i += NTHR) { const int bi = i >> 10, k = i & 1023; const float v = (bi < 4) ? FIN(I_C)[bi * DM + k] : FIN(I_CCTX)[k]; sc[i] = v / (1.f + __expf(-v)); }
            __syncthreads();
            const int q = F.tid & 15, kc = F.tid >> 4;
            f32x4 a[5];
#pragma unroll
            for (int bi = 0; bi < 5; ++bi) a[bi] = (f32x4){0.f, 0.f, 0.f, 0.f};
            const float* wp = FIN(I_WADA) + (size_t)l * DM * NMOD * DM + (size_t)(kc * 32) * (NMOD * DM) + j0 + 4 * q;
#pragma unroll 16
            for (int k = 0; k < 32; ++k) { const f32x4 w = __builtin_nontemporal_load((const f32x4*)(wp + (size_t)k * (NMOD * DM)));
#pragma unroll
                for (int bi = 0; bi < 5; ++bi) a[bi] += w * sc[bi * DM + kc * 32 + k]; }
#pragma unroll
            for (int bi = 0; bi < 5; ++bi) *(LAS f32x4*)(red + (kc * 5 + bi) * 64 + 4 * q) = a[bi];
            __syncthreads();
            if (F.tid < 320) { const int bi = F.tid >> 6, col = F.tid & 63; float s = FIN(I_BADA)[l * NMOD * DM + j0 + col];
                for (int k2 = 0; k2 < 32; ++k2) s += red[(k2 * 5 + bi) * 64 + col];
                WSP(float, WS_MOD)[((size_t)l * 5 + bi) * (NMOD * DM) + j0 + col] = s; }
            __syncthreads();
        } else if (it < I_MOD + I_FW) {
            const int r = it - I_MOD, g = r & 7, l = r >> 3;
            LAS float* tab = (LAS float*)F.lds;
            LAS float* FM = (LAS float*)(F.lds + 1024);
            LAS float* PQ = (LAS float*)(F.lds + 1024 + 16384);
            if (F.tid < 64) { float sv, cv; sincospif((float)F.tid * (1.f / 32.f), &sv, &cv); tab[F.tid] = 0.125f * cv; tab[64 + F.tid] = -0.125f * sv; }
            for (int i = F.tid; i < 4096; i += NTHR) FM[i] = FIN(I_WFMIX)[((size_t)l * 8 + g) * 4096 + i];
            __syncthreads();
            { const int d4 = (F.tid & 15) * 4, c0 = F.tid >> 4;
              f32x4 s0 = {0.f, 0.f, 0.f, 0.f}, s1 = s0, t0 = s0, t1 = s0;
#pragma unroll 8
              for (int e = 0; e < 64; ++e) { const f32x4 fm = *(const LAS f32x4*)(FM + e * 64 + d4); const int m0 = (c0 * e) & 63, m1 = ((c0 + 32) * e) & 63;
                  s0 += fm * tab[m0]; s1 += fm * tab[m1]; t0 += fm * tab[64 + m0]; t1 += fm * tab[64 + m1]; }
              *(LAS f32x4*)(PQ + c0 * 64 + d4) = s0; *(LAS f32x4*)(PQ + (c0 + 32) * 64 + d4) = s1; *(LAS f32x4*)(PQ + 4096 + c0 * 64 + d4) = t0; *(LAS f32x4*)(PQ + 4096 + (c0 + 32) * 64 + d4) = t1; }
            __syncthreads();
            { float* o32 = (float*)(F.ws + WS_TAB + TAB_PQ32) + ((size_t)l * 8 + g) * 8192;
              for (int i = F.tid; i < 8192; i += NTHR) o32[i] = PQ[i];
              bf16* of = (bf16*)(F.ws + WS_TAB + TAB_PQF) + ((size_t)l * 8 + g) * 8192;
              for (int i = F.tid; i < 8192; i += NTHR) { const int e = i & 7, ln = (i >> 3) & 63, ks = (i >> 9) & 3, nd = i >> 11;
                  const int d = 16 * nd + (ln & 15), c = 32 * (ks & 1) + 16 * (e >> 2) + 4 * (ln >> 4) + (e & 3);
                  of[i] = (bf16)(pk2(PQ[(ks >> 1) * 4096 + c * 64 + d], 0.f) & 0xffffu); } }
            __syncthreads();
        } else {
            const int ti = it - I_MOD - I_FW;
            if (ti < 64) {
                bf16* o = (bf16*)(F.ws + WS_TAB + TAB_W1);
                { const int i = ti * NTHR + F.tid; const int e = i & 7, ln = (i >> 3) & 63, t = (i >> 9) & 3, tl = (i >> 11) & 1, w = i >> 12;
                    const int g = ln >> 4, k1 = 16 * w + (ln & 15), s1 = 32 * t + 16 * (g >> 1) + 8 * (e >> 2) + 4 * (g & 1) + (e & 3);
                    float sv, cv; sincospif((float)((k1 * s1) & 127) * (1.f / 64.f), &sv, &cv);
                    o[i] = (bf16)(pk2(tl ? sv : cv, 0.f) & 0xffffu); }
            } else if (ti < 96) {
                bf16* o = (bf16*)(F.ws + WS_TAB + TAB_W2);
                { const int i = (ti - 64) * NTHR + F.tid; const int e = i & 7, ln = (i >> 3) & 63, t = (i >> 9) & 3, w = i >> 11;
                    const int g = ln >> 4, k2 = 16 * (w & 3) + (ln & 15), sp = 32 * t + 16 * (g >> 1) + 8 * (e >> 2) + 4 * (g & 1) + (e & 3), s2 = sp & 63, inim = sp >> 6, outim = w >> 2;
                    float sv, cv; sincospif((float)((k2 * s2) & 63) * (1.f / 32.f), &sv, &cv);
                    const float v = outim ? (inim ? cv : sv) : (inim ? -sv : cv);
                    o[i] = (bf16)(pk2(v, 0.f) & 0xffffu); }
            } else if (ti >= 112) {
                bf16* o = (bf16*)(F.ws + WS_WC);
                { const int i = (ti - 112) * NTHR + F.tid; const int e = i & 7, ln = (i >> 3) & 63, t = (i >> 9) & 7, tl = (i >> 12) & 1, w = i >> 13;
                    const int g = ln >> 4, k = 16 * w + (ln & 15), sp = 32 * t + 16 * (g >> 1) + 8 * (e >> 2) + 4 * (g & 1) + (e & 3);
                    float sv, cv; sincospif((float)((k * sp) & 255) * (1.f / 128.f), &sv, &cv);
                    o[i] = (bf16)(pk2(0.0625f * (tl ? sv : cv), 0.f) & 0xffffu); }
            } else {
                f32x2* o = (f32x2*)(F.ws + WS_TAB + TAB_TW);
                { const int i = (ti - 96) * NTHR + F.tid; const int s2 = i & 63, k1 = i >> 6; float sv, cv; sincospif((float)(k1 * s2) * (1.f / 4096.f), &sv, &cv);
                    o[i] = (f32x2){cv * 0.011048543456039806f, sv * 0.011048543456039806f}; }
            }
        }
    }
}

struct Thin {
    const void* xin_l; const float* xin_c;
    void* xout_l; float* xout_c;
    const bf16* Y;
    const float* YS;
    const float* nw_post; const float* gate;
    bf16* H; const float* nw_pre; const float* scale; const float* shift;
    float fac; int nslab; int nrows; int xin_bf, xout_bf;
};
#ifdef DBG_FLAGS
#define DBG_FLAG(bit) __hip_atomic_fetch_or((unsigned*)(F.ctl + 64), 1u << (bit), __ATOMIC_RELAXED, __HIP_MEMORY_SCOPE_AGENT)
#else
#define DBG_FLAG(bit) do {} while (0)
#endif
#ifdef DBG_FLAGS
#define DBG_CHK(val, bit) do { if (!(fabsf(val) < 1e30f)) DBG_FLAG(bit); } while (0)
#else
#define DBG_CHK(val, bit) do {} while (0)
#endif
__device__ __forceinline__ void thin_finish(Frame& F, const Thin& P, const int r, f32x4 (&x)[4], const f32x4 (&y)[4], const f32x4 (&A1)[4], const f32x4 (&A2)[4], const f32x4 (&A3)[4], const bool dry) {
    if (P.Y) { float ss = 0.f;
#pragma unroll
        for (int j = 0; j < 4; ++j) ss += (y[j].x * y[j].x + y[j].y * y[j].y) + (y[j].z * y[j].z + y[j].w * y[j].w);
        const float rs = __builtin_amdgcn_rsqf(wave_sum(ss) * (1.f / DM) + EPSN);
#pragma unroll
        for (int j = 0; j < 4; ++j) x[j] += A1[j] * (y[j] * rs); }
    if (r < TL) { if (P.xout_l) { if (P.xout_bf) { bf16* xo = (dry ? WSP(bf16, WS_ACT) : (bf16*)P.xout_l) + (size_t)r * DM;
#pragma unroll
                for (int j = 0; j < 4; ++j) { v2u w; w.x = pk2(x[j].x, x[j].y); w.y = pk2(x[j].z, x[j].w); __builtin_nontemporal_store(w, (v2u*)(xo + 4 * F.lane + 256 * j)); } }
            else { float* xo = (dry ? WSP(float, WS_ACT) : (float*)P.xout_l) + (size_t)r * DM;
#pragma unroll
                for (int j = 0; j < 4; ++j) __builtin_nontemporal_store(x[j], (f32x4*)(xo + 4 * F.lane + 256 * j)); } } }
    else if (P.xout_c) { float* xo = (dry ? WSP(float, WS_ACT) + (size_t)TL * DM : P.xout_c) + (size_t)(r - TL) * DM;
#pragma unroll
        for (int j = 0; j < 4; ++j) *(f32x4*)(xo + 4 * F.lane + 256 * j) = x[j]; }
    if (P.H) { float ss = 0.f;
#pragma unroll
        for (int j = 0; j < 4; ++j) ss += (x[j].x * x[j].x + x[j].y * x[j].y) + (x[j].z * x[j].z + x[j].w * x[j].w);
        const float rs = __builtin_amdgcn_rsqf(wave_sum(ss) * (1.f / DM) + EPSN);
        bf16* hr = P.H + (size_t)r * DM;
#pragma unroll
        for (int j = 0; j < 4; ++j) { const f32x4 h = x[j] * rs * A2[j] + A3[j]; v2u w; w.x = pk2(h.x, h.y); w.y = pk2(h.z, h.w); *(v2u*)(hr + 4 * F.lane + 256 * j) = w; } }
}
__device__ __forceinline__ void thin_vectors(Frame& F, const Thin& P, const int bi, f32x4 (&A1)[4], f32x4 (&A2)[4], f32x4 (&A3)[4]) {
#pragma unroll
    for (int j = 0; j < 4; ++j) { const int col = 4 * F.lane + 256 * j;
        if (P.Y) A1[j] = *(const f32x4*)(P.gate + (size_t)bi * (NMOD * DM) + col) * *(const f32x4*)(P.nw_post + col) * P.fac;
        if (P.H) { A2[j] = *(const f32x4*)(P.nw_pre + col) * (*(const f32x4*)(P.scale + (size_t)bi * (NMOD * DM) + col) + 1.0f); A3[j] = *(const f32x4*)(P.shift + (size_t)bi * (NMOD * DM) + col); } }
}
__device__ __forceinline__ f32x4 bf4(v2u w) { return (f32x4){bf2f(w.x & 0xffffu), bf2f(w.x >> 16), bf2f(w.y & 0xffffu), bf2f(w.y >> 16)}; }
__device__ __forceinline__ void thin_phase(Frame& F, const Thin& P, int dbg_idx = 99, bool dry = false) {
    const int gw = F.vcu * NWAVES + F.wave, NGW = F.G * NWAVES;
    const int nlat = (P.nrows < TL) ? P.nrows : TL;
    const bool has_ctx = P.nrows > TL;
    const int CTXW = (P.nslab > 0) ? 4 : 1;
    int r0, r1;
    if (!has_ctx || NGW != 2048) { const int per = (nlat + NGW - 1) / NGW; r0 = gw * per; r1 = (r0 + per < nlat) ? r0 + per : nlat; }
    else { const int a = 16 - CTXW / 2, b = 16 + CTXW / 2;
        if (gw < 1024) { r0 = gw * a; r1 = r0 + a; } else { r0 = 1024 * a + (gw - 1024) * b; r1 = r0 + b; } }
    int cur = -1;
    f32x4 A1[4], A2[4], A3[4];
    v2u nxb[4], nyb[4]; f32x4 nxf[4];
#define THIN_LOAD(r_) do { const int rr_ = (r_); if (P.xin_bf) { const bf16* xr_ = (const bf16*)P.xin_l + (size_t)rr_ * DM; _Pragma("unroll") for (int j = 0; j < 4; ++j) nxb[j] = __builtin_nontemporal_load((const v2u*)(xr_ + 4 * F.lane + 256 * j)); } \
        else { const float* xr_ = (const float*)P.xin_l + (size_t)rr_ * DM; _Pragma("unroll") for (int j = 0; j < 4; ++j) nxf[j] = __builtin_nontemporal_load((const f32x4*)(xr_ + 4 * F.lane + 256 * j)); } \
        if (P.Y) { const bf16* yr_ = P.Y + (size_t)rr_ * DM; _Pragma("unroll") for (int j = 0; j < 4; ++j) nyb[j] = __builtin_nontemporal_load((const v2u*)(yr_ + 4 * F.lane + 256 * j)); } } while (0)
    if (r0 < r1) THIN_LOAD(r0);
    for (int r = r0; r < r1; ++r) {
        f32x4 x[4], y[4];
#pragma unroll
        for (int j = 0; j < 4; ++j) { x[j] = P.xin_bf ? bf4(nxb[j]) : nxf[j]; y[j] = P.Y ? bf4(nyb[j]) : (f32x4){0.f, 0.f, 0.f, 0.f}; }
        if (r + 1 < r1) THIN_LOAD(r + 1);
        const int bi = r >> 13;
        if (bi != cur) { cur = bi; thin_vectors(F, P, bi, A1, A2, A3); VM_DONE(); }
        thin_finish(F, P, r, x, y, A1, A2, A3, dry);
    }
#undef THIN_LOAD
    if (has_ctx && gw < TC) { const int r = TL + gw;
        thin_vectors(F, P, 4, A1, A2, A3);
        f32x4 x[4], y[4]; const float* xr = P.xin_c + (size_t)gw * DM;
#pragma unroll
        for (int j = 0; j < 4; ++j) { x[j] = *(const f32x4*)(xr + 4 * F.lane + 256 * j); y[j] = (f32x4){0.f, 0.f, 0.f, 0.f}; }
        if (P.Y) { if (P.nslab > 0) {
#pragma unroll 4
                for (int ks = 0; ks < P.nslab; ++ks) { const float* sr = P.YS + ((size_t)ks * TC + gw) * DM;
#pragma unroll
                    for (int j = 0; j < 4; ++j) y[j] += *(const f32x4*)(sr + 4 * F.lane + 256 * j); } }
            else { const bf16* yr = P.Y + (size_t)r * DM;
#pragma unroll
                for (int j = 0; j < 4; ++j) y[j] = bf4(*(const v2u*)(yr + 4 * F.lane + 256 * j)); } }
        thin_finish(F, P, r, x, y, A1, A2, A3, dry);
    }
}
constexpr int RS = 272;
constexpr int TILE_B = 128 * RS;
__device__ __forceinline__ int cg_row0(int cg) { return cg * 128; }
__device__ __forceinline__ bf16x8 lds_frag(const LAS unsigned char* p) { return *(const LAS bf16x8*)p; }
__device__ __forceinline__ bf16x8 glb_frag(const bf16* p) { return *(const bf16x8*)p; }
__device__ __forceinline__ void st4bf(bf16* p, f32x4 v) { v2u w; w.x = pk2(v[0], v[1]); w.y = pk2(v[2], v[3]); *(v2u*)p = w; }
__device__ __forceinline__ void st4bf_lds(LAS unsigned char* p, f32x4 v) { v2u w; w.x = pk2(v[0], v[1]); w.y = pk2(v[2], v[3]); *(LAS v2u*)p = w; }

template <int CTRL, int RM> __device__ __forceinline__ float dpp_f(float idv, float v) { return __builtin_bit_cast(float, __builtin_amdgcn_update_dpp(__builtin_bit_cast(int, idv), __builtin_bit_cast(int, v), CTRL, RM, 0xf, false)); }
__device__ __forceinline__ float dscan_add(float v) {
    v += dpp_f<0x111, 0xf>(0.f, v); v += dpp_f<0x112, 0xf>(0.f, v); v += dpp_f<0x114, 0xf>(0.f, v); v += dpp_f<0x118, 0xf>(0.f, v);
    v += dpp_f<0x142, 0xa>(0.f, v); v += dpp_f<0x143, 0xc>(0.f, v); return v; }
__device__ __forceinline__ float dscan_max(float v) { const float ni = -3.0e38f;
    v = fmaxf(v, dpp_f<0x111, 0xf>(ni, v)); v = fmaxf(v, dpp_f<0x112, 0xf>(ni, v)); v = fmaxf(v, dpp_f<0x114, 0xf>(ni, v)); v = fmaxf(v, dpp_f<0x118, 0xf>(ni, v));
    v = fmaxf(v, dpp_f<0x142, 0xa>(ni, v)); v = fmaxf(v, dpp_f<0x143, 0xc>(ni, v)); return v; }
__device__ __forceinline__ float lane63(float v) { return __builtin_bit_cast(float, __builtin_amdgcn_readlane(__builtin_bit_cast(int, v), 63)); }
__device__ __forceinline__ float wscan_add_up(float v, int lane) {
#pragma unroll
    for (int o = 1; o < 64; o <<= 1) { const float t = __shfl_up(v, o); if (lane >= o) v += t; }
    return v; }
__device__ __forceinline__ float wscan_add_down(float v, int lane) {
#pragma unroll
    for (int o = 1; o < 64; o <<= 1) { const float t = __shfl_down(v, o); if (lane + o < 64) v += t; }
    return v; }
__device__ __forceinline__ float wscan_max_up(float v, int lane) {
#pragma unroll
    for (int o = 1; o < 64; o <<= 1) { const float t = __shfl_up(v, o); if (lane >= o) v = fmaxf(v, t); }
    return v; }
__device__ __forceinline__ float wscan_max_down(float v, int lane) {
#pragma unroll
    for (int o = 1; o < 64; o <<= 1) { const float t = __shfl_down(v, o); if (lane + o < 64) v = fmaxf(v, t); }
    return v; }
__device__ __forceinline__ float wave_max(float v) {
#pragma unroll
    for (int o = 1; o < 64; o <<= 1) v = fmaxf(v, __shfl_xor(v, o));
    return v; }

__device__ __forceinline__ void m1_phase(Frame& F, int l) {
    LAS unsigned char* HALO = F.lds;
    LAS unsigned char* XM = HALO + 64 * RS;
    LAS unsigned char* CV = F.lds + 2 * TILE_B;
    LAS unsigned char* VT = F.lds + 3 * TILE_B;
#define KT_ROW(dk_) (HALO + ((dk_) + (((dk_) & 64) << 1)) * RS)
    LAS float* FL = (LAS float*)(F.lds + 4 * TILE_B);
    const bf16* UXM = WSP(bf16, WS_Y) + (size_t)TT * 512;
    const float* GT = WSP(float, WS_GT);
    bf16* Qg = WSP(bf16, WS_Q); bf16* Kg = WSP(bf16, WS_K); bf16* VTg = WSP(bf16, WS_VT); bf16* CLg = WSP(bf16, WS_CL);
    float* GA = WSP(float, WS_GA); float* NL = WSP(float, WS_NL); float* SC = WSP(float, WS_SC);
    const bf16* WQ = WSP(bf16, WS_WQKV) + (size_t)l * 12 * HD * HD;
    const int wv = F.wave;
    const float* const p_conv_w = FIN(I_CONVW); const float* const p_conv_b = FIN(I_CONVB); const float* const p_gate_b = FIN(I_GATEB);
    bf16x8 wq[4], wk[4], wvv[4]; int cur_h = -1;
    v4u hpre[8];
#define M1_HALO_ISSUE(uid_) do { const int u_ = (uid_), cg_ = u_ >> 2, h_ = u_ & 3; const bool isc_ = cg_ >= 256; const int r0_ = cg_ * 128; \
        const int seq0_ = isc_ ? (TL + ((cg_ - 256) >> 1) * 256) : ((cg_ >> 6) * SEQ); const int s0_ = r0_ - seq0_, L_ = isc_ ? CTXL : SEQ; \
        _Pragma("unroll") for (int it = 0; it < 8; ++it) { const int ch = tid_i + NTHR * it, row = ch >> 4, c16 = ch & 15; const int s_ = s0_ - 64 + row; const bool ok_ = (unsigned)s_ < (unsigned)L_; \
            asm volatile("global_load_dwordx4 %0, %1, off" : "=v"(hpre[it]) : "v"(UXM + (size_t)(seq0_ + (ok_ ? s_ : s0_)) * 512 + h_ * 128 + 8 * c16) : "memory"); } } while (0)
    bool first_unit = true;
    if (F.vcu < NUID) { const int tid_i = F.tid; M1_HALO_ISSUE(F.vcu); }
    for (int uid = F.vcu; uid < NUID; uid += F.G) {
        int tid = F.tid; asm volatile("" : "+v"(tid));
        const int lane = tid & 63, li = lane & 15, g = lane >> 4;
        const int cg = uid >> 2, h = uid & 3;
        const bool isc = cg >= 256;
        const int r0 = cg * 128;
        const int seq0 = isc ? (TL + ((cg - 256) >> 1) * 256) : ((cg >> 6) * SEQ);
        const int s0 = r0 - seq0;
        if (h != cur_h) { cur_h = h;
            lds_barrier();
            for (int i = tid; i < 1280; i += NTHR) { const int tap = i >> 7, ch = i & 127;
                FL[256 + i] = (tap < 9) ? p_conv_w[((size_t)l * 9 + tap) * 512 + h * 128 + ch] : p_conv_b[l * 512 + h * 128 + ch]; }
#pragma unroll
            for (int ks = 0; ks < 4; ++ks) { const int off = (16 * wv + li) * HD + 32 * ks + 8 * g;
                wq[ks] = glb_frag(WQ + (size_t)(0 * 4 + h) * HD * HD + off); wk[ks] = glb_frag(WQ + (size_t)(1 * 4 + h) * HD * HD + off); wvv[ks] = glb_frag(WQ + (size_t)(2 * 4 + h) * HD * HD + off); }
            VM_DONE();
            lds_barrier(); }
        float gpv[4];
        if (wv < 2) { const float* gp0 = GT + (size_t)(r0 + 2 * lane) * 16 + 8 * wv + h;
            gpv[0] = gp0[0]; gpv[1] = gp0[16]; gpv[2] = gp0[4]; gpv[3] = gp0[20]; }
        REP(16) {
        { const int L = isc ? CTXL : SEQ; unsigned mall;
          if (first_unit) asm volatile("s_waitcnt vmcnt(0)\n\ts_mov_b32 %0, -1" : "=s"(mall) :: "memory"); else asm volatile("s_waitcnt vmcnt(32)\n\ts_mov_b32 %0, -1" : "=s"(mall) :: "memory");
          first_unit = false;
#pragma unroll
          for (int it = 0; it < 8; ++it) { const int ch = tid + NTHR * it, row = ch >> 4, c16 = ch & 15; const int s = s0 - 64 + row; const unsigned m_ = ((unsigned)s < (unsigned)L) ? mall : 0u;
              *(LAS v4u*)(HALO + row * RS + 16 * c16) = (v4u){hpre[it].x & m_, hpre[it].y & m_, hpre[it].z & m_, hpre[it].w & m_}; } }
        lds_barrier();
        { const int cb = tid & 15, tg = tid >> 4;
          f32x2 ac[4][4];
          const f32x4 b0 = *(const LAS f32x4*)(FL + 256 + 9 * 128 + 8 * cb), b1 = *(const LAS f32x4*)(FL + 256 + 9 * 128 + 8 * cb + 4);
          const f32x2 bias[4] = {(f32x2){b0[0], b0[1]}, (f32x2){b0[2], b0[3]}, (f32x2){b1[0], b1[1]}, (f32x2){b1[2], b1[3]}};
          const bool zl = !isc && (tg & 15) == 0, zr = !isc && (tg & 15) == 15;
          const LAS unsigned char* hb = HALO + (63 + 4 * tg) * RS + 16 * cb; const int o0 = zl ? RS : 0, o5 = zr ? 4 * RS : 5 * RS;
#pragma unroll
          for (int dy = -1; dy <= 1; ++dy) {
              if (isc && dy != 0) continue;
              f32x2 xr[6][4];
#pragma unroll
              for (int j = 0; j < 6; ++j) {
                  v4u x = *(const LAS v4u*)(hb + 64 * dy * RS + (j == 0 ? o0 : (j == 5 ? o5 : j * RS)));
                  if ((j == 0 && zl) || (j == 5 && zr)) x = (v4u){0u, 0u, 0u, 0u};
                  xr[j][0] = (f32x2){__builtin_bit_cast(float, x.x << 16), __builtin_bit_cast(float, x.x & 0xffff0000u)}; xr[j][1] = (f32x2){__builtin_bit_cast(float, x.y << 16), __builtin_bit_cast(float, x.y & 0xffff0000u)};
                  xr[j][2] = (f32x2){__builtin_bit_cast(float, x.z << 16), __builtin_bit_cast(float, x.z & 0xffff0000u)}; xr[j][3] = (f32x2){__builtin_bit_cast(float, x.w << 16), __builtin_bit_cast(float, x.w & 0xffff0000u)}; }
#pragma unroll
              for (int dx = -1; dx <= 1; ++dx) { const int tap = (dy + 1) * 3 + dx + 1;
                  const f32x4 w0 = *(const LAS f32x4*)(FL + 256 + tap * 128 + 8 * cb), w1 = *(const LAS f32x4*)(FL + 256 + tap * 128 + 8 * cb + 4);
                  const f32x2 wp[4] = {(f32x2){w0[0], w0[1]}, (f32x2){w0[2], w0[3]}, (f32x2){w1[0], w1[1]}, (f32x2){w1[2], w1[3]}};
#pragma unroll
                  for (int i = 0; i < 4; ++i)
#pragma unroll
                      for (int c = 0; c < 4; ++c) ac[i][c] = wp[c] * xr[i + dx + 1][c] + ((tap == (isc ? 3 : 0)) ? bias[c] : ac[i][c]); } }
#pragma unroll
          for (int i = 0; i < 4; ++i) { float a[8] = {ac[i][0][0], ac[i][0][1], ac[i][1][0], ac[i][1][1], ac[i][2][0], ac[i][2][1], ac[i][3][0], ac[i][3][1]};
#pragma unroll
              for (int j = 0; j < 8; ++j) { a[j] = a[j] * pg8::fast_sigmoid(a[j]); DBG_CHK(a[j], 1); }
              v4u o; o.x = pk2(a[0], a[1]); o.y = pk2(a[2], a[3]); o.z = pk2(a[4], a[5]); o.w = pk2(a[6], a[7]);
              *(LAS v4u*)(CV + (4 * tg + i) * RS + 16 * cb) = o; } }
        }
        REP(17) if (wv < 2) { const float* gb = p_gate_b + l * 16 + 8 * wv;
            const float i0 = gpv[0] + gb[h], i1 = gpv[1] + gb[h], l0 = logsigf(gpv[2] + gb[4 + h]), l1 = logsigf(gpv[3] + gb[4 + h]);
            DBG_CHK(i0 + i1 + l0 + l1, 0);
            const float ps = dscan_add(l0 + l1), bt = lane63(ps);
            float b0, b1;
            if (wv == 0) { b1 = ps; b0 = ps - l1; }
            else { const float sf = bt - ps + (l0 + l1); b0 = sf; b1 = sf - l0; }
            const float a0 = bt - b0 + i0, a1 = bt - b1 + i1;
            const float mx = lane63(dscan_max(fmaxf(a0, a1)));
            FL[128 * wv + 2 * lane] = __expf(a0 - mx); FL[128 * wv + 2 * lane + 1] = __expf(a1 - mx);
            *(f32x2*)(GA + ((size_t)(r0 + 2 * lane) * 4 + h) * 4 + 2 * wv) = (f32x2){b0, i0 - b0};
            *(f32x2*)(GA + ((size_t)(r0 + 2 * lane + 1) * 4 + h) * 4 + 2 * wv) = (f32x2){b1, i1 - b1};
            if (lane == 0) { SC[(0 * 2 + wv) * NUID + uid] = mx; SC[(1 * 2 + wv) * NUID + uid] = bt; } }
        lds_barrier();
        if (uid + F.G < NUID) { const int tid_i = tid; M1_HALO_ISSUE(uid + F.G); }
        REP(18) { bf16x8 fcv[2][4], fxm[2][4];
#pragma unroll
        for (int ks = 0; ks < 4; ++ks) { fcv[0][ks] = lds_frag(CV + li * RS + (32 * ks + 8 * g) * 2); fxm[0][ks] = lds_frag(XM + li * RS + (32 * ks + 8 * g) * 2); }
#pragma unroll
        for (int n = 0; n < 8; ++n) {
            bf16x8 (&cvf)[4] = fcv[n & 1]; bf16x8 (&xmf)[4] = fxm[n & 1];
            if (n + 1 < 8) {
#pragma unroll
                for (int ks = 0; ks < 4; ++ks) { fcv[(n + 1) & 1][ks] = lds_frag(CV + (16 * (n + 1) + li) * RS + (32 * ks + 8 * g) * 2); fxm[(n + 1) & 1][ks] = lds_frag(XM + (16 * (n + 1) + li) * RS + (32 * ks + 8 * g) * 2); } }
            __builtin_amdgcn_sched_barrier(0);
            f32x4 aq = {0.f, 0.f, 0.f, 0.f}, ak = aq, akt = aq, avt = aq;
            __builtin_amdgcn_s_setprio(1);
#pragma unroll
            for (int ks = 0; ks < 4; ++ks) { aq = mfma16(wq[ks], cvf[ks], aq); ak = mfma16(wk[ks], cvf[ks], ak); akt = mfma16(cvf[ks], wk[ks], akt); avt = mfma16(xmf[ks], wvv[ks], avt); }
            __builtin_amdgcn_s_setprio(0);
            DBG_CHK(aq[0] + aq[1] + aq[2] + aq[3] + ak[0] + ak[1] + ak[2] + ak[3] + akt[0] + akt[1] + akt[2] + akt[3] + avt[0] + avt[1] + avt[2] + avt[3], 2);
            st4bf(Qg + (size_t)(r0 + 16 * n + li) * 512 + h * 128 + 16 * wv + 4 * g, aq);
            st4bf(Kg + (size_t)(r0 + 16 * n + li) * 512 + h * 128 + 16 * wv + 4 * g, ak);
            st4bf_lds(KT_ROW(16 * wv + li) + (16 * n + 4 * g) * 2, akt);
            st4bf_lds(VT + (16 * wv + li) * RS + (16 * n + 4 * g) * 2, avt);
        } }
        lds_barrier();
        REP(19) {
#pragma unroll
            for (int it = 0; it < 4; ++it) { const int ch = tid + NTHR * it, row = ch >> 4, c16 = ch & 15; *(v4u*)(VTg + (size_t)uid * 16384 + row * 128 + 8 * c16) = *(const LAS v4u*)(VT + row * RS + 16 * c16); }
            bf16x8 vf[4], vb[4];
#pragma unroll
            for (int ks = 0; ks < 4; ++ks) { const bf16x8 v = lds_frag(VT + (16 * wv + li) * RS + (32 * ks + 8 * g) * 2);
                float x[8];
#pragma unroll
                for (int e = 0; e < 8; ++e) x[e] = bf2f((unsigned short)v[e]);
                v4u a, b; const LAS float* wf = FL + 32 * ks + 8 * g; const LAS float* wb = FL + 128 + 32 * ks + 8 * g;
                a.x = pk2(x[0] * wf[0], x[1] * wf[1]); a.y = pk2(x[2] * wf[2], x[3] * wf[3]); a.z = pk2(x[4] * wf[4], x[5] * wf[5]); a.w = pk2(x[6] * wf[6], x[7] * wf[7]);
                b.x = pk2(x[0] * wb[0], x[1] * wb[1]); b.y = pk2(x[2] * wb[2], x[3] * wb[3]); b.z = pk2(x[4] * wb[4], x[5] * wb[5]); b.w = pk2(x[6] * wb[6], x[7] * wb[7]);
                vf[ks] = __builtin_bit_cast(bf16x8, a); vb[ks] = __builtin_bit_cast(bf16x8, b); }
            bf16x8 fkt[2][4];
#pragma unroll
            for (int ks = 0; ks < 4; ++ks) fkt[0][ks] = lds_frag(KT_ROW(li) + (32 * ks + 8 * g) * 2);
#pragma unroll
            for (int n = 0; n < 8; ++n) {
                if (n + 1 < 8) {
#pragma unroll
                    for (int ks = 0; ks < 4; ++ks) fkt[(n + 1) & 1][ks] = lds_frag(KT_ROW(16 * (n + 1) + li) + (32 * ks + 8 * g) * 2); }
                __builtin_amdgcn_sched_barrier(0);
                f32x4 af = {0.f, 0.f, 0.f, 0.f}, ab = af;
                __builtin_amdgcn_s_setprio(1);
#pragma unroll
                for (int ks = 0; ks < 4; ++ks) { const bf16x8 kt = fkt[n & 1][ks]; af = mfma16(kt, vf[ks], af); ab = mfma16(kt, vb[ks], ab); }
                __builtin_amdgcn_s_setprio(0);
                DBG_CHK(af[0] + af[1] + af[2] + af[3] + ab[0] + ab[1] + ab[2] + ab[3], 3);
                st4bf(CLg + ((size_t)0 * NUID + uid) * 16384 + (16 * wv + li) * 128 + 16 * n + 4 * g, af);
                st4bf(CLg + ((size_t)1 * NUID + uid) * 16384 + (16 * wv + li) * 128 + 16 * n + 4 * g, ab);
            }
            { const int dir = tid >> 8, dk = (tid >> 1) & 127, hf = tid & 1; float sacc = 0.f; const LAS float* w = FL + 128 * dir + 64 * hf;
#pragma unroll 4
                for (int t8 = 0; t8 < 8; ++t8) { const bf16x8 kk = lds_frag(KT_ROW(dk) + 128 * hf + 16 * t8);
#pragma unroll
                    for (int e = 0; e < 8; ++e) sacc += w[8 * t8 + e] * bf2f((unsigned short)kk[e]); }
                sacc += dpp_f<0xB1, 0xf>(0.f, sacc);
                if (hf == 0) NL[((size_t)dir * NUID + uid) * 128 + dk] = sacc; }
        }
        lds_barrier();
    }
}

#undef KT_ROW
#undef M1_HALO_ISSUE
__device__ __forceinline__ int m2_cg(int step, int b, int dir) { return (step < 2) ? (256 + 2 * b + (dir ? 1 - step : step)) : (64 * b + (dir ? 63 - (step - 2) : (step - 2))); }
__device__ __forceinline__ void m2_phase(Frame& F, bool dry = false) {
    bf16* CLg = WSP(bf16, WS_CL); float* NL = WSP(float, WS_NL); float* SC = WSP(float, WS_SC);
    const int gid = F.vcu * NTHR + F.tid;
    const int nthreads = F.G * NTHR;
    constexpr int PF = 11, NSTEP = 66;
    for (int item = gid; item < 32 * 4096; item += nthreads) {
        const int chain = __builtin_amdgcn_readfirstlane(item >> 12), e4 = item & 4095;
        const int dir = chain & 1, h = (chain >> 1) & 3, b = chain >> 3;
        float zero_ = 0.f; asm volatile("" : "+v"(zero_));
        float C0 = zero_, C1 = zero_, C2 = zero_, C3 = zero_, m = zero_;
        f32x4 nvec = {zero_, zero_, zero_, zero_};
        const bool do_n = e4 < 32; const int en = do_n ? e4 : 0;
        v2u w[PF]; float ml[PF], bt[PF]; f32x4 nl[PF];
#pragma unroll
        for (int p = 0; p < PF; ++p) { const int uid = m2_cg(p, b, dir) * 4 + h;
            w[p] = *(const v2u*)(CLg + ((size_t)dir * NUID + uid) * 16384 + 4 * e4); ml[p] = SC[(0 * 2 + dir) * NUID + uid]; bt[p] = SC[(1 * 2 + dir) * NUID + uid];
            nl[p] = *(const f32x4*)(NL + ((size_t)dir * NUID + uid) * 128 + 4 * en); }
#pragma unroll
        for (int s0 = 0; s0 < NSTEP; s0 += PF) {
#pragma unroll
            for (int p = 0; p < PF; ++p) { const int step = s0 + p; const int uid = m2_cg(step, b, dir) * 4 + h;
                bf16* cp = CLg + ((size_t)dir * NUID + uid) * 16384 + 4 * e4;
                const v2u wc = w[p]; const float mlc = ml[p], btc = bt[p]; const f32x4 nlc = nl[p];
                if (!dry) { v2u o; o.x = pk2(C0, C1); o.y = pk2(C2, C3); *(v2u*)cp = o; } else asm volatile("" :: "v"(C0), "v"(C1), "v"(C2), "v"(C3), "v"(m), "v"(nvec[0]));
                if (do_n && !dry) *(f32x4*)(NL + ((size_t)dir * NUID + uid) * 128 + 4 * e4) = nvec;
                if (e4 == 0 && !dry) SC[(2 * 2 + dir) * NUID + uid] = m;
                { const int uid2 = m2_cg((step + PF < NSTEP) ? step + PF : NSTEP - 1, b, dir) * 4 + h;
                    w[p] = *(const v2u*)(CLg + ((size_t)dir * NUID + uid2) * 16384 + 4 * e4); ml[p] = SC[(0 * 2 + dir) * NUID + uid2]; bt[p] = SC[(1 * 2 + dir) * NUID + uid2];
                    nl[p] = *(const f32x4*)(NL + ((size_t)dir * NUID + uid2) * 128 + 4 * en); }
                const float mn = fmaxf(btc + m, mlc), dec = __expf(btc + m - mn), inj = __expf(mlc - mn);
                C0 = dec * C0 + inj * bf2f(wc.x & 0xffffu); C1 = dec * C1 + inj * bf2f(wc.x >> 16); C2 = dec * C2 + inj * bf2f(wc.y & 0xffffu); C3 = dec * C3 + inj * bf2f(wc.y >> 16);
                nvec = nvec * dec + nlc * inj; m = mn; DBG_CHK(C0 + C1 + C2 + C3 + m + nvec[0] + nvec[1] + nvec[2] + nvec[3], 5);
            }
        }
    }
}

__device__ __forceinline__ void m3_phase(Frame& F, int l, int ncg, bool dry = false) {
    LAS unsigned char* KS = F.lds;
    LAS unsigned char* VT = F.lds + TILE_B;
    LAS unsigned char* CF = F.lds + 2 * TILE_B;
    LAS unsigned char* CB = F.lds + 3 * TILE_B;
    LAS float* FL = (LAS float*)(F.lds + 4 * TILE_B);
    const bf16* Qg = WSP(bf16, WS_Q); const bf16* Kg = WSP(bf16, WS_K); const bf16* VTg = WSP(bf16, WS_VT); const bf16* CLg = WSP(bf16, WS_CL);
    const float* GA = WSP(float, WS_GA); const float* NL = WSP(float, WS_NL); const float* SC = WSP(float, WS_SC);
    bf16* A4 = WSP(bf16, WS_A4);
    const int wv = F.wave;
    v4u pk_[4], pv_[4], pf_[4], pb_[4];
#define M3_LOAD(uid_) do { const int u_ = (uid_), cg_ = u_ >> 2, h_ = u_ & 3, rr_ = cg_ * 128; _Pragma("unroll") for (int it = 0; it < 4; ++it) { const int ch = tid0 + NTHR * it, row = ch >> 4, c16 = ch & 15; \
        pk_[it] = __builtin_nontemporal_load((const v4u*)(Kg + (size_t)(rr_ + row) * 512 + h_ * 128 + 8 * c16)); \
        pf_[it] = __builtin_nontemporal_load((const v4u*)(CLg + ((size_t)0 * NUID + u_) * 16384 + row * 128 + 8 * c16)); } } while (0)
#define M3_STORE() do { _Pragma("unroll") for (int it = 0; it < 4; ++it) { const int ch = tid0 + NTHR * it, row = ch >> 4, c16 = ch & 15; \
        *(LAS v4u*)(KS + row * RS + 16 * c16) = pk_[it]; *(LAS v4u*)(CF + row * RS + 16 * c16) = pf_[it]; } } while (0)
    f32x4 psm4; float psm1; bool m3_first = true;
#define M3_SMALL_ISSUE(uid_) do { const int u_ = (uid_), r0_ = (u_ >> 2) * 128, h_ = u_ & 3; \
        const float* p4_ = (tid0 < 128) ? GA + ((size_t)(r0_ + tid0) * 4 + h_) * 4 : FIN(I_HNW) + l * 512 + h_ * 128 + 4 * ((tid0 - 128) & 31); \
        const int e1_ = tid0 - 160; const float* p1_ = ((unsigned)e1_ < 256u) ? NL + ((size_t)(e1_ >> 7) * NUID + u_) * 128 + (e1_ & 127) : SC + (2 * 2 + (tid0 & 1)) * NUID + u_; \
        asm volatile("global_load_dwordx4 %0, %1, off" : "=v"(psm4) : "v"(p4_) : "memory"); asm volatile("global_load_dword %0, %1, off" : "=v"(psm1) : "v"(p1_) : "memory"); } while (0)
    { const int tid0 = F.tid; if (F.vcu < ncg * 4) { M3_SMALL_ISSUE(F.vcu); M3_LOAD(F.vcu); M3_STORE(); } }
    for (int uid = F.vcu; uid < ncg * 4; uid += F.G) {
        int tid = F.tid; asm volatile("" : "+v"(tid));
        const int lane = tid & 63, li = lane & 15, g = lane >> 4; const int tid0 = tid;
        const int cg = uid >> 2, h = uid & 3, r0 = cg * 128;
        const bool more = uid + F.G < ncg * 4;
        const int t = 16 * wv + li;
        if (m3_first) asm volatile("s_waitcnt vmcnt(0)" :: "v"(psm4), "v"(psm1) : "memory"); else asm volatile("s_waitcnt vmcnt(16)" :: "v"(psm4), "v"(psm1) : "memory");
        m3_first = false;
        if (tid < 128) *(LAS f32x4*)(FL + 4 * tid) = psm4; else if (tid < 160) *(LAS f32x4*)(FL + 1040 + 4 * (tid - 128)) = psm4;
        if ((unsigned)(tid - 160) < 256u) FL[512 + (tid - 160)] = psm1; else if ((unsigned)(tid - 416) < 2u) FL[1024 + (tid - 416)] = psm1;
        bf16x8 qf[4];
#pragma unroll
        for (int ks = 0; ks < 4; ++ks) qf[ks] = glb_frag(Qg + (size_t)(r0 + t) * 512 + h * 128 + 32 * ks + 8 * g);
#pragma unroll
        for (int it = 0; it < 4; ++it) { const int ch = tid + NTHR * it; pv_[it] = __builtin_nontemporal_load((const v4u*)(VTg + (size_t)uid * 16384 + (ch >> 4) * 128 + 8 * (ch & 15))); pb_[it] = __builtin_nontemporal_load((const v4u*)(CLg + ((size_t)1 * NUID + uid) * 16384 + (ch >> 4) * 128 + 8 * (ch & 15))); }
        lds_barrier();
        if (wv == 0) { const float u0 = FL[4 * (2 * lane) + 1], u1 = FL[4 * (2 * lane + 1) + 1];
            const float pm = dscan_max(fmaxf(u0, u1)), excl = dpp_f<0x138, 0xf>(-3.0e38f, pm), mp = FL[1024];
            FL[768 + 2 * lane] = fmaxf(mp, fmaxf(excl, u0)); FL[768 + 2 * lane + 1] = fmaxf(mp, pm); }
        else if (wv == 1) { const float u0 = FL[4 * (2 * lane) + 3], u1 = FL[4 * (2 * lane + 1) + 3];
            const float rv = __shfl(fmaxf(u0, u1), 63 - lane), rs = dscan_max(rv), rx = dpp_f<0x138, 0xf>(-3.0e38f, rs);
            const float sm = __shfl(rs, 63 - lane), excl = __shfl(rx, 63 - lane), mp = FL[1025];
            FL[896 + 2 * lane + 1] = fmaxf(mp, fmaxf(excl, u1)); FL[896 + 2 * lane] = fmaxf(mp, sm); }
        lds_barrier();
        M3_LOAD(more ? uid + F.G : uid); if (more) M3_SMALL_ISSUE(uid + F.G);
        REP(21) {
            const bool dry_ = dry || (rep_ == 0 && ((DUPMASK >> 21) & 1));
            bf16x8 sfr[4], sbr[4];
            const float Mf = FL[768 + t], Mb = FL[896 + t], mpf = FL[1024], mpb = FL[1025];
            float rsf = 0.f, rsb = 0.f; const int d = wv >> 1;
#pragma unroll
            for (int kp = 0; kp < 4; ++kp) { f32x4 a0 = {0.f, 0.f, 0.f, 0.f}, a1 = a0;
                __builtin_amdgcn_s_setprio(1);
#pragma unroll
                for (int ks = 0; ks < 4; ++ks) { a0 = mfma16(lds_frag(KS + (32 * kp + li) * RS + (32 * ks + 8 * g) * 2), qf[ks], a0); a1 = mfma16(lds_frag(KS + (32 * kp + 16 + li) * RS + (32 * ks + 8 * g) * 2), qf[ks], a1); }
                __builtin_amdgcn_s_setprio(0);
                DBG_CHK(a0[0] + a0[1] + a0[2] + a0[3] + a1[0] + a1[1] + a1[2] + a1[3], 7);
                __builtin_amdgcn_sched_barrier(0);
                float pf_[8], pb_[8];
                if (kp < d) {
#pragma unroll
                    for (int e = 0; e < 8; ++e) { const int s = 32 * kp + 16 * (e >> 2) + 4 * g + (e & 3); const float a = (e < 4) ? a0[e & 3] : a1[e & 3];
                        pf_[e] = a * __expf(FL[4 * s + 1] - Mf); pb_[e] = 0.f; rsf += pf_[e]; }
                } else if (kp > d) {
#pragma unroll
                    for (int e = 0; e < 8; ++e) { const int s = 32 * kp + 16 * (e >> 2) + 4 * g + (e & 3); const float a = (e < 4) ? a0[e & 3] : a1[e & 3];
                        pb_[e] = a * __expf(FL[4 * s + 3] - Mb); pf_[e] = 0.f; rsb += pb_[e]; }
                } else {
#pragma unroll
                    for (int e = 0; e < 8; ++e) { const int s = 32 * kp + 16 * (e >> 2) + 4 * g + (e & 3); const float a = (e < 4) ? a0[e & 3] : a1[e & 3]; const float uf = FL[4 * s + 1], ub = FL[4 * s + 3];
                        const int dts = t - s; const float pen_f = (float)min(dts, 0) * 1.0e30f, pen_b = (float)min(-dts, 0) * 1.0e30f;
                        const float wf = __expf(uf - Mf + pen_f), wb = __expf(ub - Mb + pen_b);
                        pf_[e] = a * wf; pb_[e] = a * wb; rsf += pf_[e]; rsb += pb_[e]; }
                }
                v4u wa, wb4; wa.x = pk2(pf_[0], pf_[1]); wa.y = pk2(pf_[2], pf_[3]); wa.z = pk2(pf_[4], pf_[5]); wa.w = pk2(pf_[6], pf_[7]);
                wb4.x = pk2(pb_[0], pb_[1]); wb4.y = pk2(pb_[2], pb_[3]); wb4.z = pk2(pb_[4], pb_[5]); wb4.w = pk2(pb_[6], pb_[7]);
                sfr[kp] = __builtin_bit_cast(bf16x8, wa); sbr[kp] = __builtin_bit_cast(bf16x8, wb4);
                __builtin_amdgcn_sched_barrier(0); }
            rsf += __shfl_xor(rsf, 16); rsf += __shfl_xor(rsf, 32); rsb += __shfl_xor(rsb, 16); rsb += __shfl_xor(rsb, 32);
            float qnf = 0.f, qnb = 0.f;
#pragma unroll
            for (int ks = 0; ks < 4; ++ks)
#pragma unroll
                for (int e = 0; e < 8; ++e) { const float qv = bf2f((unsigned short)qf[ks][e]); const int d = 32 * ks + 8 * g + e; qnf += qv * FL[512 + d]; qnb += qv * FL[640 + d]; }
            qnf += __shfl_xor(qnf, 16); qnf += __shfl_xor(qnf, 32); qnb += __shfl_xor(qnb, 16); qnb += __shfl_xor(qnb, 32);
            const f32x4 gat = *(const LAS f32x4*)(FL + 4 * t);
            const float wif = __expf(mpf - Mf), wib = __expf(mpb - Mb);
            const float denf = rsf + wif * qnf, denb = rsb + wib * qnb;
            const float rf = __builtin_amdgcn_rcpf(fmaxf(fabsf(denf), __expf(-(gat[0] + Mf)))), rb = __builtin_amdgcn_rcpf(fmaxf(fabsf(denb), __expf(-(gat[2] + Mb))));
            const float alf = rf * wif, alb = rb * wib; DBG_CHK(rf + rb + alf + alb, 8);
            if (rep_ == 0) {
#pragma unroll
                for (int it = 0; it < 4; ++it) { const int ch = tid + NTHR * it; *(LAS v4u*)(VT + (ch >> 4) * RS + 16 * (ch & 15)) = pv_[it]; *(LAS v4u*)(CB + (ch >> 4) * RS + 16 * (ch & 15)) = pb_[it]; } }
            lds_barrier();
            f32x4 o[8]; float sum = 0.f;
#pragma unroll
            for (int n = 0; n < 8; ++n) { f32x4 apf = {0.f, 0.f, 0.f, 0.f}, apb = apf, acf = apf, acb = apf;
                __builtin_amdgcn_s_setprio(1);
#pragma unroll
                for (int kp = 0; kp < 4; ++kp) { const v2u lo = *(const LAS v2u*)(VT + (16 * n + li) * RS + (32 * kp + 4 * g) * 2), hi = *(const LAS v2u*)(VT + (16 * n + li) * RS + (32 * kp + 16 + 4 * g) * 2);
                    const v4u vv = {lo.x, lo.y, hi.x, hi.y}; const bf16x8 vfr = __builtin_bit_cast(bf16x8, vv); if (kp <= d) apf = mfma16(vfr, sfr[kp], apf); if (kp >= d) apb = mfma16(vfr, sbr[kp], apb); }
#pragma unroll
                for (int ks = 0; ks < 4; ++ks) { acf = mfma16(lds_frag(CF + (16 * n + li) * RS + (32 * ks + 8 * g) * 2), qf[ks], acf); acb = mfma16(lds_frag(CB + (16 * n + li) * RS + (32 * ks + 8 * g) * 2), qf[ks], acb); }
                __builtin_amdgcn_s_setprio(0);
                const f32x4 a = apf * rf + apb * rb + acf * alf + acb * alb;
                o[n] = a; sum += (a[0] + a[1]) + (a[2] + a[3]);
                __builtin_amdgcn_sched_barrier(0); }
            DBG_CHK(sum, 9);
            bf16* zrow = A4 + (size_t)(r0 + t) * 1024 + 512 + h * 128;
            v2u zz[8];
#pragma unroll
            for (int n = 0; n < 8; ++n) zz[n] = *(const v2u*)(zrow + 16 * n + 4 * g);
            sum += __shfl_xor(sum, 16); sum += __shfl_xor(sum, 32);
            const float mu = sum * (1.f / 128.f); float var = 0.f;
#pragma unroll
            for (int n = 0; n < 8; ++n) { o[n] = o[n] - mu; var += (o[n][0] * o[n][0] + o[n][1] * o[n][1]) + (o[n][2] * o[n][2] + o[n][3] * o[n][3]); }
            var += __shfl_xor(var, 16); var += __shfl_xor(var, 32);
            const float rstd = __builtin_amdgcn_rsqf(var * (1.f / 128.f) + EPSN);
#pragma unroll
            for (int n = 0; n < 8; ++n) { const int dv = 16 * n + 4 * g; const f32x4 w4 = *(const LAS f32x4*)(FL + 1040 + dv);
                f32x4 y; y[0] = o[n][0] * rstd * w4[0] * pg8::fast_sigmoid(bf2f(zz[n].x & 0xffffu)); y[1] = o[n][1] * rstd * w4[1] * pg8::fast_sigmoid(bf2f(zz[n].x >> 16));
                y[2] = o[n][2] * rstd * w4[2] * pg8::fast_sigmoid(bf2f(zz[n].y & 0xffffu)); y[3] = o[n][3] * rstd * w4[3] * pg8::fast_sigmoid(bf2f(zz[n].y >> 16));
                DBG_CHK(y[0] + y[1] + y[2] + y[3], 10); if (!dry_) st4bf(zrow + dv, y); else asm volatile("" :: "v"(y[0]), "v"(y[1]), "v"(y[2]), "v"(y[3])); }
        }
        lds_barrier();
        M3_STORE();
        lds_barrier();
    }
#undef M3_LOAD
#undef M3_SMALL_ISSUE
#undef M3_STORE
}
constexpr int FRS = 288;
__device__ __forceinline__ s16x4 tr_read(const LAS unsigned char* p) { typedef short v4i16_t __attribute__((ext_vector_type(4))); return __builtin_bit_cast(s16x4, __builtin_amdgcn_ds_read_tr16_b64_v4i16((LAS v4i16_t*)p)); }
__device__ __forceinline__ bf16x8 dft_frag(const LAS unsigned char* tile, int t, int nt, int lane) {
    const int g = lane >> 4, q = (lane & 15) >> 2, p = lane & 3;
    const LAS unsigned char* a = tile + (32 * t + 16 * (g >> 1) + 4 * (g & 1) + q) * FRS + (16 * nt + 4 * p) * 2;
    const s16x4 lo = tr_read(a), hi = tr_read(a + 8 * FRS);
    bf16x8 r; r[0] = lo[0]; r[1] = lo[1]; r[2] = lo[2]; r[3] = lo[3]; r[4] = hi[0]; r[5] = hi[1]; r[6] = hi[2]; r[7] = hi[3]; return r;
}
__device__ __forceinline__ const bf16* f1_src(const bf16* UXF, int u, int ch) { const int cb = u & 3, s2 = (u >> 2) & 63, b = u >> 8, row = ch >> 4, c16 = ch & 15; return UXF + (size_t)(b * SEQ + 64 * row + s2) * 512 + 128 * cb + 8 * c16; }
__device__ __forceinline__ void f1_phase(Frame& F) {
    const bf16* UXF = WSP(bf16, WS_Y); bf16* HS1 = (bf16*)FOUT;
    const bf16* W1 = (const bf16*)(F.ws + WS_TAB + TAB_W1); const f32x2* TW = (const f32x2*)(F.ws + WS_TAB + TAB_TW);
    const int lane0 = F.lane, wv = F.wave;
    const int kt = wv & 3, nh = wv >> 2;
    bf16x8 wre[4], wim[4], wre4[4], wim4[4];
#pragma unroll
    for (int t = 0; t < 4; ++t) { wre[t] = glb_frag(W1 + ((((size_t)kt * 2 + 0) * 4 + t) * 64 + lane0) * 8); wim[t] = glb_frag(W1 + ((((size_t)kt * 2 + 1) * 4 + t) * 64 + lane0) * 8);
        wre4[t] = glb_frag(W1 + ((((size_t)4 * 2 + 0) * 4 + t) * 64 + lane0) * 8); wim4[t] = glb_frag(W1 + ((((size_t)4 * 2 + 1) * 4 + t) * 64 + lane0) * 8); }
    int ub, un, us;
    if (F.G == 256) { us = 1; const int v = F.vcu; if (v < 32) { ub = 0; un = 0; } else { const int w = v - 32; if (w < 128) { ub = 5 * w; un = 5; } else { ub = 640 + 4 * (w - 128); un = 4; } } }
    else { ub = F.vcu; us = F.G; un = (NB * 64 * 4 - F.vcu + F.G - 1) / F.G; }
    constexpr int TB = 128 * FRS;
    f32x2 twn = {0.f, 0.f}, twn4 = twn;
    if (un > 0) { const int tid = F.tid;
#pragma unroll
        for (int it = 0; it < 4; ++it) { const int ch = tid + NTHR * it; *(LAS v4u*)(F.lds + (ch >> 4) * FRS + 16 * (ch & 15)) = *(const v4u*)f1_src(UXF, ub, ch); }
        twn = TW[(16 * kt + (lane0 & 15)) * 64 + ((ub >> 2) & 63)]; twn4 = TW[(64 + (lane0 & 15)) * 64 + ((ub >> 2) & 63)]; }
    VM_DONE();
    lds_barrier();
    for (int ui = 0; ui < un; ++ui) {
        const int u = ub + ui * us;
        int tid = F.tid; asm volatile("" : "+v"(tid)); const int lane = tid & 63, li = lane & 15, g = lane >> 4;
        const int cb = u & 3, s2 = (u >> 2) & 63, b = u >> 8;
        LAS unsigned char* tile = F.lds + (ui & 1) * TB; LAS unsigned char* ntile = F.lds + ((ui + 1) & 1) * TB;
        v4u pre[4]; const bool more = ui + 1 < un;
        const int k1 = 16 * kt + li; const f32x2 tw = twn, tw4 = twn4;
        if (more) {
#pragma unroll
            for (int it = 0; it < 4; ++it) pre[it] = *(const v4u*)f1_src(UXF, u + us, tid + NTHR * it);
            twn = TW[k1 * 64 + (((u + us) >> 2) & 63)]; twn4 = TW[(64 + li) * 64 + (((u + us) >> 2) & 63)]; }
        bf16* ore = HS1 + (size_t)(b * SEQ + 64 * k1 + s2) * 1024 + 128 * cb;
#pragma unroll
        for (int q = 0; q < 4; ++q) { const int nt = 4 * nh + q; f32x4 are = {0.f, 0.f, 0.f, 0.f}, aim = are;
#pragma unroll
            for (int t = 0; t < 4; ++t) { const bf16x8 d = dft_frag(tile, t, nt, lane); are = mfma16(d, wre[t], are); aim = mfma16(d, wim[t], aim); }
            DBG_CHK(are[0] + are[1] + are[2] + are[3] + aim[0] + aim[1] + aim[2] + aim[3], 4);
            st4bf(ore + 16 * nt + 4 * g, are * tw.x - aim * tw.y);
            st4bf(ore + 512 + 16 * nt + 4 * g, are * tw.y + aim * tw.x); }
        { const int nt = wv; f32x4 are = {0.f, 0.f, 0.f, 0.f}, aim = are;
#pragma unroll
            for (int t = 0; t < 4; ++t) { const bf16x8 d = dft_frag(tile, t, nt, lane); are = mfma16(d, wre4[t], are); aim = mfma16(d, wim4[t], aim); }
            bf16* o4 = HS1 + (size_t)(b * SEQ + 64 * 64 + s2) * 1024 + 128 * cb;
            if (li == 0) { st4bf(o4 + 16 * nt + 4 * g, are * tw4.x - aim * tw4.y); st4bf(o4 + 512 + 16 * nt + 4 * g, are * tw4.y + aim * tw4.x); } }
        if (more) {
#pragma unroll
            for (int it = 0; it < 4; ++it) { const int ch = tid + NTHR * it; *(LAS v4u*)(ntile + (ch >> 4) * FRS + 16 * (ch & 15)) = pre[it]; } }
        lds_barrier();
    }
}
__device__ __forceinline__ const bf16* f2_src(const bf16* HS1, int u, int ch) { const int cb = u & 3, k1 = (u >> 2) & 127, b = u >> 9, row = ch >> 4, c16 = ch & 15;
    return HS1 + (size_t)(b * SEQ + 64 * k1 + (row & 63)) * 1024 + (row >> 6) * 512 + 128 * cb + 8 * c16; }
__device__ __forceinline__ void f2_phase(Frame& F, int l) {
    const bf16* HS1 = (const bf16*)FOUT; bf16* A4 = WSP(bf16, WS_A4);
    const bf16* W2 = (const bf16*)(F.ws + WS_TAB + TAB_W2); const bf16* PQF = (const bf16*)(F.ws + WS_TAB + TAB_PQF) + (size_t)l * 8 * 8192;
    const int lane0 = F.lane, wv = F.wave, kq = wv & 3, grp = wv >> 2;
    bf16x8 w2r[4], w2i[4];
#pragma unroll
    for (int t = 0; t < 4; ++t) { w2r[t] = glb_frag(W2 + (((size_t)kq * 4 + t) * 64 + lane0) * 8); w2i[t] = glb_frag(W2 + (((size_t)(kq + 4) * 4 + t) * 64 + lane0) * 8); }
    constexpr int TB = 128 * FRS;
    constexpr int NQP = NB * 63 * 4, NU = NQP + NB * 2 * 4;
#define F2_OLD(q_) (((q_) < NQP) ? ((((q_) >> 2) / 63 * 128 + 1 + ((q_) >> 2) % 63) << 2) | ((q_) & 3) : ((((((q_) - NQP) >> 3) * 128 + ((((q_) - NQP) >> 2) & 1) * 64)) << 2) | ((q_) & 3))
    bf16x8 pqr[16]; int cur_gi = 2 * (F.vcu & 3) + grp;
    { const bf16* pq = PQF + (size_t)cur_gi * 8192 + lane0 * 8;
#pragma unroll
      for (int q = 0; q < 16; ++q) pqr[q] = glb_frag(pq + q * 512); }
    if (F.vcu < NU) { const int tid = F.tid;
#pragma unroll
        for (int it = 0; it < 4; ++it) { const int ch = tid + NTHR * it; *(LAS v4u*)(F.lds + (ch >> 4) * FRS + 16 * (ch & 15)) = *(const v4u*)f2_src(HS1, F2_OLD(F.vcu), ch); } }
    VM_DONE();
    v4u preA[4], preB[4];
#define PF_LOAD(dst_, ptr_) asm volatile("global_load_dwordx4 %0, %1, off" : "=v"(dst_) : "v"(ptr_) : "memory")
#define PF_WAIT(P_, younger4_) do { if (younger4_) asm volatile("s_waitcnt vmcnt(4)" :: "v"(P_[0]), "v"(P_[1]), "v"(P_[2]), "v"(P_[3]) : "memory"); \
        else asm volatile("s_waitcnt vmcnt(0)" :: "v"(P_[0]), "v"(P_[1]), "v"(P_[2]), "v"(P_[3]) : "memory"); } while (0)
    if (F.vcu + F.G < NU) { const int tid = F.tid;
#pragma unroll
        for (int it = 0; it < 4; ++it) PF_LOAD(preA[it], f2_src(HS1, F2_OLD(F.vcu + F.G), tid + NTHR * it)); }
    lds_barrier();
#define F2_BODY(TILE_, NTILE_, PL_, PW_) do { \
        int tid = F.tid; asm volatile("" : "+v"(tid)); const int lane = tid & 63, li = lane & 15, g = lane >> 4; \
        const int u = F2_OLD(q); const bool pair = q < NQP; \
        const int cb = u & 3, k1 = (u >> 2) & 127, b = u >> 9, gi = 2 * cb + grp; \
        LAS unsigned char* tile = (TILE_); LAS unsigned char* ntile = (NTILE_); \
        const bool more1 = q + F.G < NU, more2 = q + 2 * F.G < NU; \
        if (more2) { _Pragma("unroll") for (int it = 0; it < 4; ++it) PF_LOAD(PL_[it], f2_src(HS1, F2_OLD(q + 2 * F.G), tid + NTHR * it)); } \
        bf16x8 uf[4]; \
        _Pragma("unroll") for (int hp = 0; hp < 2; ++hp) { f32x4 r0 = {0.f, 0.f, 0.f, 0.f}, r1 = r0, i0 = r0, i1 = r0; \
            _Pragma("unroll") for (int t = 0; t < 4; ++t) { const bf16x8 d0 = dft_frag(tile, t, 4 * grp + 2 * hp, lane), d1 = dft_frag(tile, t, 4 * grp + 2 * hp + 1, lane); \
                r0 = mfma16(d0, w2r[t], r0); r1 = mfma16(d1, w2r[t], r1); i0 = mfma16(d0, w2i[t], i0); i1 = mfma16(d1, w2i[t], i1); } \
            DBG_CHK(r0[0] + r1[1] + i0[2] + i1[3], 6); \
            v4u wr_, wi_; wr_.x = pk2(r0[0], r0[1]); wr_.y = pk2(r0[2], r0[3]); wr_.z = pk2(r1[0], r1[1]); wr_.w = pk2(r1[2], r1[3]); \
            wi_.x = pk2(i0[0], i0[1]); wi_.y = pk2(i0[2], i0[3]); wi_.z = pk2(i1[0], i1[1]); wi_.w = pk2(i1[2], i1[3]); \
            uf[hp] = __builtin_bit_cast(bf16x8, wr_); uf[2 + hp] = __builtin_bit_cast(bf16x8, wi_); } \
        if (more1) { PF_WAIT(PW_, more2); \
            _Pragma("unroll") for (int it = 0; it < 4; ++it) { const int ch = tid + NTHR * it; *(LAS v4u*)(ntile + (ch >> 4) * FRS + 16 * (ch & 15)) = PW_[it]; } } \
        bf16* orow = A4 + (size_t)(b * SEQ + k1 + 128 * (16 * kq + li)) * 1024 + 64 * gi; \
        bf16* orow2 = A4 + (size_t)(b * SEQ + (128 - k1) + 128 * (63 - (16 * kq + li))) * 1024 + 64 * gi; \
        if (gi != cur_gi) { cur_gi = gi; const bf16* pq = PQF + (size_t)gi * 8192 + lane * 8; \
            _Pragma("unroll") for (int q = 0; q < 16; ++q) pqr[q] = glb_frag(pq + q * 512); \
            VM_DONE(); } \
        _Pragma("unroll") for (int nd = 0; nd < 4; ++nd) { f32x4 pa = {0.f, 0.f, 0.f, 0.f}, pb = pa;        \
            pa = mfma16(pqr[nd * 4 + 0], uf[0], pa); pb = mfma16(pqr[nd * 4 + 2], uf[2], pb); pa = mfma16(pqr[nd * 4 + 1], uf[1], pa); pb = mfma16(pqr[nd * 4 + 3], uf[3], pb); \
            st4bf(orow + 16 * nd + 4 * g, pa + pb); if (pair) st4bf(orow2 + 16 * nd + 4 * g, pa - pb); } \
        lds_barrier(); } while (0)
    for (int q = F.vcu; q < NU; q += F.G) {
        F2_BODY(F.lds, F.lds + TB, preB, preA);
        q += F.G; if (q >= NU) break;
        F2_BODY(F.lds + TB, F.lds, preA, preB);
    }
#undef F2_BODY
#undef F2_OLD
#undef PF_LOAD
#undef PF_WAIT
}
__device__ __forceinline__ void ctx_fourier(Frame& F, int l) {
    const bf16* UXF = WSP(bf16, WS_Y); bf16* A4 = WSP(bf16, WS_A4);
    const bf16* WC = (const bf16*)(F.ws + WS_WC); const bf16* PQF = (const bf16*)(F.ws + WS_TAB + TAB_PQF) + (size_t)l * 8 * 8192;
    const int wv = F.wave, kq = wv & 3, grp = wv >> 2;
    for (int it = (F.G == 256) ? F.vcu - 128 : F.vcu; it < NB * 4 * 4; it += F.G) {
        if (it < 0) continue;
        int tid = F.tid; asm volatile("" : "+v"(tid)); const int lane = tid & 63, li = lane & 15, g = lane >> 4;
        const int kt = it & 3, cb = (it >> 2) & 3, b = it >> 4, gi = 2 * cb + grp;
#pragma unroll
        for (int i8 = 0; i8 < 8; ++i8) { const int ch = tid + NTHR * i8, row = ch >> 4, c16 = ch & 15;
            *(LAS v4u*)(F.lds + row * FRS + 16 * c16) = *(const v4u*)(UXF + (size_t)(TL + b * CTXL + row) * 512 + 128 * cb + 8 * c16); }
        bf16x8 wr[8], wi[8], pqr[16];
#pragma unroll
        for (int t = 0; t < 8; ++t) { wr[t] = glb_frag(WC + ((((size_t)(kt * 4 + kq) * 2 + 0) * 8 + t) * 64 + lane) * 8); wi[t] = glb_frag(WC + ((((size_t)(kt * 4 + kq) * 2 + 1) * 8 + t) * 64 + lane) * 8); }
#pragma unroll
        for (int q = 0; q < 16; ++q) pqr[q] = glb_frag(PQF + (size_t)gi * 8192 + lane * 8 + q * 512);
        lds_barrier();
        bf16x8 uf[4];
#pragma unroll
        for (int hp = 0; hp < 2; ++hp) { f32x4 r0 = {0.f, 0.f, 0.f, 0.f}, r1 = r0, i0 = r0, i1 = r0;
#pragma unroll
            for (int t = 0; t < 8; ++t) { const bf16x8 d0 = dft_frag(F.lds, t, 4 * grp + 2 * hp, lane), d1 = dft_frag(F.lds, t, 4 * grp + 2 * hp + 1, lane);
                r0 = mfma16(d0, wr[t], r0); r1 = mfma16(d1, wr[t], r1); i0 = mfma16(d0, wi[t], i0); i1 = mfma16(d1, wi[t], i1); }
            v4u wr_, wi_; wr_.x = pk2(r0[0], r0[1]); wr_.y = pk2(r0[2], r0[3]); wr_.z = pk2(r1[0], r1[1]); wr_.w = pk2(r1[2], r1[3]);
            wi_.x = pk2(i0[0], i0[1]); wi_.y = pk2(i0[2], i0[3]); wi_.z = pk2(i1[0], i1[1]); wi_.w = pk2(i1[2], i1[3]);
            uf[hp] = __builtin_bit_cast(bf16x8, wr_); uf[2 + hp] = __builtin_bit_cast(bf16x8, wi_); }
        bf16* orow = A4 + (size_t)(TL + b * CTXL + 64 * kt + 16 * kq + li) * 1024 + 64 * gi;
#pragma unroll
        for (int nd = 0; nd < 4; ++nd) { f32x4 a = {0.f, 0.f, 0.f, 0.f};
#pragma unroll
            for (int ks = 0; ks < 4; ++ks) a = mfma16(pqr[nd * 4 + ks], uf[ks], a);
            DBG_CHK(a[0] + a[1] + a[2] + a[3], 11); st4bf(orow + 16 * nd + 4 * g, a); }
        lds_barrier();
    }
    lds_barrier();
}

struct Args { const float* in[17]; float* out; unsigned char* ws; int ph_lo, ph_hi; };
constexpr int NPHASES = 2 + DEPTH * 12;
__global__ void __launch_bounds__(NTHR, 2) mega_fwd(Args args) {
    extern __shared__ __attribute__((aligned(16))) unsigned char lds[];
    Frame F;
    F.lds = (LAS unsigned char*)lds;
    F.MISC = (volatile LAS unsigned*)(F.lds + MISC_OFF);
    F.tid = threadIdx.x; F.lane = F.tid & 63; F.wave = __builtin_amdgcn_readfirstlane(F.tid >> 6);
    F.G = gridDim.x; { const int bx = blockIdx.x; F.vcu = (F.G % 8 == 0) ? (bx % 8) * (F.G / 8) + bx / 8 : bx; }
    F.ws = args.ws; F.ctl = (gu32*)(args.ws + WS_CTL);
    if (F.tid < 16) ((LAS unsigned*)(F.lds + MISC_OFF))[F.tid] = 0u;
    if (F.tid == 64) { LAS unsigned long long* pt = (LAS unsigned long long*)(F.lds + PTAB_OFF);
#pragma unroll
        for (int i = 0; i < 17; ++i) pt[i] = (unsigned long long)args.in[i];
        pt[17] = (unsigned long long)args.out; pt[18] = (unsigned long long)args.ws; }
    __syncthreads();
    XcdBarrier bar = xcd_barrier_post((unsigned*)(F.ctl + CW_BAR), F.MISC + 8);
    const int lo = args.ph_lo, hi = args.ph_hi;
    const int vcu_s = F.vcu; const int wave_s = F.wave;
    int pid = 0;
#ifdef SEC_PROBE
#define SEC_T(v_) const unsigned long long v_ = __builtin_amdgcn_s_memrealtime();
#define SEC_SLEEP(a_, b_) { const unsigned long long t_ = __builtin_amdgcn_s_memrealtime(), d_ = ((b_) - (a_)) * SEC_K; while (__builtin_amdgcn_s_memrealtime() - t_ < d_) __builtin_amdgcn_s_sleep(32); }
#else
#define SEC_T(v_)
#define SEC_SLEEP(a_, b_)
#endif
#define PH_BEGIN if (lo <= pid && pid < hi) { { int t_; asm volatile("v_mbcnt_lo_u32_b32 %0, -1, 0\n\tv_mbcnt_hi_u32_b32 %0, -1, %0" : "=v"(t_)); t_ += wave_s * 64; { int g_ = (int)gridDim.x, v_ = vcu_s, b_ = (int)blockIdx.x; asm volatile("" : "+s"(g_), "+s"(v_), "+s"(b_)); F.G = g_; F.vcu = v_; F.bid = b_; } F.tid = t_; F.lane = t_ & 63; F.wave = __builtin_amdgcn_readfirstlane(t_ >> 6); { LAS unsigned char* lp_ = (LAS unsigned char*)lds; asm volatile("" : "+s"(lp_)); F.lds = lp_; } F.ws = (unsigned char*)(GAS unsigned char*)ptab(F, 18); F.ctl = (gu32*)(F.ws + WS_CTL); }
#define PH_END   if (pid + 1 < hi) { int tb_; asm volatile("v_mbcnt_lo_u32_b32 %0, -1, 0\n\tv_mbcnt_hi_u32_b32 %0, -1, %0" : "=v"(tb_)); xcd_barrier(bar.bar, bar.x, bar.st, tb_ + wave_s * 64, gridDim.x); } } ++pid;
#define XC WSP(float, WS_XC)
#define Hb ((bf16*)FOUT)
#define XB WSP(bf16, WS_XB)
#define Yb WSP(bf16, WS_Y)
#define ACT WSP(bf16, WS_ACT)
#define A4 WSP(bf16, WS_A4)
#define MOD WSP(float, WS_MOD)

    PH_BEGIN mod_first(F);
      if (F.G == 256) { if (pid + 1 < hi && F.tid == 0) { __builtin_amdgcn_fence(__ATOMIC_RELEASE, "agent"); asm volatile("s_waitcnt vmcnt(0)" ::: "memory"); __hip_atomic_fetch_add((unsigned*)(F.ctl + CW_MODCNT), 1u, __ATOMIC_RELAXED, __HIP_MEMORY_SCOPE_AGENT); } }
      else if (pid + 1 < hi) { int tb_; asm volatile("v_mbcnt_lo_u32_b32 %0, -1, 0\n\tv_mbcnt_hi_u32_b32 %0, -1, %0" : "=v"(tb_)); xcd_barrier(bar.bar, bar.x, bar.st, tb_ + wave_s * 64, gridDim.x); }
    } ++pid;
    PH_BEGIN { SEC_T(ta_) REP(0) p0_prologue(F, 3, F.vcu, F.G); SEC_T(tb_s)
#if defined(SEC_PROBE) && SEC_PROBE == 5
      SEC_SLEEP(ta_, tb_s)
#endif

      if (F.G != 256) { int tb_; asm volatile("v_mbcnt_lo_u32_b32 %0, -1, 0\n\tv_mbcnt_hi_u32_b32 %0, -1, %0" : "=v"(tb_)); xcd_barrier(bar.bar, bar.x, bar.st, tb_ + wave_s * 64, gridDim.x); }
      else { if (F.tid == 0) { unsigned sp_ = 0u; while (__hip_atomic_load((unsigned*)(F.ctl + CW_MODCNT), __ATOMIC_RELAXED, __HIP_MEMORY_SCOPE_AGENT) < 256u && ++sp_ < (1u << 24)) __builtin_amdgcn_s_sleep(2);
                            __builtin_amdgcn_fence(__ATOMIC_ACQUIRE, "agent"); asm volatile("s_waitcnt vmcnt(0)" ::: "memory"); }
             __syncthreads(); }
      REP(1) { const Thin P{FIN(I_X), FIN(I_CTX), XB, XC, nullptr, nullptr, nullptr, nullptr, Hb, FIN(I_NORMW) + 0 * DM, MOD + 1 * DM, MOD + 0 * DM, 0.f, 0, TT, 0, 1}; thin_phase(F, P, 0); } } PH_END

#pragma unroll 1
    for (int hl = 0; hl < 2 * DEPTH; ++hl) {
        const int l = hl >> 1, f = hl & 1; const bool last = (l == DEPTH - 1);

        const int Mrows = (last && f == 1) ? TL : TT;
        PH_BEGIN REP(2) { pg8::Gemm gm{Hb, WSP(bf16, WS_WFFIN) + (size_t)(l * 2 + f) * 2 * DFF * DM, Mrows, 2 * DFF, DM, DM, 0, 0}; pg8::StaticOrder S; S.init(Mrows, 2 * DFF, F.G, F.bid);
            pg8::EpiSwiGLU E{ACT, DFF}; pg8::gemm_phase<pg8::EpiSwiGLU, pg8::StaticOrder, true, true>(F.lds, gm, S, E, F.tid);
            if (false && l == 0) { const int nfull = (Mrows / 256) * (2 * DFF / 256) % F.G; if (nfull > 0 && F.bid >= nfull) p0_prologue(F, 1 + f, F.bid - nfull, F.G - nfull); } } PH_END
        PH_BEGIN REP(3) { { pg8::Gemm gm{ACT, WSP(bf16, WS_WFFOUT) + (size_t)(l * 2 + f) * DM * DFF, TL, DM, DFF, DFF, 1, 1}; pg8::StaticOrder S; S.init(TL, DM, F.G, F.bid, 1);
            pg8::EpiPlain E{Yb, DM}; pg8::gemm_phase<pg8::EpiPlain, pg8::StaticOrder, false, true>(F.lds, gm, S, E, F.tid); }
            if (Mrows > TL) {
                pg8::Gemm gm{ACT, WSP(bf16, WS_WFFOUT) + (size_t)(l * 2 + f) * DM * DFF, TT, DM, DFF, 256, 1, 1}; pg8::SplitKOrder S; S.init(TL / 256, 4, 4, 11, F.G, F.bid);
                pg8::EpiSlab E{WSP(float, WS_SLAB2), DM, TL / 256, (size_t)TC * DM}; pg8::gemm_phase<pg8::EpiSlab, pg8::SplitKOrder, true, true>(F.lds, gm, S, E, F.tid); } } PH_END
        PH_BEGIN { const int j = f ? 2 : 0;
            const float* nw = FIN(I_NORMW) + (size_t)l * 6 * DM; const float* modl = MOD + (size_t)l * 5 * NMOD * DM; const bool fin = last && f == 1;
            bf16* const Hp = (f == 0 || !last) ? Hb : nullptr;
            const float* const nwp = (f == 0) ? nw + 2 * DM : nw + 6 * DM;
            const float* const scp = (f == 0) ? modl + 4 * DM : modl + (size_t)5 * NMOD * DM + 1 * DM;
            const float* const shp = (f == 0) ? modl + 3 * DM : modl + (size_t)5 * NMOD * DM;
            const Thin P{XB, XC, fin ? (void*)FOUT : (void*)XB, XC, Yb, WSP(float, WS_SLAB2), nw + (f ? 5 : 1) * DM, modl + (3 * j + 2) * DM, Hp, nwp, scp, shp, 0.5f, (Mrows > TL) ? 11 : 0, Mrows, 1, fin ? 0 : 1};
            REP(4) thin_phase(F, P, l == 0 ? (f ? 3 : 1) : (f ? 6 : 4), rep_ == 0 && ((DUPMASK >> 4) & 1));
#ifdef DBG_FLAGS
            if (last && f == 1) { __syncthreads(); if (blockIdx.x == 0 && F.tid == 0) { const unsigned m = __hip_atomic_load((unsigned*)(F.ctl + 64), __ATOMIC_RELAXED, __HIP_MEMORY_SCOPE_AGENT); if (m) FOUT[0] = 1.0e6f * (float)(__builtin_ctz(m) + 1); } }
#endif
            } PH_END
        if (f == 0) {
            PH_BEGIN REP(5) { pg8::Gemm gm{Hb, WSP(bf16, WS_WIN) + (size_t)l * DIN_PAD * DM, TT, DIN_PAD, DM, DM, 0, 0}; pg8::StaticOrder S; S.init(TT, DIN_PAD, F.G, F.bid);
                pg8::EpiInProj E{Yb, Yb + (size_t)TT * 512, A4, WSP(float, WS_GT)}; pg8::gemm_phase<pg8::EpiInProj, pg8::StaticOrder, true, true>(F.lds, gm, S, E, F.tid); } PH_END
            PH_BEGIN { REP(6) m1_phase(F, l); REP(12) f1_phase(F); } PH_END
            PH_BEGIN { REP(7) m2_phase(F, rep_ == 0 && ((DUPMASK >> 7) & 1)); REP(13) f2_phase(F, l); } PH_END
            PH_BEGIN { REP(8) m3_phase(F, l, last ? 256 : NCG, rep_ == 0 && ((DUPMASK >> 8) & 1)); if (!last) ctx_fourier(F, l); } PH_END
            { const int M4 = last ? TL : TT;
            PH_BEGIN REP(9) { { pg8::Gemm gm{A4, WSP(bf16, WS_WOUT) + (size_t)l * DM * DM, TL, DM, DM, DM, 0, 0}; pg8::StaticOrder S; S.init(TL, DM, F.G, F.bid);
                pg8::EpiPlain E{Yb, DM}; pg8::gemm_phase<pg8::EpiPlain, pg8::StaticOrder, false, true>(F.lds, gm, S, E, F.tid); }
                if (M4 > TL) { pg8::Gemm gm{A4, WSP(bf16, WS_WOUT) + (size_t)l * DM * DM, TT, DM, DM, 256, 0, 0}; pg8::SplitKOrder S; S.init(TL / 256, 4, 4, 4, F.G, F.bid);
                    pg8::EpiSlab E{WSP(float, WS_SLAB4), DM, TL / 256, (size_t)TC * DM}; pg8::gemm_phase<pg8::EpiSlab, pg8::SplitKOrder, true, true>(F.lds, gm, S, E, F.tid); } } PH_END
            PH_BEGIN { const float* nw = FIN(I_NORMW) + (size_t)l * 6 * DM; const float* modl = MOD + (size_t)l * 5 * NMOD * DM;
                const Thin P{XB, XC, XB, XC, Yb, WSP(float, WS_SLAB4), nw + 3 * DM, modl + 5 * DM, Hb, nw + 4 * DM, modl + 7 * DM, modl + 6 * DM, 1.0f, (M4 > TL) ? 4 : 0, M4, 1, 1}; REP(10) thin_phase(F, P, l == 0 ? 2 : 5, rep_ == 0 && ((DUPMASK >> 10) & 1)); } PH_END
            }
        }
    }
#undef XC
#undef Hb
#undef XB
#undef Yb
#undef ACT
#undef A4
#undef MOD
#undef PH_BEGIN
#undef PH_END
}

#ifndef MK_PER_PHASE
#define MK_PER_PHASE 0
#endif
extern "C" void kernel_launch(void* const* d_in, const int* in_sizes, int n_in, void* d_out, int out_size, void* d_ws, size_t ws_size, hipStream_t stream) {
    static int grid = 0;
    if (grid == 0) {
        if (n_in != 17 || out_size != TL * DM || ws_size < WS_END) { fprintf(stderr, "kernel_launch: unexpected problem (n_in %d, out %d, ws %zu); nothing launched\n", n_in, out_size, ws_size); grid = -1; return; }
        int dev = 0, cus = 0, per_cu = 0;
        if (hipGetDevice(&dev) != hipSuccess || hipDeviceGetAttribute(&cus, hipDeviceAttributeMultiprocessorCount, dev) != hipSuccess) { grid = -1; return; }
        if (hipFuncSetAttribute((const void*)mega_fwd, hipFuncAttributeMaxDynamicSharedMemorySize, LDS_BYTES) != hipSuccess) { fprintf(stderr, "kernel_launch: hipFuncSetAttribute failed\n"); grid = -1; return; }
        if (hipOccupancyMaxActiveBlocksPerMultiprocessor(&per_cu, (const void*)mega_fwd, NTHR, LDS_BYTES) != hipSuccess || per_cu < 1) fprintf(stderr, "kernel_launch: occupancy query reports %d\n", per_cu);
        (void)hipGetLastError();
        grid = cus;
    }
    if (grid < 0) return;
    if (hipMemsetAsync((char*)d_ws + WS_CTL, 0, CTL_ZERO_BYTES, stream) != hipSuccess) return;
    Args a{};
    for (int i = 0; i < 17; ++i) a.in[i] = (const float*)d_in[i];
    a.out = (float*)d_out; a.ws = (unsigned char*)d_ws;
#if MK_PER_PHASE
    for (int p = 0; p < NPHASES; ++p) { a.ph_lo = p; a.ph_hi = p + 1; hipLaunchKernelGGL(mega_fwd, dim3(grid), dim3(NTHR), LDS_BYTES, stream, a); }
#else
    a.ph_lo = 0; a.ph_hi = NPHASES;
    hipLaunchKernelGGL(mega_fwd, dim3(grid), dim3(NTHR), LDS_BYTES, stream, a);
#endif
}
```
